# Optimizing an MI355X kernel written in HIP

```python
import math
import jax, jax.numpy as jnp
from jax import lax
import numpy as np

D_MODEL = 2048
BATCH = 8
SEQ = 4096
DEPTH = 4

CHUNK = 64
Q_BLOCK = 128
MLA_HEADS = 16
QK_NOPE_DIM = 128
QK_ROPE_DIM = 64
V_HEAD_DIM = 128
Q_LORA_RANK = 512
KV_LORA_RANK = 256
ROPE_THETA = 10000.0
SSM_WIDTH = D_MODEL // 2
SSM_GROUP = 16
SSM_GROUPS = SSM_WIDTH // SSM_GROUP
SSM_STATE = 64
DT_MIN = 1e-3
DT_MAX = 1e-1
FFN_HIDDEN = -(-8 * D_MODEL // (3 * 256)) * 256
OFF_KV = Q_LORA_RANK
OFF_SSM = OFF_KV + KV_LORA_RANK + QK_ROPE_DIM
OFF_GATE = OFF_SSM + SSM_WIDTH
IN_WIDTH = OFF_GATE + 2 * D_MODEL
EPS = 1e-6

kernel_name = "chunk_causal_mla_s5_hybrid"


def rms_norm(x, w):
    xf = x.astype(jnp.float32)
    y = xf * lax.rsqrt(jnp.mean(xf * xf, axis=-1, keepdims=True) + EPS)
    return (y * w.astype(jnp.float32)).astype(x.dtype)


def rope_tables(positions):
    inv_freq = ROPE_THETA ** (-jnp.arange(0, QK_ROPE_DIM, 2, dtype=jnp.float32) / QK_ROPE_DIM)
    ang = positions.astype(jnp.float32)[..., None] * inv_freq
    return jnp.cos(ang), jnp.sin(ang)


def apply_rope(x, cos, sin):
    half = x.shape[-1] // 2
    x1 = x[..., :half].astype(jnp.float32)
    x2 = x[..., half:].astype(jnp.float32)
    return jnp.concatenate([x1 * cos - x2 * sin, x1 * sin + x2 * cos], axis=-1).astype(x.dtype)


def mla(cq_raw, ckv_raw, q_norm_w, kv_norm_w, w_uq, w_ukv, w_o, cos, sin):
    B, S, _ = cq_raw.shape
    H = MLA_HEADS
    c_q = rms_norm(cq_raw, q_norm_w)
    q = jnp.einsum('bsr,re->bse', c_q, w_uq).reshape(B, S, H, QK_NOPE_DIM + QK_ROPE_DIM)
    q_nope = q[..., :QK_NOPE_DIM]
    q_pe = apply_rope(q[..., QK_NOPE_DIM:], cos[:, :, None, :], sin[:, :, None, :])
    c_kv = rms_norm(ckv_raw[..., :KV_LORA_RANK], kv_norm_w)
    k_pe = apply_rope(ckv_raw[..., KV_LORA_RANK:], cos, sin)
    kv = jnp.einsum('bsr,re->bse', c_kv, w_ukv).reshape(B, S, H, QK_NOPE_DIM + V_HEAD_DIM)
    k_nope = kv[..., :QK_NOPE_DIM]
    v = kv[..., QK_NOPE_DIM:]
    scale = (QK_NOPE_DIM + QK_ROPE_DIM) ** -0.5
    outs = []
    for q0 in range(0, S, Q_BLOCK):
        q1 = min(q0 + Q_BLOCK, S)
        kv_len = min(S, ((q1 - 1) // CHUNK + 1) * CHUNK)
        s = (jnp.einsum('bqhd,bkhd->bhqk', q_nope[:, q0:q1], k_nope[:, :kv_len],
                        preferred_element_type=jnp.float32)
             + jnp.einsum('bqhd,bkd->bhqk', q_pe[:, q0:q1], k_pe[:, :kv_len],
                          preferred_element_type=jnp.float32)) * scale
        q_chunk = jnp.arange(q0, q1) // CHUNK
        k_chunk = jnp.arange(kv_len) // CHUNK
        mask = k_chunk[None, :] <= q_chunk[:, None]
        s = jnp.where(mask, s, jnp.finfo(jnp.float32).min)
        p = jax.nn.softmax(s, axis=-1).astype(v.dtype)
        outs.append(jnp.einsum('bhqk,bkhd->bqhd', p, v[:, :kv_len]))
    o = jnp.concatenate(outs, axis=1).reshape(B, S, H * V_HEAD_DIM)
    return jnp.einsum('bse,ed->bsd', o, w_o)


def s5(u, a_re, a_im, log_dt, b_re, b_im, c_re, c_im, d_skip, w_glu, b_glu):
    B, S, _ = u.shape
    G, N, P = SSM_GROUPS, SSM_STATE, SSM_GROUP
    f32 = jnp.float32
    uf = u.astype(f32).reshape(B, S, G, P)
    a_re = a_re.astype(f32)
    a_im = a_im.astype(f32)
    dt = jnp.exp(log_dt.astype(f32))[:, None]
    mag = jnp.exp(a_re * dt)
    abar_re = mag * jnp.cos(a_im * dt)
    abar_im = mag * jnp.sin(a_im * dt)
    den = a_re * a_re + a_im * a_im
    nr = abar_re - 1.0
    f_re = (nr * a_re + abar_im * a_im) / den
    f_im = (abar_im * a_re - nr * a_im) / den
    br = b_re.astype(f32)
    bi = b_im.astype(f32)
    bb_re = f_re[..., None] * br - f_im[..., None] * bi
    bb_im = f_re[..., None] * bi + f_im[..., None] * br
    bu_re = jnp.einsum('bsgp,gnp->bsgn', uf, bb_re)
    bu_im = jnp.einsum('bsgp,gnp->bsgn', uf, bb_im)
    ar = jnp.broadcast_to(abar_re[None, None], (1, S, G, N))
    ai = jnp.broadcast_to(abar_im[None, None], (1, S, G, N))

    def combine(e1, e2):
        a1r, a1i, b1r, b1i = e1
        a2r, a2i, b2r, b2i = e2
        return (a2r * a1r - a2i * a1i,
                a2r * a1i + a2i * a1r,
                a2r * b1r - a2i * b1i + b2r,
                a2r * b1i + a2i * b1r + b2i)

    _, _, xr, xi = lax.associative_scan(combine, (ar, ai, bu_re, bu_im), axis=1)
    y = (jnp.einsum('bsgn,gpn->bsgp', xr, c_re.astype(f32))
         - jnp.einsum('bsgn,gpn->bsgp', xi, c_im.astype(f32))
         + d_skip.astype(f32).reshape(G, P) * uf).reshape(B, S, SSM_WIDTH)
    z = jax.nn.gelu(y).astype(u.dtype)
    zz = jnp.einsum('bsw,we->bse', z, w_glu) + b_glu
    return zz[..., :D_MODEL] * jax.nn.sigmoid(zz[..., D_MODEL:])


def setup_inputs(seed: int = 0) -> dict:
    key = jax.random.key(seed)
    ks = jax.random.split(key, 32)
    L, D = DEPTH, D_MODEL
    G, N, P = SSM_GROUPS, SSM_STATE, SSM_GROUP
    f32 = jnp.float32

    def nrm(k, shape, scale):
        return jax.random.normal(k, shape, f32) * scale

    def gain(k, n):
        return 1.0 + 0.05 * jax.random.normal(k, (L, n), f32)

    x = jax.random.normal(ks[0], (BATCH, SEQ, D), f32)
    offsets = jax.random.randint(ks[1], (BATCH, 1), 0, 4096, dtype=jnp.int32)
    positions = offsets + jnp.arange(SEQ, dtype=jnp.int32)[None, :]
    n_idx = jnp.arange(N, dtype=f32)
    return {
        "x": x,
        "positions": positions,
        "pre_mix_norm": gain(ks[2], D),
        "w_in": nrm(ks[3], (L, D, IN_WIDTH), D ** -0.5),
        "b_gate": nrm(ks[4], (L, 2 * D), 0.01),
        "q_norm": gain(ks[5], Q_LORA_RANK),
        "kv_norm": gain(ks[6], KV_LORA_RANK),
        "w_uq": nrm(ks[7], (L, Q_LORA_RANK, MLA_HEADS * (QK_NOPE_DIM + QK_ROPE_DIM)), Q_LORA_RANK ** -0.5),
        "w_ukv": nrm(ks[8], (L, KV_LORA_RANK, MLA_HEADS * (QK_NOPE_DIM + V_HEAD_DIM)), KV_LORA_RANK ** -0.5),
        "w_o_mla": nrm(ks[9], (L, MLA_HEADS * V_HEAD_DIM, D), (MLA_HEADS * V_HEAD_DIM) ** -0.5),
        "ssm_a_re": -0.5 + nrm(ks[10], (L, G, N), 0.01),
        "ssm_a_im": math.pi * n_idx + nrm(ks[11], (L, G, N), 0.01),
        "ssm_log_dt": jax.random.uniform(ks[12], (L, G), f32, math.log(DT_MIN), math.log(DT_MAX)),
        "ssm_b_re": nrm(ks[13], (L, G, N, P), (2 * P) ** -0.5),
        "ssm_b_im": nrm(ks[14], (L, G, N, P), (2 * P) ** -0.5),
        "ssm_c_re": nrm(ks[15], (L, G, P, N), (2 * N) ** -0.5),
        "ssm_c_im": nrm(ks[16], (L, G, P, N), (2 * N) ** -0.5),
        "ssm_d": nrm(ks[17], (L, SSM_WIDTH), 1.0),
        "w_glu": nrm(ks[18], (L, SSM_WIDTH, 2 * D), SSM_WIDTH ** -0.5),
        "b_glu": nrm(ks[19], (L, 2 * D), 0.01),
        "w_out": nrm(ks[20], (L, D, D), D ** -0.5),
        "post_mix_norm": gain(ks[21], D),
        "pre_ffn_norm": gain(ks[22], D),
        "w_ffn_gate": nrm(ks[23], (L, D, FFN_HIDDEN), D ** -0.5),
        "w_ffn_up": nrm(ks[24], (L, D, FFN_HIDDEN), D ** -0.5),
        "w_ffn_down": nrm(ks[25], (L, FFN_HIDDEN, D), FFN_HIDDEN ** -0.5),
        "post_ffn_norm": gain(ks[26], D),
    }


def reference(x, positions, pre_mix_norm, w_in, b_gate, q_norm, kv_norm, w_uq, w_ukv, w_o_mla,
              ssm_a_re, ssm_a_im, ssm_log_dt, ssm_b_re, ssm_b_im, ssm_c_re, ssm_c_im, ssm_d,
              w_glu, b_glu, w_out, post_mix_norm, pre_ffn_norm, w_ffn_gate, w_ffn_up,
              w_ffn_down, post_ffn_norm):
    cos, sin = rope_tables(positions)
    for l in range(DEPTH):
        h = rms_norm(x, pre_mix_norm[l])
        proj = jnp.einsum('bsd,de->bse', h, w_in[l])
        cq_raw = proj[..., :OFF_KV]
        ckv_raw = proj[..., OFF_KV:OFF_SSM]
        u = proj[..., OFF_SSM:OFF_GATE]
        gates = jax.nn.sigmoid((proj[..., OFF_GATE:] + b_gate[l]).astype(jnp.float32))
        a_out = mla(cq_raw, ckv_raw, q_norm[l], kv_norm[l], w_uq[l], w_ukv[l], w_o_mla[l], cos, sin)
        s_out = s5(u, ssm_a_re[l], ssm_a_im[l], ssm_log_dt[l], ssm_b_re[l], ssm_b_im[l],
                   ssm_c_re[l], ssm_c_im[l], ssm_d[l], w_glu[l], b_glu[l])
        merged = (gates[..., :D_MODEL] * a_out.astype(jnp.float32)
                  + gates[..., D_MODEL:] * s_out.astype(jnp.float32)).astype(x.dtype)
        mix = jnp.einsum('bsd,de->bse', merged, w_out[l])
        x = x + rms_norm(mix, post_mix_norm[l])
        h = rms_norm(x, pre_ffn_norm[l])
        f = jnp.einsum('bsf,fd->bsd',
                       jax.nn.silu(jnp.einsum('bsd,df->bsf', h, w_ffn_gate[l]))
                       * jnp.einsum('bsd,df->bsf', h, w_ffn_up[l]),
                       w_ffn_down[l])
        x = x + rms_norm(f, post_ffn_norm[l])
    return x
```

```cpp
#include <hip/hip_runtime.h>
#include <cstdio>
#include <cstdint>
#define MK_ALIGN true
#ifndef MK_SINGLE
#define MK_SINGLE 0
#endif
#ifndef MK_PH_END
#define MK_PH_END NPH
#endif
#ifndef PH_MASK
#define PH_MASK 0x1FFF
#endif
#ifndef DBG_DELTA
#define DBG_DELTA C_RA
#endif
namespace pg8 {
#define PG8_LAS __attribute__((address_space(3)))
typedef unsigned short bf16_t;
typedef short bf16x8 __attribute__((ext_vector_type(8)));
typedef float f32x4 __attribute__((ext_vector_type(4)));
typedef unsigned u32x4 __attribute__((ext_vector_type(4)));
constexpr int BM = 256, BK = 64, HALF = 128, HTB = HALF * BK * 2  , STAGE_BYTES = 8 * HTB, NXCD = 8, WGM = 8;

__host__ __device__ __forceinline__ int lds_byte(int r, int c) { const int st = (r >> 4) * 2 + (c >> 5), rr = r & 15, cc = c & 31, ob = rr * 64 + cc * 2; return st * 1024 + (ob ^ (((ob >> 9) & 1) << 5)); }
__host__ __device__ __forceinline__ void stage_rc(int b, int& R, int& C) { const int st = b / 1024, sb = b % 1024, swz = sb ^ (((sb >> 9) & 1) << 5); R = (st >> 1) * 16 + swz / 64; C = (st & 1) * 32 + (swz % 64) / 2; }
__host__ __device__ __forceinline__ int perm32(int rho) { const int n = rho >> 4, i = rho & 15; return 8 * (i >> 2) + 4 * n + (i & 3); }

__device__ __forceinline__ int opaque_tid() { int t = threadIdx.x; asm volatile("" : "+v"(t)); return t; }
struct Unit { int pm, pn; };
struct Gemm { const bf16_t* A; const bf16_t* Bt; int M, N, K; };

struct StaticOrder {
    int nM, nN, nwg, G, c;
    __host__ __device__ void init(int M, int N, int G_, int c_) { nM = M / BM; nN = N / BM; nwg = nM * nN; G = G_; c = c_; }
    __host__ __device__ bool next(int i, Unit& u) const {
        const long L = (long)i * G + c; if (L >= nwg) return false;
        int wgid = (int)L; { const int q = nwg / NXCD, r = nwg % NXCD, xcd = wgid % NXCD, off = wgid / NXCD; wgid = (xcd < r ? xcd * (q + 1) : r * (q + 1) + (xcd - r) * q) + off; }
        const int nig = WGM * nN, gid = wgid / nig, fm = gid * WGM, gsz = (nM - fm) < WGM ? (nM - fm) : WGM;
        u.pm = fm + ((wgid % nig) % gsz); u.pn = (wgid % nig) / gsz; return true;
    }
    __device__ __forceinline__ void a_ready(const Unit&) const {}
    __device__ __forceinline__ void done(const Unit&) const {}
};

typedef __bf16 bf16x2_t __attribute__((ext_vector_type(2))); typedef float f32x2_t __attribute__((ext_vector_type(2)));
__device__ __forceinline__ unsigned cvt_pk_bf16(float lo, float hi) { const f32x2_t v = {lo, hi}; const bf16x2_t b = __builtin_convertvector(v, bf16x2_t); return __builtin_bit_cast(unsigned, b); }
template <class Epi, class Sched, bool ALIGN_EPI = false, bool SP2 = false>
__device__ __forceinline__ void gemm_phase(PG8_LAS unsigned char* lds, const Gemm g, const Sched& S, const Epi& E) {
    const int tid = opaque_tid(), wid = __builtin_amdgcn_readfirstlane(tid >> 6), lane = tid & 63, wr = wid >> 2, wc = wid & 3, fr = lane & 15, fq = lane >> 4;
    const int K = g.K, nt = K / BK;
    unsigned voffA[2], voffB[2];
#pragma unroll
    for (int i = 0; i < 2; ++i) { int R, C; stage_rc(tid * 16 + i * 8192, R, C); const int Rb = Epi::PERM ? ((R & ~31) + perm32(R & 31)) : R;
        voffA[i] = (unsigned)(R * K + C) * 2u; voffB[i] = (unsigned)(Rb * K + C) * 2u; }
    const size_t kstep = (size_t)(BK * 2);
    const size_t hstep = (size_t)HALF * K * 2;
    const size_t tstep = 2 * hstep;
    const unsigned ldsw = (unsigned)wid * 1024u;
    const int aoff = lds_byte(wr * 64 + fr, fq * 8), boff = lds_byte(wc * 32 + fr, fq * 8);
#define PG8_SA(b, h) (((b) * 2 + (h)) * HTB)
#define PG8_SB(b, h) ((4 + (b) * 2 + (h)) * HTB)
#define PG8_STAGE(bufoff, gbase, voff) do { _Pragma("unroll") for (int _i = 0; _i < 2; ++_i) \
        __builtin_amdgcn_global_load_lds((const unsigned*)((const char*)(gbase) + (voff)[_i]), (PG8_LAS unsigned*)(lds + (bufoff) + ldsw + _i * 8192), 16, 0, 0); } while (0)
#define PG8_LDA(dst, b, h) do { _Pragma("unroll") for (int m = 0; m < 4; ++m) _Pragma("unroll") for (int k = 0; k < 2; ++k) dst[m][k] = *(const PG8_LAS bf16x8*)(lds + PG8_SA(b, h) + aoff + m * 2048 + k * 1024); } while (0)
#define PG8_LDB(dst, b, h) do { _Pragma("unroll") for (int n = 0; n < 2; ++n) _Pragma("unroll") for (int k = 0; k < 2; ++k) dst[n][k] = *(const PG8_LAS bf16x8*)(lds + PG8_SB(b, h) + boff + n * 2048 + k * 1024); } while (0)
#define PG8_MMA(ai, bj, At, Bt) do { __builtin_amdgcn_s_setprio(1); _Pragma("unroll") for (int m = 0; m < 4; ++m) _Pragma("unroll") for (int n = 0; n < 2; ++n) _Pragma("unroll") for (int k = 0; k < 2; ++k) \
        acc[ai][bj][m][n] = __builtin_amdgcn_mfma_f32_16x16x32_bf16(Bt[n][k], At[m][k], acc[ai][bj][m][n], 0, 0, 0); __builtin_amdgcn_s_setprio(0); } while (0)
#define PG8_WAIT_V(n) asm volatile("s_waitcnt vmcnt(" #n ")" ::: "memory")
#define PG8_WAIT_L(n) asm volatile("s_waitcnt lgkmcnt(" #n ")" ::: "memory")
#define PG8_BAR __builtin_amdgcn_s_barrier()
#define PG8_SCHED __builtin_amdgcn_sched_barrier(0)
    Unit cur, nxt; int ui = 0;
    if (!S.next(0, cur)) return;
    f32x4 acc[2][2][4][2];
#pragma unroll
    for (int a = 0; a < 2; ++a)
#pragma unroll
        for (int b = 0; b < 2; ++b)
#pragma unroll
            for (int m = 0; m < 4; ++m)
#pragma unroll
                for (int n = 0; n < 2; ++n) acc[a][b][m][n] = (f32x4){0.f, 0.f, 0.f, 0.f};
    bf16x8 At[4][2], B0[2][2], B1[2][2];
    const char* cA = (const char*)g.A + (size_t)cur.pm * tstep; const char* cB = (const char*)g.Bt + (size_t)cur.pn * tstep;
    S.a_ready(cur);
    if constexpr (SP2) {
        PG8_STAGE(PG8_SB(0, 0), cB, voffB); PG8_STAGE(PG8_SB(0, 1), cB + hstep, voffB); PG8_STAGE(PG8_SA(0, 0), cA, voffA); PG8_STAGE(PG8_SA(0, 1), cA + hstep, voffA);
        if (wr == 1) PG8_BAR;
        PG8_WAIT_V(2); PG8_BAR;
        PG8_STAGE(PG8_SB(1, 0), cB + kstep, voffB); PG8_STAGE(PG8_SA(1, 0), cA + kstep, voffA); PG8_STAGE(PG8_SB(1, 1), cB + hstep + kstep, voffB);
        PG8_WAIT_V(6); PG8_BAR;
    } else {
        PG8_STAGE(PG8_SB(0, 0), cB, voffB); PG8_STAGE(PG8_SA(0, 0), cA, voffA); PG8_STAGE(PG8_SB(0, 1), cB + hstep, voffB); PG8_STAGE(PG8_SA(0, 1), cA + hstep, voffA);
        if (wr == 1) PG8_BAR;
        PG8_WAIT_V(4); PG8_BAR;
        PG8_STAGE(PG8_SB(1, 0), cB + kstep, voffB); PG8_STAGE(PG8_SA(1, 0), cA + kstep, voffA); PG8_STAGE(PG8_SB(1, 1), cB + hstep + kstep, voffB);
        PG8_WAIT_V(6); PG8_BAR;
    }
    for (;;) {
        const bool has_next = S.next(ui + 1, nxt);
        const char* nA = has_next ? (const char*)g.A + (size_t)nxt.pm * tstep : cA; const char* nB = has_next ? (const char*)g.Bt + (size_t)nxt.pn * tstep : cB;
        for (int t = 0; t < nt; t += 2) {
            const bool last = (t == nt - 2);
            const char* a1 = cA + (size_t)(t + 1) * kstep;
            const char* a2 = last ? nA : cA + (size_t)(t + 2) * kstep; const char* b2 = last ? nB : cB + (size_t)(t + 2) * kstep;
            const char* a3 = a2 + kstep; const char* b3 = b2 + kstep;
            if (last && has_next) S.a_ready(nxt);
            if constexpr (SP2) {
            PG8_LDB(B0, 0, 0); PG8_LDB(B1, 0, 1); PG8_SCHED; PG8_LDA(At, 0, 0); PG8_STAGE(PG8_SA(1, 1), a1 + hstep, voffA);
            PG8_WAIT_V(8); PG8_WAIT_L(0); PG8_BAR; PG8_MMA(0, 0, At, B0); PG8_MMA(0, 1, At, B1); PG8_BAR; PG8_SCHED;
            PG8_LDA(At, 0, 1); PG8_STAGE(PG8_SB(0, 0), b2, voffB); PG8_STAGE(PG8_SB(0, 1), b2 + hstep, voffB); PG8_STAGE(PG8_SA(0, 0), a2, voffA);
            PG8_WAIT_V(8); PG8_WAIT_L(0); PG8_BAR; PG8_MMA(1, 0, At, B0); PG8_MMA(1, 1, At, B1); PG8_BAR; PG8_SCHED;
            PG8_LDB(B0, 1, 0); PG8_LDB(B1, 1, 1); PG8_SCHED; PG8_LDA(At, 1, 0); PG8_STAGE(PG8_SA(0, 1), a2 + hstep, voffA);
            PG8_WAIT_V(8); PG8_WAIT_L(0); PG8_BAR; PG8_MMA(0, 0, At, B0); PG8_MMA(0, 1, At, B1); PG8_BAR; PG8_SCHED;
            PG8_LDA(At, 1, 1); PG8_STAGE(PG8_SB(1, 0), b3, voffB); PG8_STAGE(PG8_SB(1, 1), b3 + hstep, voffB); PG8_STAGE(PG8_SA(1, 0), a3, voffA);
            PG8_WAIT_V(8); PG8_WAIT_L(0); PG8_BAR; PG8_MMA(1, 0, At, B0); PG8_MMA(1, 1, At, B1); PG8_BAR; PG8_SCHED;
            } else {
            PG8_LDB(B0, 0, 0); PG8_SCHED; PG8_LDA(At, 0, 0); PG8_STAGE(PG8_SA(1, 1), a1 + hstep, voffA);
            PG8_WAIT_L(8); PG8_BAR; PG8_WAIT_L(0); PG8_MMA(0, 0, At, B0); PG8_BAR; PG8_SCHED;
            PG8_LDB(B1, 0, 1); PG8_STAGE(PG8_SB(0, 0), b2, voffB);
            PG8_BAR; PG8_WAIT_L(0); PG8_MMA(0, 1, At, B1); PG8_BAR;
            PG8_LDA(At, 0, 1); PG8_STAGE(PG8_SA(0, 0), a2, voffA);
            PG8_BAR; PG8_WAIT_L(0); PG8_MMA(1, 0, At, B0); PG8_BAR; PG8_SCHED;
            PG8_STAGE(PG8_SB(0, 1), b2 + hstep, voffB);
            PG8_WAIT_V(6); PG8_BAR; PG8_MMA(1, 1, At, B1); PG8_BAR;
            PG8_LDB(B0, 1, 0); PG8_SCHED; PG8_LDA(At, 1, 0); PG8_STAGE(PG8_SA(0, 1), a2 + hstep, voffA);
            PG8_WAIT_L(8); PG8_BAR; PG8_WAIT_L(0); PG8_MMA(0, 0, At, B0); PG8_BAR; PG8_SCHED;
            PG8_LDB(B1, 1, 1); PG8_STAGE(PG8_SB(1, 0), b3, voffB);
            PG8_BAR; PG8_WAIT_L(0); PG8_MMA(0, 1, At, B1); PG8_BAR;
            PG8_LDA(At, 1, 1); PG8_STAGE(PG8_SA(1, 0), a3, voffA);
            PG8_BAR; PG8_WAIT_L(0); PG8_MMA(1, 0, At, B0); PG8_BAR; PG8_SCHED;
            PG8_STAGE(PG8_SB(1, 1), b3 + hstep, voffB);
            PG8_WAIT_V(6); PG8_BAR; PG8_MMA(1, 1, At, B1); PG8_BAR;
            }
        }
        if constexpr (ALIGN_EPI) { if (wr == 0) PG8_BAR; }
        if constexpr (!Epi::AFTER_DRAIN) { E(acc, cur, wr, wc, fr, fq); S.done(cur); }
        if (!has_next) break;
#pragma unroll
        for (int a = 0; a < 2; ++a)
#pragma unroll
            for (int b = 0; b < 2; ++b)
#pragma unroll
                for (int m = 0; m < 4; ++m)
#pragma unroll
                    for (int n = 0; n < 2; ++n) acc[a][b][m][n] = (f32x4){0.f, 0.f, 0.f, 0.f};
        cur = nxt; cA = nA; cB = nB; ++ui;
        if constexpr (ALIGN_EPI) { if (wr == 1) PG8_BAR; }
    }
    PG8_WAIT_V(0);
    if constexpr (!ALIGN_EPI) { if (wr == 0) PG8_BAR; }
    PG8_BAR;
    if constexpr (Epi::AFTER_DRAIN) { E.fused(acc, cur, wr, wc, fr, fq, lds, wid, lane); S.done(cur); }
#undef PG8_SA
#undef PG8_SB
#undef PG8_STAGE
#undef PG8_LDA
#undef PG8_LDB
#undef PG8_MMA
#undef PG8_WAIT_V
#undef PG8_WAIT_L
#undef PG8_BAR
#undef PG8_SCHED
}
}

constexpr int BATCH = 8, SEQ = 4096, DM = 2048, DEPTH = 4, T = BATCH * SEQ;
constexpr int NH = 16, DQK = 192, QL = 512, KVL = 256;
constexpr int SW = 1024, SG = 64, SN = 64, SP = 16, FF = 5632;
constexpr int INW = 5952, OFF_SSM = 832, OFF_GATE = 1856;
constexpr int NIN = 6144;
constexpr float EPS = 1e-6f;
constexpr float QSCALE = 0.07216878364870322f * 1.4426950408889634f;
constexpr int NWAVES = 8;
constexpr int NPH = DEPTH * 12 + 1;

constexpr size_t MiB = 1u << 20;
constexpr size_t WS_CTL = 0, CTL_ZERO_BYTES = 1 * MiB;
constexpr size_t WS_COS = 1 * MiB, WS_SIN = 5 * MiB;
constexpr size_t WS_SSQQ = 9 * MiB, WS_SSQKV = 10 * MiB;
constexpr size_t WS_LP = 11 * MiB;
constexpr size_t WS_FB = WS_LP + 5 * MiB / 2;
constexpr size_t WS_KD = 14 * MiB;
constexpr size_t WS_MAT = 17 * MiB;
constexpr size_t WS_CCT = 33 * MiB;
constexpr size_t WS_XST = 49 * MiB;
constexpr size_t WS_W = 57 * MiB;
constexpr size_t WO_WIN = 0, WO_WUQ = 24 * MiB, WO_WUKV = 27 * MiB, WO_WO = 29 * MiB, WO_WGLU = 37 * MiB, WO_WOUT = 45 * MiB, WO_WGU = 53 * MiB, WO_WDN = 97 * MiB;
constexpr size_t WS_RA = 176 * MiB;
constexpr size_t WS_CQ = 304 * MiB, WS_CKV = 336 * MiB, WS_KPE = 352 * MiB, WS_U = 356 * MiB, WS_GA = 420 * MiB, WS_GB = 548 * MiB;
constexpr size_t WS_HID = 304 * MiB;
constexpr size_t WS_Q = 676 * MiB;
constexpr size_t WS_KV = 868 * MiB;
constexpr size_t WS_Z = 1124 * MiB;
constexpr size_t WS_END = 1188 * MiB;
static_assert(WS_HID + (size_t)T * FF * 2 <= WS_Q, "HID overlay");

constexpr int CW_TMO = 0, CW_CODE = 1, CW_BAR = 4096;

constexpr int RING_BYTES = 131072, MISC_OFF = RING_BYTES + 320, LDS_BYTES = 147456;

#define GAS __attribute__((address_space(1)))
#define LAS __attribute__((address_space(3)))
#define CAS __attribute__((address_space(4)))
typedef unsigned short bf16;
using pg8::bf16x8; using pg8::f32x4; using pg8::u32x4; using pg8::cvt_pk_bf16;
typedef float f32x2 __attribute__((ext_vector_type(2)));
typedef float f32x16 __attribute__((ext_vector_type(16)));
typedef unsigned u32x2 __attribute__((ext_vector_type(2)));
typedef short s16x4 __attribute__((ext_vector_type(4)));
typedef GAS unsigned gu32;
#define RLX_AGENT __ATOMIC_RELAXED, __HIP_MEMORY_SCOPE_AGENT
#define LDS_WAIT() asm volatile("s_waitcnt lgkmcnt(0)" ::: "memory")
#define VM_WAIT() asm volatile("s_waitcnt vmcnt(0)" ::: "memory")
__device__ __forceinline__ unsigned f2bf(float f) { unsigned u = __builtin_bit_cast(unsigned, f); return (u + 0x7fffu + ((u >> 16) & 1u)) >> 16; }
__device__ __forceinline__ unsigned pk2(float lo, float hi) { return f2bf(lo) | (f2bf(hi) << 16); }
__device__ __forceinline__ float bflo(unsigned w) { return __uint_as_float(w << 16); }
__device__ __forceinline__ float bfhi(unsigned w) { return __uint_as_float(w & 0xffff0000u); }
__device__ __forceinline__ float sigm(float x) { return __builtin_amdgcn_rcpf(1.0f + __builtin_amdgcn_exp2f(-1.4426950408889634f * x)); }
__device__ __forceinline__ void st8(bf16* p, f32x4 v0, f32x4 v1) { u32x4 w; w.x = cvt_pk_bf16(v0[0], v0[1]); w.y = cvt_pk_bf16(v0[2], v0[3]); w.z = cvt_pk_bf16(v1[0], v1[1]); w.w = cvt_pk_bf16(v1[2], v1[3]); *(u32x4*)p = w; }
__device__ __forceinline__ void ld8(const bf16* p, f32x4& v0, f32x4& v1) { const u32x4 w = *(const u32x4*)p; v0[0] = bflo(w.x); v0[1] = bfhi(w.x); v0[2] = bflo(w.y); v0[3] = bfhi(w.y); v1[0] = bflo(w.z); v1[1] = bfhi(w.z); v1[2] = bflo(w.w); v1[3] = bfhi(w.w); }
__device__ __forceinline__ float wave_sum(float v) {
#pragma unroll
    for (int o = 1; o < 64; o <<= 1) v += __shfl_xor(v, o);
    return v;
}

#define XB_TMO      128
#define XB_XCNT(j)  (256  + 64 * (j))
#define XB_XSUB(j)  (1280 + 64 * (j))
#define XB_XGEN(j)  (2304 + 64 * (j))
#define XB_TOP      3328
#define XB_TOPGEN   3392
#define XCD_BAR_WORDS 3456
#define XB_SPIN_CAP (1u << 18)

__device__ __forceinline__ unsigned xb_ld(unsigned* p)              { return __hip_atomic_load(p, __ATOMIC_RELAXED, __HIP_MEMORY_SCOPE_AGENT); }
__device__ __forceinline__ unsigned xb_add(unsigned* p, unsigned v) { return __hip_atomic_fetch_add(p, v, __ATOMIC_RELAXED, __HIP_MEMORY_SCOPE_AGENT); }
__device__ __forceinline__ unsigned xb_xcc_id() { return (unsigned)__builtin_amdgcn_s_getreg((3 << 11) | 20) & 0xFu; }
#define XB_SPIN(cond, bar) do { unsigned _sp = 0; while (cond) { __builtin_amdgcn_s_sleep(1); \
    if ((++_sp & 255u) == 0u) { if (xb_ld(&(bar)[XB_TMO])) break; if (_sp > XB_SPIN_CAP) { atomicAdd(&(bar)[XB_TMO], 1u); break; } } } } while (0)

struct XcdBarrier {
    unsigned* bar; unsigned x;
    volatile LAS unsigned* st;
};

__device__ __forceinline__ XcdBarrier xcd_barrier_post(unsigned* bar, volatile LAS unsigned* st) {
    XcdBarrier b; b.bar = bar; b.x = xb_xcc_id(); b.st = st;
    if (threadIdx.x == 0) (void)xb_add(&bar[XB_XCNT(b.x)], 1u);
    return b;
}
__device__ __forceinline__ void xcd_barrier_complete(unsigned* bar, unsigned x, unsigned& nloc, unsigned& nx) {
    const unsigned G = gridDim.x * gridDim.y * gridDim.z;
    unsigned sum, cnt, mine, sp = 0u;
    for (;;) {
        sum = 0u; cnt = 0u; mine = 0u;
#pragma unroll
        for (unsigned j = 0; j < 16; ++j) { const unsigned c = xb_ld(&bar[XB_XCNT(j)]); sum += c; cnt += (c > 0u) ? 1u : 0u; mine = (j == x) ? c : mine; }
        if (sum == G) break;
        __builtin_amdgcn_s_sleep(1);
        if ((++sp & 255u) == 0u) { if (xb_ld(&bar[XB_TMO])) break; if (sp > XB_SPIN_CAP) { atomicAdd(&bar[XB_TMO], 1u); break; } }
    }
    nloc = mine > 0u ? mine : 1u; nx = cnt > 0u ? cnt : 1u;
}

__device__ __forceinline__ void xcd_barrier(const XcdBarrier& b) {
    asm volatile("s_waitcnt vmcnt(0)" ::: "memory");
    __syncthreads();
    if (threadIdx.x == 0) {
        unsigned* bar = b.bar;
        __builtin_amdgcn_s_waitcnt(0);
        unsigned nloc = b.st[0], nx = b.st[1];
        if (nloc == 0u) { xcd_barrier_complete(bar, b.x, nloc, nx); b.st[0] = nloc; b.st[1] = nx; }
        const unsigned old = xb_add(&bar[XB_XSUB(b.x)], 1u);
        const unsigned gen = old / nloc;
        if (old + 1u == (gen + 1u) * nloc) {
            __builtin_amdgcn_fence(__ATOMIC_RELEASE, "agent");
            asm volatile("s_waitcnt vmcnt(0)" ::: "memory");
            const unsigned og = xb_add(&bar[XB_TOP], 1u);
            const unsigned tg = og / nx;
            if (og + 1u == (tg + 1u) * nx) xb_add(&bar[XB_TOPGEN], 1u);
            else XB_SPIN(xb_ld(&bar[XB_TOPGEN]) == tg, bar);
            __builtin_amdgcn_fence(__ATOMIC_ACQUIRE, "agent");
            xb_add(&bar[XB_XGEN(b.x)], 1u);
            asm volatile("s_waitcnt vmcnt(0)" ::: "memory");
        } else {
            XB_SPIN(xb_ld(&bar[XB_XGEN(b.x)]) == gen, bar);
            __builtin_amdgcn_fence(__ATOMIC_ACQUIRE, "agent");
            asm volatile("s_waitcnt vmcnt(0)" ::: "memory");
        }
    }
    __syncthreads();
}

struct Args { const float* in[27]; float* out; unsigned char* ws; int ph_lo, ph_hi; };
struct Ctx {
    LAS unsigned char* lds;
    int tid, lane, wave, G, bid;
    const CAS char* ka;
};
static_assert(sizeof(Args) == 240, "Args layout");
#define C_in(i) (*(const float* const CAS*)(C.ka + 8 * (i)))
#define C_out (*(float* const CAS*)(C.ka + 216))
#define C_ws (*(unsigned char* const CAS*)(C.ka + 224))
#define WSP(TY, off) ((TY*)(C_ws + (off)))
#define C_cosT WSP(float, WS_COS)
#define C_sinT WSP(float, WS_SIN)
#define C_ssqq WSP(float, WS_SSQQ)
#define C_ssqkv WSP(float, WS_SSQKV)
#define C_LP WSP(f32x2, WS_LP)
#define C_FB WSP(f32x2, WS_FB)
#define C_KD WSP(bf16, WS_KD)
#define C_MAT WSP(bf16, WS_MAT)
#define C_CCT WSP(bf16, WS_CCT)
#define C_XST WSP(bf16, WS_XST)
#define C_Win WSP(bf16, WS_W + WO_WIN)
#define C_Wuq WSP(bf16, WS_W + WO_WUQ)
#define C_Wukv WSP(bf16, WS_W + WO_WUKV)
#define C_Wo WSP(bf16, WS_W + WO_WO)
#define C_Wglu WSP(bf16, WS_W + WO_WGLU)
#define C_Wout WSP(bf16, WS_W + WO_WOUT)
#define C_Wgu WSP(bf16, WS_W + WO_WGU)
#define C_Wdn WSP(bf16, WS_W + WO_WDN)
#define C_RA WSP(bf16, WS_RA)
#define C_CQ WSP(bf16, WS_CQ)
#define C_CKV WSP(bf16, WS_CKV)
#define C_KPE WSP(bf16, WS_KPE)
#define C_U WSP(bf16, WS_U)
#define C_GA WSP(bf16, WS_GA)
#define C_GB WSP(bf16, WS_GB)
#define C_HID WSP(bf16, WS_HID)
#define C_Q WSP(bf16, WS_Q)
#define C_KV WSP(bf16, WS_KV)
#define C_Z WSP(bf16, WS_Z)
#define C_H2 WSP(bf16, WS_Q)
#define C_F WSP(bf16, WS_KV)
enum { I_X = 0, I_POS, I_PREMIX, I_WIN, I_BGATE, I_QNORM, I_KVNORM, I_WUQ, I_WUKV, I_WO, I_ARE, I_AIM, I_LOGDT, I_BRE, I_BIM, I_CRE, I_CIM, I_SSMD, I_WGLU, I_BGLU, I_WOUT, I_POSTMIX, I_PREFFN, I_WFG, I_WFU, I_WFD, I_POSTFFN };

using pg8::Unit;
#define EPI_HDR static constexpr bool PERM = true, AFTER_DRAIN = false;
#define EPI_ARGS const f32x4 (&acc)[2][2][4][2], const Unit& u, int wr, int wc, int fr, int fq
#define FOR_AI_M _Pragma("unroll") for (int ai = 0; ai < 2; ++ai) _Pragma("unroll") for (int m = 0; m < 4; ++m)

typedef __amdgpu_buffer_rsrc_t rsrc_t;
__device__ __forceinline__ rsrc_t mk_rsrc(const void* p, unsigned bytes) { return __builtin_amdgcn_make_buffer_rsrc((void*)p, (short)0, (int)bytes, 0x00020000); }
__device__ __forceinline__ void bst8(rsrc_t r, unsigned voff, unsigned soff, f32x4 v0, f32x4 v1) { u32x4 w; w.x = cvt_pk_bf16(v0[0], v0[1]); w.y = cvt_pk_bf16(v0[2], v0[3]); w.z = cvt_pk_bf16(v1[0], v1[1]); w.w = cvt_pk_bf16(v1[2], v1[3]); __builtin_amdgcn_raw_buffer_store_b128(w, r, voff + soff, 0, 0); }
__device__ __forceinline__ void bld8(rsrc_t r, unsigned voff, unsigned soff, f32x4& v0, f32x4& v1) { const u32x4 w = __builtin_amdgcn_raw_buffer_load_b128(r, voff, soff, 0); v0[0] = bflo(w.x); v0[1] = bfhi(w.x); v0[2] = bflo(w.y); v0[3] = bfhi(w.y); v1[0] = bflo(w.z); v1[1] = bfhi(w.z); v1[2] = bflo(w.w); v1[3] = bfhi(w.w); }
__device__ __forceinline__ f32x4 bldf4(rsrc_t r, unsigned voff, unsigned soff) { return __builtin_bit_cast(f32x4, __builtin_amdgcn_raw_buffer_load_b128(r, voff, soff, 0)); }
#define ROWG (ai * 128 + m * 16)
#define TILE_BYTES(PB) (255u * (PB) + (PB))

struct EpiInProj { EPI_HDR
    bf16 *CQ, *CKV, *KPE, *U, *GA, *GB; float *ssqq, *ssqkv; const float *bgate, *cosT, *sinT;
    __device__ __forceinline__ void operator()(EPI_ARGS) const {
        const int pn = u.pn, lr = wr * 64 + fr, cl = wc * 32 + 8 * fq; const size_t r0 = (size_t)u.pm * 256;
        if (pn < 2) {
            const rsrc_t rb = mk_rsrc(CQ + r0 * QL + pn * 256, TILE_BYTES(QL * 2)), rq = mk_rsrc(ssqq + r0 * 8, 256 * 32);
            const unsigned vo = (unsigned)(lr * QL + cl) * 2u, vs = (unsigned)(lr * 8 + pn * 4 + wc) * 4u;
            FOR_AI_M { float s = 0.f;
#pragma unroll
                for (int bj = 0; bj < 2; ++bj) { const f32x4 v0 = acc[ai][bj][m][0], v1 = acc[ai][bj][m][1];
                    s += (v0[0] * v0[0] + v0[1] * v0[1]) + (v0[2] * v0[2] + v0[3] * v0[3]) + (v1[0] * v1[0] + v1[1] * v1[1]) + (v1[2] * v1[2] + v1[3] * v1[3]);
                    bst8(rb, vo, ROWG * QL * 2 + bj * 256, v0, v1); }
                s += __shfl_xor(s, 16); s += __shfl_xor(s, 32);
                if (fq == 0) __builtin_amdgcn_raw_buffer_store_b32(__float_as_uint(s), rq, vs + ROWG * 32, 0, 0); }
        } else if (pn == 2) {
            const rsrc_t rb = mk_rsrc(CKV + r0 * KVL, TILE_BYTES(KVL * 2)), rq = mk_rsrc(ssqkv + r0 * 4, 256 * 16);
            const unsigned vo = (unsigned)(lr * KVL + cl) * 2u, vs = (unsigned)(lr * 4 + wc) * 4u;
            FOR_AI_M { float s = 0.f;
#pragma unroll
                for (int bj = 0; bj < 2; ++bj) { const f32x4 v0 = acc[ai][bj][m][0], v1 = acc[ai][bj][m][1];
                    s += (v0[0] * v0[0] + v0[1] * v0[1]) + (v0[2] * v0[2] + v0[3] * v0[3]) + (v1[0] * v1[0] + v1[1] * v1[1]) + (v1[2] * v1[2] + v1[3] * v1[3]);
                    bst8(rb, vo, ROWG * KVL * 2 + bj * 256, v0, v1); }
                s += __shfl_xor(s, 16); s += __shfl_xor(s, 32);
                if (fq == 0) __builtin_amdgcn_raw_buffer_store_b32(__float_as_uint(s), rq, vs + ROWG * 16, 0, 0); }
        } else if (pn < 7) {
            const rsrc_t rb = mk_rsrc(U + r0 * SW + (pn - 3) * 256, TILE_BYTES(SW * 2)); const unsigned vo = (unsigned)(lr * SW + cl) * 2u;
            FOR_AI_M {
#pragma unroll
                for (int bj = 0; bj < 2; ++bj) bst8(rb, vo, ROWG * SW * 2 + bj * 256, acc[ai][bj][m][0], acc[ai][bj][m][1]); }
        } else if (pn < 23) {
            const int colt = (pn - (pn < 15 ? 7 : 15)) * 256;
            const rsrc_t rb = mk_rsrc((pn < 15 ? GA : GB) + r0 * DM + colt, TILE_BYTES(DM * 2)); const unsigned vo = (unsigned)(lr * DM + cl) * 2u;
            const float* bb = bgate + (pn < 15 ? 0 : DM) + colt + cl;
            f32x4 bv[2][2];
#pragma unroll
            for (int bj = 0; bj < 2; ++bj) { bv[bj][0] = *(const f32x4*)(bb + bj * 128); bv[bj][1] = *(const f32x4*)(bb + bj * 128 + 4); }
            FOR_AI_M {
#pragma unroll
                for (int bj = 0; bj < 2; ++bj) { f32x4 v0 = acc[ai][bj][m][0] + bv[bj][0], v1 = acc[ai][bj][m][1] + bv[bj][1];
#pragma unroll
                    for (int e = 0; e < 4; ++e) { v0[e] = sigm(v0[e]); v1[e] = sigm(v1[e]); }
#ifdef DBG_PLAINGATE
                    v0 = acc[ai][bj][m][0]; v1 = acc[ai][bj][m][1];
#endif
#ifdef DBG_BIASONLY
#pragma unroll
                    for (int e = 0; e < 4; ++e) { float t0 = acc[ai][bj][m][0][e] + bv[bj][0][e], t1 = acc[ai][bj][m][1][e] + bv[bj][1][e]; asm volatile("" : "+v"(t0), "+v"(t1)); v0[e] = t0; v1[e] = t1; }
#endif
                    bst8(rb, vo, ROWG * DM * 2 + bj * 256, v0, v1); } }
        } else if (wc == 0) {
            const rsrc_t rb = mk_rsrc(KPE + r0 * 64, 256 * 128), rc = mk_rsrc(cosT + r0 * 32, 256 * 128), rs_ = mk_rsrc(sinT + r0 * 32, 256 * 128);
            const unsigned vo = (unsigned)(lr * 64 + 8 * fq) * 2u, vt = (unsigned)(lr * 32 + 8 * fq) * 4u;
            FOR_AI_M {
                const f32x4 c0 = bldf4(rc, vt, ROWG * 128), c1 = bldf4(rc, vt, ROWG * 128 + 16), s0 = bldf4(rs_, vt, ROWG * 128), s1 = bldf4(rs_, vt, ROWG * 128 + 16);
                const f32x4 x10 = acc[ai][0][m][0], x11 = acc[ai][0][m][1], x20 = acc[ai][1][m][0], x21 = acc[ai][1][m][1];
                bst8(rb, vo, ROWG * 128, x10 * c0 - x20 * s0, x11 * c1 - x21 * s1);
                bst8(rb, vo, ROWG * 128 + 64, x10 * s0 + x20 * c0, x11 * s1 + x21 * c1);
                asm volatile("" ::: "memory"); }
        }
    }
};
struct EpiQ { EPI_HDR
    bf16* Q; const float *ssqq, *cosT, *sinT;
    __device__ __forceinline__ void operator()(EPI_ARGS) const {
        constexpr int PQ = NH * DQK * 2;
        const int pn = u.pn, lr = wr * 64 + fr, cl = wc * 32 + 8 * fq; const size_t r0 = (size_t)u.pm * 256;
        const rsrc_t rq = mk_rsrc(ssqq + r0 * 8, 256 * 32), rb = mk_rsrc(Q + r0 * (NH * DQK), TILE_BYTES(PQ));
        const unsigned vs = (unsigned)lr * 32u;
        if (pn < 8) {
            const unsigned vo = (unsigned)lr * PQ + (unsigned)(2 * pn * DQK + cl) * 2u;
            FOR_AI_M { const f32x4 sa = bldf4(rq, vs, ROWG * 32), sb = bldf4(rq, vs, ROWG * 32 + 16);
                const float rs = rsqrtf((((sa[0] + sa[1]) + (sa[2] + sa[3])) + ((sb[0] + sb[1]) + (sb[2] + sb[3]))) * (1.0f / QL) + EPS) * QSCALE;
#pragma unroll
                for (int bj = 0; bj < 2; ++bj) bst8(rb, vo, ROWG * PQ + bj * DQK * 2, acc[ai][bj][m][0] * rs, acc[ai][bj][m][1] * rs);
                asm volatile("" ::: "memory"); }
        } else {
            const rsrc_t rc = mk_rsrc(cosT + r0 * 32, 256 * 128), rs_ = mk_rsrc(sinT + r0 * 32, 256 * 128);
            const unsigned vo = (unsigned)lr * PQ + (unsigned)((4 * (pn - 8) + wc) * DQK + 128 + 8 * fq) * 2u, vt = (unsigned)(lr * 32 + 8 * fq) * 4u;
            FOR_AI_M { const f32x4 sa = bldf4(rq, vs, ROWG * 32), sb = bldf4(rq, vs, ROWG * 32 + 16);
                const float rs = rsqrtf((((sa[0] + sa[1]) + (sa[2] + sa[3])) + ((sb[0] + sb[1]) + (sb[2] + sb[3]))) * (1.0f / QL) + EPS) * QSCALE;
                const f32x4 c0 = bldf4(rc, vt, ROWG * 128) * rs, c1 = bldf4(rc, vt, ROWG * 128 + 16) * rs, s0 = bldf4(rs_, vt, ROWG * 128) * rs, s1 = bldf4(rs_, vt, ROWG * 128 + 16) * rs;
                const f32x4 x10 = acc[ai][0][m][0], x11 = acc[ai][0][m][1], x20 = acc[ai][1][m][0], x21 = acc[ai][1][m][1];
                bst8(rb, vo, ROWG * PQ, x10 * c0 - x20 * s0, x11 * c1 - x21 * s1);
                bst8(rb, vo, ROWG * PQ + 64, x10 * s0 + x20 * c0, x11 * s1 + x21 * c1);
                asm volatile("" ::: "memory"); }
        }
    }
};
struct EpiKV { EPI_HDR
    bf16* KV; const float* ssqkv;
    __device__ __forceinline__ void operator()(EPI_ARGS) const {
        const int lr = wr * 64 + fr, cl = wc * 32 + 8 * fq; const size_t r0 = (size_t)u.pm * 256;
        const rsrc_t rq = mk_rsrc(ssqkv + r0 * 4, 256 * 16), rb = mk_rsrc(KV + r0 * 4096 + u.pn * 256, TILE_BYTES(8192));
        const unsigned vs = (unsigned)lr * 16u, vo = (unsigned)(lr * 4096 + cl) * 2u;
        FOR_AI_M { const f32x4 sa = bldf4(rq, vs, ROWG * 16);
            const float rs = rsqrtf(((sa[0] + sa[1]) + (sa[2] + sa[3])) * (1.0f / KVL) + EPS);
#pragma unroll
            for (int bj = 0; bj < 2; ++bj) bst8(rb, vo, ROWG * 8192 + bj * 256, acc[ai][bj][m][0] * rs, acc[ai][bj][m][1] * rs);
            asm volatile("" ::: "memory"); }
    }
};
struct EpiWo { EPI_HDR
    bf16* GA;
    __device__ __forceinline__ void operator()(EPI_ARGS) const {
        const int lr = wr * 64 + fr, cl = wc * 32 + 8 * fq; const size_t r0 = (size_t)u.pm * 256;
        const rsrc_t rb = mk_rsrc(GA + r0 * DM + u.pn * 256, TILE_BYTES(DM * 2)); const unsigned vo = (unsigned)(lr * DM + cl) * 2u;
        FOR_AI_M {
#pragma unroll
            for (int bj = 0; bj < 2; ++bj) { f32x4 g0, g1; bld8(rb, vo, ROWG * DM * 2 + bj * 256, g0, g1); bst8(rb, vo, ROWG * DM * 2 + bj * 256, g0 * acc[ai][bj][m][0], g1 * acc[ai][bj][m][1]); }
            asm volatile("" ::: "memory"); }
    }
};
struct EpiGlu { EPI_HDR
    bf16 *GA, *GB; const float* bglu;
    __device__ __forceinline__ void operator()(EPI_ARGS) const {
        const int lr = wr * 64 + fr, j0 = u.pn * 128 + wc * 32 + 8 * fq; const size_t r0 = (size_t)u.pm * 256;
        const rsrc_t ra = mk_rsrc(GA + r0 * DM, TILE_BYTES(DM * 2)), rb = mk_rsrc(GB + r0 * DM, TILE_BYTES(DM * 2)); const unsigned vo = (unsigned)(lr * DM + j0) * 2u;
        const f32x4 bv0 = *(const f32x4*)(bglu + j0), bv1 = *(const f32x4*)(bglu + j0 + 4), bg0 = *(const f32x4*)(bglu + DM + j0), bg1 = *(const f32x4*)(bglu + DM + j0 + 4);
        FOR_AI_M {
            f32x4 v0 = acc[ai][0][m][0] + bv0, v1 = acc[ai][0][m][1] + bv1, g0 = acc[ai][1][m][0] + bg0, g1 = acc[ai][1][m][1] + bg1;
#pragma unroll
            for (int e = 0; e < 4; ++e) { v0[e] *= sigm(g0[e]); v1[e] *= sigm(g1[e]); }
            f32x4 m0, m1, q0, q1; bld8(ra, vo, ROWG * DM * 2, m0, m1); bld8(rb, vo, ROWG * DM * 2, q0, q1);
            bst8(ra, vo, ROWG * DM * 2, m0 + q0 * v0, m1 + q1 * v1);
            asm volatile("" ::: "memory"); }
    }
};
struct EpiPlain { EPI_HDR
    bf16* O;
    __device__ __forceinline__ void operator()(EPI_ARGS) const {
        const int lr = wr * 64 + fr, cl = wc * 32 + 8 * fq; const size_t r0 = (size_t)u.pm * 256;
        const rsrc_t rb = mk_rsrc(O + r0 * DM + u.pn * 256, TILE_BYTES(DM * 2)); const unsigned vo = (unsigned)(lr * DM + cl) * 2u;
        FOR_AI_M {
#pragma unroll
            for (int bj = 0; bj < 2; ++bj) bst8(rb, vo, ROWG * DM * 2 + bj * 256, acc[ai][bj][m][0], acc[ai][bj][m][1]); }
    }
};
struct EpiSwiGlu { EPI_HDR
    bf16* HID;
    __device__ __forceinline__ void operator()(EPI_ARGS) const {
        const int lr = wr * 64 + fr, j0 = u.pn * 128 + wc * 32 + 8 * fq; const size_t r0 = (size_t)u.pm * 256;
        const rsrc_t rb = mk_rsrc(HID + r0 * FF, TILE_BYTES(FF * 2)); const unsigned vo = (unsigned)(lr * FF + j0) * 2u;
        FOR_AI_M {
            f32x4 g0 = acc[ai][0][m][0], g1 = acc[ai][0][m][1];
#pragma unroll
            for (int e = 0; e < 4; ++e) { g0[e] *= sigm(g0[e]); g1[e] *= sigm(g1[e]); }
            bst8(rb, vo, ROWG * FF * 2, g0 * acc[ai][1][m][0], g1 * acc[ai][1][m][1]); }
    }
};

template <class Epi> __device__ __forceinline__ void run_gemm(Ctx& C, const bf16* A, const bf16* Bt, int N, int K, const Epi& E) {
    int Kv = K, Nv = N; asm volatile("" : "+s"(Kv), "+s"(Nv));
    pg8::Gemm g{A, Bt, T, Nv, Kv}; pg8::StaticOrder S; S.init(T, Nv, C.G, C.bid);
    pg8::gemm_phase<Epi, pg8::StaticOrder, MK_ALIGN, true>(C.lds, g, S, E);
}

__device__ __forceinline__ void row_pass(const float* xin, const bf16* delta, const float* wpost, float* xout, const float* wpre, bf16* hout, int lane) {
    f32x4 x[8];
#pragma unroll
    for (int j = 0; j < 8; ++j) x[j] = ((const f32x4*)xin)[64 * j + lane];
    if (delta) {
        f32x4 d[8]; float s = 0.f;
#pragma unroll
        for (int j = 0; j < 8; ++j) { const u32x2 w = ((const u32x2*)delta)[64 * j + lane]; d[j] = (f32x4){bflo(w.x), bfhi(w.x), bflo(w.y), bfhi(w.y)};
            s += (d[j][0] * d[j][0] + d[j][1] * d[j][1]) + (d[j][2] * d[j][2] + d[j][3] * d[j][3]); }
        const float rs = rsqrtf(wave_sum(s) * (1.0f / DM) + EPS);
#pragma unroll
        for (int j = 0; j < 8; ++j) { const f32x4 w = ((const f32x4*)wpost)[64 * j + lane]; x[j] = x[j] + d[j] * rs * w; }
        if (xout) {
#pragma unroll
            for (int j = 0; j < 8; ++j) ((f32x4*)xout)[64 * j + lane] = x[j]; }
    }
    if (hout) {
        float s = 0.f;
#pragma unroll
        for (int j = 0; j < 8; ++j) s += (x[j][0] * x[j][0] + x[j][1] * x[j][1]) + (x[j][2] * x[j][2] + x[j][3] * x[j][3]);
        const float rs = rsqrtf(wave_sum(s) * (1.0f / DM) + EPS);
#pragma unroll
        for (int j = 0; j < 8; ++j) { const f32x4 w = ((const f32x4*)wpre)[64 * j + lane]; const f32x4 h = x[j] * rs * w;
            u32x2 o; o.x = cvt_pk_bf16(h[0], h[1]); o.y = cvt_pk_bf16(h[2], h[3]); ((u32x2*)hout)[64 * j + lane] = o; }
    }
}

__device__ __forceinline__ void tr_item(const float* src, int lds_, bf16* dst, int ldd, const float* ksc, LAS float* scr, int lane) {
#pragma unroll 8
    for (int i = 0; i < 32; ++i) { const int kk = 2 * i + (lane >> 5); float v = src ? src[(size_t)kk * lds_ + (lane & 31)] : 0.f; if (ksc) v *= ksc[kk]; scr[kk * 33 + (lane & 31)] = v; }
    LDS_WAIT(); asm volatile("" ::: "memory");
    const int c = lane & 7;
#pragma unroll
    for (int j = 0; j < 4; ++j) { const int n = (lane >> 3) + 8 * j; const LAS float* s = scr + (8 * c) * 33 + n;
        u32x4 o; o.x = pk2(s[0 * 33], s[1 * 33]); o.y = pk2(s[2 * 33], s[3 * 33]); o.z = pk2(s[4 * 33], s[5 * 33]); o.w = pk2(s[6 * 33], s[7 * 33]);
        *(u32x4*)(dst + (size_t)n * ldd + 8 * c) = o; }
    LDS_WAIT(); asm volatile("" ::: "memory");
}
constexpr int IT_WIN = 32 * 192, IT_WUQ = 8 * 96, IT_WUKV = 4 * 128, IT_WO = 32 * 64, IT_WGLU = 16 * 128, IT_WOUT = 32 * 64, IT_WGU = 32 * 352, IT_WDN = 88 * 64;
constexpr int IT_ALL = IT_WIN + IT_WUQ + IT_WUKV + IT_WO + IT_WGLU + IT_WOUT + IT_WGU + IT_WDN;
__device__ __forceinline__ void convert_weights(Ctx& C, int l) {
    LAS float* scr = (LAS float*)(C.lds + C.wave * 16384);
    const int gw = C.bid * NWAVES + C.wave, NGW = C.G * NWAVES, lane = C.lane;
    for (int it = gw; it < IT_ALL; it += NGW) {
        int r = it;
        if (r < IT_WIN) { const int kb = r / 192, nb = r % 192, n0 = nb * 32, k0 = kb * 64; int sc = -1;
            if (n0 < 768) sc = n0; else if (n0 < 5888) sc = n0 + 64; else if (n0 == 5888) sc = 768; else if (n0 == 5888 + 128) sc = 800;
            const float* W = C_in(I_WIN) + (size_t)l * DM * INW;
            tr_item(sc >= 0 ? W + (size_t)k0 * INW + sc : nullptr, INW, C_Win + (size_t)n0 * DM + k0, DM, nullptr, scr, lane); continue; } r -= IT_WIN;
        if (r < IT_WUQ) { const int kb = r / 96, nb = r % 96, n0 = nb * 32, k0 = kb * 64; int sc;
            if (n0 < 2048) sc = (n0 >> 7) * DQK + (n0 & 127); else { const int rr = n0 - 2048, t = rr >> 8, c = rr & 255, bj = c >> 7, hh = (c & 127) >> 5; sc = (4 * t + hh) * DQK + 128 + bj * 32; }
            const float* W = C_in(I_WUQ) + (size_t)l * QL * (NH * DQK);
            tr_item(W + (size_t)k0 * (NH * DQK) + sc, NH * DQK, C_Wuq + (size_t)n0 * QL + k0, QL, C_in(I_QNORM) + l * QL + k0, scr, lane); continue; } r -= IT_WUQ;
        if (r < IT_WUKV) { const int kb = r / 128, nb = r % 128, n0 = nb * 32, k0 = kb * 64;
            const float* W = C_in(I_WUKV) + (size_t)l * KVL * 4096;
            tr_item(W + (size_t)k0 * 4096 + n0, 4096, C_Wukv + (size_t)n0 * KVL + k0, KVL, C_in(I_KVNORM) + l * KVL + k0, scr, lane); continue; } r -= IT_WUKV;
        if (r < IT_WO) { const int kb = r / 64, nb = r % 64, n0 = nb * 32, k0 = kb * 64;
            const float* W = C_in(I_WO) + (size_t)l * DM * DM;
            tr_item(W + (size_t)k0 * DM + n0, DM, C_Wo + (size_t)n0 * DM + k0, DM, nullptr, scr, lane); continue; } r -= IT_WO;
        if (r < IT_WGLU) { const int kb = r / 128, nb = r % 128, n0 = nb * 32, k0 = kb * 64; const int t = n0 >> 8, bj = (n0 >> 7) & 1, i0 = n0 & 127;
            const float* W = C_in(I_WGLU) + (size_t)l * SW * 4096;
            tr_item(W + (size_t)k0 * 4096 + bj * DM + t * 128 + i0, 4096, C_Wglu + (size_t)n0 * SW + k0, SW, nullptr, scr, lane); continue; } r -= IT_WGLU;
        if (r < IT_WOUT) { const int kb = r / 64, nb = r % 64, n0 = nb * 32, k0 = kb * 64;
            const float* W = C_in(I_WOUT) + (size_t)l * DM * DM;
            tr_item(W + (size_t)k0 * DM + n0, DM, C_Wout + (size_t)n0 * DM + k0, DM, nullptr, scr, lane); continue; } r -= IT_WOUT;
        if (r < IT_WGU) { const int kb = r / 352, nb = r % 352, n0 = nb * 32, k0 = kb * 64; const int t = n0 >> 8, bj = (n0 >> 7) & 1, i0 = n0 & 127;
            const float* W = (bj ? C_in(I_WFU) : C_in(I_WFG)) + (size_t)l * DM * FF;
            tr_item(W + (size_t)k0 * FF + t * 128 + i0, FF, C_Wgu + (size_t)n0 * DM + k0, DM, nullptr, scr, lane); continue; } r -= IT_WGU;
        { const int kb = r / 64, nb = r % 64, n0 = nb * 32, k0 = kb * 64;
            const float* W = C_in(I_WFD) + (size_t)l * FF * DM;
            tr_item(W + (size_t)k0 * DM + n0, DM, C_Wdn + (size_t)n0 * FF + k0, FF, nullptr, scr, lane); }
    }
}

__device__ __forceinline__ void rope_tables(Ctx& C) {
    const int* pos = (const int*)C_in(I_POS); float* cT = C_cosT; float* sT = C_sinT;
    for (int i = C.bid * 512 + C.tid; i < T * 32; i += C.G * 512) { const int row = i >> 5, k = i & 31;
        const float inv = __builtin_amdgcn_exp2f(-(float)k * (13.287712379549449f / 32.0f));
        const float ang = (float)pos[row] * inv;
        cT[i] = cosf(ang); sT[i] = sinf(ang); }
}
__device__ __forceinline__ void ssm_lp(Ctx& C, int l) {
    const float* are = C_in(I_ARE) + l * SG * SN; const float* aim = C_in(I_AIM) + l * SG * SN; const float* ldt = C_in(I_LOGDT) + l * SG; f32x2* LPp = C_LP; f32x2* FBp = C_FB;
    for (int i = C.bid * 512 + C.tid; i < SG * 65 * SN; i += C.G * 512) { const int n = i & 63, d = (i >> 6) % 65, g = i / (65 * 64);
        const float dt = expf(ldt[g]), ar = are[g * SN + n], ai = aim[g * SN + n];
        const float e = expf((float)d * (ar * dt)), ang = (float)d * (ai * dt); const float s = sinf(ang), c = cosf(ang);
        LPp[i] = (f32x2){e * c, e * s};
        if (d == 1) { const float lr = e * c, li = e * s, nr = lr - 1.0f, den = ar * ar + ai * ai;
            FBp[g * SN + n] = (f32x2){(nr * ar + li * ai) / den, (li * ar - nr * ai) / den}; } }
}
__device__ __forceinline__ void ssm_tables(Ctx& C, int l) {
    const float* bre = C_in(I_BRE) + (size_t)l * SG * SN * SP; const float* bim = C_in(I_BIM) + (size_t)l * SG * SN * SP;
    const float* cre = C_in(I_CRE) + (size_t)l * SG * SP * SN; const float* cim = C_in(I_CIM) + (size_t)l * SG * SP * SN;
    const int gt = C.bid * 512 + C.tid, NT_ = C.G * 512;
    for (int i = gt; i < SG * 65 * 256; i += NT_) { const int pp = i & 15, p = (i >> 4) & 15, dd = (i >> 8) % 65, g = i / (65 * 256); float sum = 0.f;
        if (dd > 0) { const f32x2* lp = C_LP + (size_t)(g * 65 + dd - 1) * 64; const f32x2* fb = C_FB + g * SN;
            for (int n = 0; n < SN; ++n) { const f32x2 L = lp[n], f = fb[n]; const float br = bre[(g * SN + n) * SP + pp], bi = bim[(g * SN + n) * SP + pp];
                const float Br = f.x * br - f.y * bi, Bi = f.x * bi + f.y * br, wr_ = L.x * Br - L.y * Bi, wi_ = L.x * Bi + L.y * Br;
                sum += cre[(g * SP + p) * SN + n] * wr_ - cim[(g * SP + p) * SN + n] * wi_; } }
        C_KD[i] = (bf16)f2bf(sum); }
    for (int i = gt; i < SG * 64 * 128; i += NT_) { const int ncol = i & 127, j = (i >> 7) & 63, g = i >> 13, n = ncol & 63, part = ncol >> 6;
        const f32x2 L = C_LP[(size_t)(g * 65 + 63 - j) * 64 + n], f = C_FB[g * SN + n]; float o[16];
#pragma unroll
        for (int pp = 0; pp < 16; ++pp) { const float br = bre[(g * SN + n) * SP + pp], bi = bim[(g * SN + n) * SP + pp];
            const float Br = f.x * br - f.y * bi, Bi = f.x * bi + f.y * br; o[pp] = part ? (L.x * Bi + L.y * Br) : (L.x * Br - L.y * Bi); }
        u32x4 w0, w1; w0.x = pk2(o[0], o[1]); w0.y = pk2(o[2], o[3]); w0.z = pk2(o[4], o[5]); w0.w = pk2(o[6], o[7]); w1.x = pk2(o[8], o[9]); w1.y = pk2(o[10], o[11]); w1.z = pk2(o[12], o[13]); w1.w = pk2(o[14], o[15]);
        u32x4* dst = (u32x4*)(C_MAT + (size_t)i * 16); dst[0] = w0; dst[1] = w1; }
    for (int i = gt; i < SG * 8 * 1024; i += NT_) { const int p = i & 15, j = (i >> 4) & 63, kk = (i >> 10) & 7, g = i >> 13; float o[16];
#pragma unroll
        for (int k = 0; k < 16; ++k) { const int kq = kk * 16 + k, n = kq & 63, part = kq >> 6; const f32x2 L = C_LP[(size_t)(g * 65 + j + 1) * 64 + n];
            const float cr = cre[(g * SP + p) * SN + n], ci = cim[(g * SP + p) * SN + n]; o[k] = part ? -(cr * L.y + ci * L.x) : (cr * L.x - ci * L.y); }
        u32x4 w0, w1; w0.x = pk2(o[0], o[1]); w0.y = pk2(o[2], o[3]); w0.z = pk2(o[4], o[5]); w0.w = pk2(o[6], o[7]); w1.x = pk2(o[8], o[9]); w1.y = pk2(o[10], o[11]); w1.z = pk2(o[12], o[13]); w1.w = pk2(o[14], o[15]);
        u32x4* dst = (u32x4*)(C_CCT + (size_t)i * 16); dst[0] = w0; dst[1] = w1; }
}

__device__ __forceinline__ int crow(int r, int hi) { return (r & 3) + 8 * (r >> 2) + 4 * hi; }
__device__ __forceinline__ f32x16 mfma32(bf16x8 a, bf16x8 b, f32x16 c) { return __builtin_amdgcn_mfma_f32_32x32x16_bf16(a, b, c, 0, 0, 0); }
__device__ __forceinline__ void ssm_states(Ctx& C) {
    const int lane = C.lane, r32 = lane & 31, hi = lane >> 5, mt = C.wave >> 2, nblk = C.wave & 3;
    LAS float* SL = (LAS float*)C.lds;
    for (int unit = C.bid; unit < SG * BATCH; unit += C.G) { const int g = unit >> 3, b = unit & 7;
        f32x16 acc = {};
        const bf16* ap = C_U + ((size_t)(b * SEQ + (32 * mt + r32) * 64)) * SW + g * 16 + hi * 8;
        const bf16* bp = C_MAT + ((size_t)(g * 64) * 128 + nblk * 32 + r32) * 16 + hi * 8;
#pragma unroll 8
        for (int j = 0; j < 64; ++j) { const bf16x8 a = *(const bf16x8*)(ap + (size_t)j * SW), bb = *(const bf16x8*)(bp + (size_t)j * 128 * 16); acc = mfma32(a, bb, acc); }
#pragma unroll
        for (int r = 0; r < 16; ++r) SL[(32 * mt + crow(r, hi)) * 128 + 32 * nblk + r32] = acc[r];
        LDS_WAIT(); __syncthreads();
        if (C.tid < 64) { const int n = C.tid; const f32x2 lam = C_LP[(size_t)(g * 65 + 64) * 64 + n]; float xr = 0.f, xi = 0.f;
            bf16* xp = C_XST + ((size_t)(b * 64) * 64 + g) * 128 + n;
            for (int c = 0; c < 64; ++c) { xp[(size_t)c * 64 * 128] = (bf16)f2bf(xr); xp[(size_t)c * 64 * 128 + 64] = (bf16)f2bf(xi);
                const float sr = SL[c * 128 + n], si = SL[c * 128 + 64 + n]; const float nr = lam.x * xr - lam.y * xi + sr, ni = lam.x * xi + lam.y * xr + si; xr = nr; xi = ni; } }
        LDS_WAIT(); __syncthreads();
    }
}
__device__ __forceinline__ float gelu_tanh(float y) { return y * sigm(1.5957691216057308f * (y + 0.044715f * y * y * y)); }
__device__ __forceinline__ void ssm_outputs(Ctx& C, int l) {
    const int lane = C.lane, r32 = lane & 31, hi = lane >> 5, half = C.wave & 1;
    const float* dsk = C_in(I_SSMD) + l * SW;
    for (int unit = C.bid; unit < 16 * 16; unit += C.G) { const int gb = unit >> 4, mt = unit & 15, g = 4 * gb + (C.wave >> 1), b = mt >> 1, c0 = 32 * (mt & 1);
        const bf16* up = C_U + ((size_t)(b * SEQ + (c0 + r32) * 64)) * SW + g * 16 + hi * 8;
        const bf16* xp = C_XST + ((size_t)((b * 64 + c0 + r32) * 64 + g)) * 128 + hi * 8;
        const bf16* kd = C_KD + (size_t)g * (65 * 256) + r32 * 16 + hi * 8;
        const bf16* cc = C_CCT + ((size_t)(g * 8) * 1024 + r32) * 16 + hi * 8;
        for (int s2 = 0; s2 < 2; ++s2) { const int sp = half ? (2 - s2) : (s2 ? 0 : 3);
            f32x16 acc[8];
#pragma unroll
            for (int nb = 0; nb < 8; ++nb) acc[nb] = (f32x16){};
#pragma unroll 2
            for (int kk = 0; kk < 8; ++kk) { const bf16x8 a = *(const bf16x8*)(xp + kk * 16);
#pragma unroll
                for (int nb = 0; nb < 8; ++nb) { const bf16x8 bb = *(const bf16x8*)(cc + ((size_t)kk * 1024 + (16 * sp + 2 * nb) * 16) * 16); acc[nb] = mfma32(a, bb, acc[nb]); } }
            const int iend = 16 * sp + 15;
            for (int i = 0; i <= iend; ++i) { const bf16x8 a = *(const bf16x8*)(up + (size_t)i * SW);
#pragma unroll
                for (int nb = 0; nb < 8; ++nb) { const int d = 16 * sp + 2 * nb - i;
                    if (d >= -1) { const bf16x8 bb = *(const bf16x8*)(kd + (d + 1) * 256); acc[nb] = mfma32(a, bb, acc[nb]); } } }
            const int p = r32 & 15, toff = r32 >> 4; const float dv = dsk[g * 16 + p];
#pragma unroll
            for (int nb = 0; nb < 8; ++nb)
#pragma unroll
                for (int r = 0; r < 16; ++r) { const size_t tok = (size_t)(b * SEQ + (c0 + crow(r, hi)) * 64 + 16 * sp + 2 * nb + toff); const size_t off = tok * SW + g * 16 + p;
                    const float uu = bflo((unsigned)C_U[off]); const float y = acc[nb][r] + dv * uu; C_Z[off] = (bf16)f2bf(gelu_tanh(y)); }
        }
    }
}

namespace att {
constexpr int LDQ = NH * DQK, LDKV = 4096, LDO = DM;
constexpr int SHM_V = 16384, SHM_K = 16384, SHM_KP = 8192;
constexpr int OFF_V = 0, OFF_K = 2 * SHM_V, OFF_KP = OFF_K + 2 * SHM_K, OFF_WS = OFF_KP + 2 * SHM_KP, ATT_LDS = OFF_WS + NWAVES * 64 * 4;
constexpr float THRL = 11.5f;
#define KSWZ(row, colB) ((row) * 256 + ((colB) ^ (((row) & 7) << 4)))
#define KPSWZ(row, colB) ((row) * 128 + ((colB) ^ (((row) & 7) << 4)))
#define SBAR() __builtin_amdgcn_sched_barrier(0)
__device__ __forceinline__ void partialSM(f32x16& p0, f32x16& p1, float& m_reg, float& mn, float& alpha, bool dead) {
    if (dead) {
#pragma unroll
        for (int r = 0; r < 16; ++r) { p0[r] = -1e30f; p1[r] = -1e30f; } }
    float pmax = p0[0];
#pragma unroll
    for (int r = 1; r < 16; ++r) pmax = fmaxf(pmax, p0[r]);
#pragma unroll
    for (int r = 0; r < 16; ++r) pmax = fmaxf(pmax, p1[r]);
    { auto rr = __builtin_amdgcn_permlane32_swap(__float_as_uint(pmax), __float_as_uint(pmax), false, false); pmax = fmaxf(__uint_as_float(rr[0]), __uint_as_float(rr[1])); }
    if (__builtin_expect(__all(pmax - m_reg <= THRL), 1)) { mn = m_reg; alpha = 1.f; }
    else { mn = fmaxf(m_reg, pmax); alpha = __builtin_amdgcn_exp2f(m_reg - mn); m_reg = mn; }
#pragma unroll
    for (int r = 0; r < 16; ++r) p0[r] = p0[r] - mn;
#pragma unroll
    for (int r = 0; r < 16; ++r) p1[r] = p1[r] - mn;
#pragma unroll
    for (int r = 0; r < 16; ++r) p0[r] = __builtin_amdgcn_exp2f(p0[r]);
}
__device__ __forceinline__ void finishSM(f32x16& p0, f32x16& p1, float alpha, float& l_reg, bf16x8& pa0, bf16x8& pa1, bf16x8& pa2, bf16x8& pa3) {
#pragma unroll
    for (int r = 0; r < 16; ++r) p1[r] = __builtin_amdgcn_exp2f(p1[r]);
    float ps = 0;
#pragma unroll
    for (int r = 0; r < 16; ++r) ps += p0[r];
#pragma unroll
    for (int r = 0; r < 16; ++r) ps += p1[r];
    { auto rr = __builtin_amdgcn_permlane32_swap(__float_as_uint(ps), __float_as_uint(ps), false, false); ps = __uint_as_float(rr[0]) + __uint_as_float(rr[1]); }
    l_reg = l_reg * alpha + ps;
#define PK4(P, BASE, OUT) do { unsigned a0 = cvt_pk_bf16(P[BASE + 0], P[BASE + 1]), a1 = cvt_pk_bf16(P[BASE + 2], P[BASE + 3]);   \
    unsigned b0 = cvt_pk_bf16(P[BASE + 4], P[BASE + 5]), b1 = cvt_pk_bf16(P[BASE + 6], P[BASE + 7]);                              \
    auto r0 = __builtin_amdgcn_permlane32_swap(a0, b0, false, false); auto r1 = __builtin_amdgcn_permlane32_swap(a1, b1, false, false); \
    u32x4 w = {r0[0], r1[0], r0[1], r1[1]}; OUT = *reinterpret_cast<bf16x8*>(&w); } while (0)
    PK4(p0, 0, pa0); PK4(p0, 8, pa1); PK4(p1, 0, pa2); PK4(p1, 8, pa3);
#undef PK4
}
__device__ __forceinline__ void qkt(f32x16& p0, f32x16& p1, const LAS char* Ks, const LAS char* KPs, const bf16x8* qr, int r32, int hi) {
    p0 = f32x16{}; p1 = f32x16{};
#pragma unroll
    for (int d0 = 0; d0 < 8; ++d0) { const int cb = (d0 * 16 + hi * 8) * 2;
        const bf16x8 b0 = *(const LAS bf16x8*)(Ks + KSWZ(r32, cb)), b1 = *(const LAS bf16x8*)(Ks + KSWZ(32 + r32, cb));
        p0 = mfma32(b0, qr[d0], p0); p1 = mfma32(b1, qr[d0], p1); }
#pragma unroll
    for (int d0 = 0; d0 < 4; ++d0) { const int cb = (d0 * 16 + hi * 8) * 2;
        const bf16x8 b0 = *(const LAS bf16x8*)(KPs + KPSWZ(r32, cb)), b1 = *(const LAS bf16x8*)(KPs + KPSWZ(32 + r32, cb));
        p0 = mfma32(b0, qr[8 + d0], p0); p1 = mfma32(b1, qr[8 + d0], p1); }
}
__device__ __forceinline__ int v_st(int k, int c) { const int kk = (k & ~0xC) | ((k & 4) << 1) | ((k & 8) >> 1); return ((kk >> 3) * 4 + (c >> 5)) * 512 + ((kk & 7) * 32 + (c & 31)) * 2; }
__device__ __forceinline__ int v_rd_base(int lane) { return ((lane & 3) << 3) | (((lane >> 2) & 3) << 6) | (((lane >> 4) & 1) << 5) | (((lane >> 5) & 1) << 8); }
constexpr int v_rd_off(int d0, int ks, int half) { return d0 * 512 + ks * 4096 + half * 2048; }
template <int OFF> __device__ __forceinline__ s16x4 tr_read(int vb) { s16x4 r; asm volatile("ds_read_b64_tr_b16 %0, %1 offset:%2" : "=&v"(r) : "v"(vb), "i"(OFF) : "memory"); return r; }
template <int D0> __device__ __forceinline__ void pv_one(f32x16& od, int vb, bf16x8 pa0, bf16x8 pa1, bf16x8 pa2, bf16x8 pa3) {
    const s16x4 l0 = tr_read<v_rd_off(D0, 0, 0)>(vb), h0 = tr_read<v_rd_off(D0, 0, 1)>(vb), l1 = tr_read<v_rd_off(D0, 1, 0)>(vb), h1 = tr_read<v_rd_off(D0, 1, 1)>(vb);
    const s16x4 l2 = tr_read<v_rd_off(D0, 2, 0)>(vb), h2 = tr_read<v_rd_off(D0, 2, 1)>(vb), l3 = tr_read<v_rd_off(D0, 3, 0)>(vb), h3 = tr_read<v_rd_off(D0, 3, 1)>(vb);
    asm volatile("s_waitcnt lgkmcnt(0)" ::: "memory"); SBAR();
#define PK(L, H) (bf16x8){L[0], L[1], L[2], L[3], H[0], H[1], H[2], H[3]}
    od = mfma32(pa0, PK(l0, h0), od); od = mfma32(pa1, PK(l1, h1), od); od = mfma32(pa2, PK(l2, h2), od); od = mfma32(pa3, PK(l3, h3), od);
#undef PK
}
__device__ __forceinline__ void pv_d0(f32x16* o, int vb, bf16x8 pa0, bf16x8 pa1, bf16x8 pa2, bf16x8 pa3) {
    pv_one<0>(o[0], vb, pa0, pa1, pa2, pa3); pv_one<1>(o[1], vb, pa0, pa1, pa2, pa3); pv_one<2>(o[2], vb, pa0, pa1, pa2, pa3); pv_one<3>(o[3], vb, pa0, pa1, pa2, pa3);
}
__device__ __forceinline__ void attn_unit(const bf16* __restrict__ Q, const bf16* __restrict__ KV, const bf16* __restrict__ KPE, bf16* __restrict__ O, int b, int h, int qb, LAS char* lds) {
    const int tid = pg8::opaque_tid(), wid = __builtin_amdgcn_readfirstlane(tid >> 6), lane = tid & 63, r32 = lane & 31, hi = lane >> 5;
    LAS char* V_lds = lds + OFF_V; LAS char* K_lds = lds + OFF_K; LAS char* KP_lds = lds + OFF_KP;
    LAS float* ws = (LAS float*)(lds + OFF_WS) + wid * 64; LAS float* li_l = ws; LAS float* al_l = ws + 32;
    const bf16* Kh = KV + (size_t)(b * SEQ) * LDKV + h * 256; const bf16* Vh = Kh + 128; const bf16* Pb = KPE + (size_t)(b * SEQ) * 64;
    const int NT = 4 * qb + 4, NTw = 4 * qb + (wid >> 1) + 1;
    float m_reg = -1e30f, l_reg = 0; f32x16 o[4] = {}; bf16x8 qr[12];
    const bf16* Qw = Q + (size_t)(b * SEQ + qb * 256 + wid * 32 + r32) * LDQ + h * DQK + hi * 8;
#pragma unroll
    for (int d0 = 0; d0 < 12; ++d0) qr[d0] = *(const bf16x8*)(Qw + d0 * 16);
    const int sr = tid >> 4, sc = (tid & 15) * 8, vst0 = v_st(sr, sc), vst1 = v_st(32 + sr, sc), pr = tid >> 3, pc = (tid & 7) * 8;
    const int vb0 = (int)(unsigned)(uintptr_t)V_lds + v_rd_base(lane);
    bf16x8 vs0, vs1, ks0, ks1, kp0;
#define SLOAD(k0) do { vs0 = *(const bf16x8*)(Vh + (size_t)((k0) + sr) * LDKV + sc); vs1 = *(const bf16x8*)(Vh + (size_t)((k0) + 32 + sr) * LDKV + sc); \
    ks0 = *(const bf16x8*)(Kh + (size_t)((k0) + sr) * LDKV + sc); ks1 = *(const bf16x8*)(Kh + (size_t)((k0) + 32 + sr) * LDKV + sc); kp0 = *(const bf16x8*)(Pb + (size_t)((k0) + pr) * 64 + pc); } while (0)
#define SWRITE(bb) do { *(LAS bf16x8*)(V_lds + (bb) * SHM_V + vst0) = vs0; *(LAS bf16x8*)(V_lds + (bb) * SHM_V + vst1) = vs1; \
    *(LAS bf16x8*)(K_lds + (bb) * SHM_K + KSWZ(sr, sc * 2)) = ks0; *(LAS bf16x8*)(K_lds + (bb) * SHM_K + KSWZ(32 + sr, sc * 2)) = ks1; \
    *(LAS bf16x8*)(KP_lds + (bb) * SHM_KP + KPSWZ(pr, pc * 2)) = kp0; } while (0)
#define RESC(a) do { if (__any((a) < 1.f)) { if (hi == 0) al_l[r32] = (a); asm volatile("s_waitcnt lgkmcnt(0)" ::: "memory"); \
    _Pragma("unroll") for (int d = 0; d < 4; ++d) _Pragma("unroll") for (int r = 0; r < 16; ++r) o[d][r] *= al_l[crow(r, hi)]; } } while (0)
    f32x16 p0, p1; float mn, al; bf16x8 pa0, pa1, pa2, pa3;
    SLOAD(0); asm volatile("s_waitcnt vmcnt(0)" ::: "memory"); SWRITE(0); __syncthreads();
    for (int j = 0; j < NT; ++j) {
        const int bsel = j & 1;
        if (j + 1 < NT) SLOAD((j + 1) * 64);
        SBAR();
        if (j < NTw) {
            qkt(p0, p1, K_lds + bsel * SHM_K, KP_lds + bsel * SHM_KP, qr, r32, hi);
            partialSM(p0, p1, m_reg, mn, al, false);
            RESC(al);
            finishSM(p0, p1, al, l_reg, pa0, pa1, pa2, pa3); SBAR();
            pv_d0(o, vb0 + bsel * SHM_V, pa0, pa1, pa2, pa3);
        }
        SBAR();
        if (j + 1 < NT) { asm volatile("s_waitcnt vmcnt(0)" ::: "memory"); SWRITE(bsel ^ 1); }
        __syncthreads();
    }
    if (hi == 0) li_l[r32] = l_reg; asm volatile("s_waitcnt lgkmcnt(0)" ::: "memory");
    float rli[16];
#pragma unroll
    for (int r = 0; r < 16; ++r) rli[r] = __builtin_amdgcn_rcpf(li_l[crow(r, hi)]);
    bf16* Ow = O + (size_t)(b * SEQ + qb * 256 + wid * 32) * LDO + h * 128;
#pragma unroll
    for (int r = 0; r < 16; ++r) { const int orow = crow(r, hi);
#pragma unroll
        for (int d0 = 0; d0 < 4; ++d0) Ow[(size_t)orow * LDO + d0 * 32 + r32] = (bf16)f2bf(o[d0][r] * rli[r]); }
    __syncthreads();
#undef SLOAD
#undef SWRITE
#undef RESC
}
}
__device__ __forceinline__ void attn_phase(Ctx& C) {
    const int x = C.bid & 7, idx = C.bid >> 3, per = C.G >> 3;
    for (int p = idx; p < 128; p += per) { const int bh = 16 * x + (p >> 3), pr = p & 7, b = bh >> 4, h = bh & 15;
        att::attn_unit(C_Q, C_KV, C_KPE, C_RA, b, h, 15 - pr, (LAS char*)C.lds);
        att::attn_unit(C_Q, C_KV, C_KPE, C_RA, b, h, pr, (LAS char*)C.lds); }
}

#ifndef DBG_DELTA
#define DBG_DELTA C_RA
#endif
__global__ void __launch_bounds__(NWAVES * 64, 2) mk_fwd(Args args) {
    extern __shared__ __attribute__((aligned(16))) unsigned char lds_raw[];
    Ctx C;
    C.lds = (LAS unsigned char*)lds_raw;
    volatile LAS unsigned* MISC = (volatile LAS unsigned*)(C.lds + MISC_OFF);
    C.tid = threadIdx.x; C.lane = C.tid & 63; C.wave = __builtin_amdgcn_readfirstlane(C.tid >> 6); C.G = gridDim.x; C.bid = blockIdx.x;
    C.ka = (const CAS char*)__builtin_amdgcn_kernarg_segment_ptr(); gu32* ctl = (gu32*)(args.ws + WS_CTL);
    for (int u = C.tid; u < (LDS_BYTES - RING_BYTES) / 4; u += NWAVES * 64) ((LAS unsigned*)(C.lds + RING_BYTES))[u] = 0u;
    __syncthreads();
    const int lo = args.ph_lo, hi = args.ph_hi;
    const bool fused = (hi - lo) > 1;
    XcdBarrier bar; bar.bar = (unsigned*)(ctl + CW_BAR); bar.x = 0; bar.st = nullptr;
    if (fused) bar = xcd_barrier_post((unsigned*)(ctl + CW_BAR), MISC + 8);
#ifndef PH_MASK
#define PH_MASK 0x1FFF
#endif
#define IN(k) ((((PH_MASK) >> ((k) >= DEPTH * 12 ? 12 : (k) % 12)) & 1) && lo <= (k) && (k) < hi)
#define PH_FENCE() do { asm volatile("" : "+s"(C.ka), "+v"(C.tid)); C.lane = C.tid & 63; C.wave = __builtin_amdgcn_readfirstlane(C.tid >> 6); } while (0)
#define SEAM(k) do { if ((k) + 1 < hi) { XcdBarrier b2_ = bar; asm volatile("" : "+s"(b2_.bar)); xcd_barrier(b2_); } } while (0)
#define gw (C.bid * NWAVES + C.wave)
#define NGW (C.G * NWAVES)

    for (int l = 0; l < DEPTH; ++l) {
        const int pb = l * 12;
        if (IN(pb + 0)) { PH_FENCE();
            convert_weights(C, l);
            ssm_lp(C, l);
            if (l == 0) rope_tables(C);
            const float* wpre = C_in(I_PREMIX) + l * DM;
            if (l == 0) { for (int m = gw; m < T; m += NGW) row_pass(C_in(I_X) + (size_t)m * DM, nullptr, nullptr, nullptr, wpre, C_RA + (size_t)m * DM, C.lane); }
            else { const float* wpost = C_in(I_POSTFFN) + (l - 1) * DM;
                for (int m = gw; m < T; m += NGW) row_pass(C_out + (size_t)m * DM, C_F + (size_t)m * DM, wpost, C_out + (size_t)m * DM, wpre, C_RA + (size_t)m * DM, C.lane); }
            SEAM(pb + 0);
        }
        if (IN(pb + 1)) { PH_FENCE();
            EpiInProj E{C_CQ, C_CKV, C_KPE, C_U, C_GA, C_GB, C_ssqq, C_ssqkv, C_in(I_BGATE) + l * 2 * DM, C_cosT, C_sinT};
            run_gemm(C, C_RA, C_Win, NIN, DM, E);
            ssm_tables(C, l);
            SEAM(pb + 1);
        }
        if (IN(pb + 2)) { PH_FENCE(); ssm_states(C); SEAM(pb + 2); }
        if (IN(pb + 3)) { PH_FENCE();
#ifndef NO_Q
            { EpiQ E{C_Q, C_ssqq, C_cosT, C_sinT}; run_gemm(C, C_CQ, C_Wuq, NH * DQK, QL, E); }
#endif
#ifndef NO_KV
            { EpiKV E{C_KV, C_ssqkv}; run_gemm(C, C_CKV, C_Wukv, 4096, KVL, E); }
#endif
            SEAM(pb + 3);
        }
        if (IN(pb + 4)) { PH_FENCE(); ssm_outputs(C, l); SEAM(pb + 4); }
        if (IN(pb + 5)) { PH_FENCE(); attn_phase(C); SEAM(pb + 5); }
        if (IN(pb + 6)) { PH_FENCE(); EpiWo E{C_GA}; run_gemm(C, C_RA, C_Wo, DM, DM, E); SEAM(pb + 6); }
        if (IN(pb + 7)) { PH_FENCE(); EpiGlu E{C_GA, C_GB, C_in(I_BGLU) + l * 2 * DM}; run_gemm(C, C_Z, C_Wglu, 4096, SW, E); SEAM(pb + 7); }
        #ifdef DBG_K8
        if (IN(pb + 8)) { PH_FENCE(); EpiPlain E{C_GA}; run_gemm(C, C_RA, C_Wout, DM, DM, E); SEAM(pb + 8); }
#else
        if (IN(pb + 8)) { PH_FENCE(); EpiPlain E{C_RA}; run_gemm(C, C_GA, C_Wout, DM, DM, E); SEAM(pb + 8); }
#endif
        if (IN(pb + 9)) { PH_FENCE();
            const float* xin = (l == 0) ? C_in(I_X) : C_out; const float* wpost = C_in(I_POSTMIX) + l * DM; const float* wpre = C_in(I_PREFFN) + l * DM;
            for (int m = gw; m < T; m += NGW) row_pass(xin + (size_t)m * DM, DBG_DELTA + (size_t)m * DM, wpost, C_out + (size_t)m * DM, wpre, C_H2 + (size_t)m * DM, C.lane);
            SEAM(pb + 9);
        }
        if (IN(pb + 10)) { PH_FENCE(); EpiSwiGlu E{C_HID}; run_gemm(C, C_H2, C_Wgu, 2 * FF, DM, E); SEAM(pb + 10); }
        if (IN(pb + 11)) { PH_FENCE(); EpiPlain E{C_F}; run_gemm(C, C_HID, C_Wdn, DM, FF, E); SEAM(pb + 11); }
    }
    if (IN(DEPTH * 12)) { PH_FENCE();
        const float* wpost = C_in(I_POSTFFN) + (DEPTH - 1) * DM;
        for (int m = gw; m < T; m += NGW) row_pass(C_out + (size_t)m * DM, C_F + (size_t)m * DM, wpost, C_out + (size_t)m * DM, nullptr, nullptr, C.lane);
    }
#undef IN
#undef SEAM
#undef gw
#undef NGW
}

#ifndef MK_SINGLE
#define MK_SINGLE 0
#endif
#ifndef MK_PH_END
#define MK_PH_END NPH
#endif
extern "C" void kernel_launch(void* const* d_in, const int* in_sizes, int n_in, void* d_out, int out_size, void* d_ws, size_t ws_size, hipStream_t stream) {
    static int grid = 0;
    if (grid == 0) {
        if (n_in != 27 || in_sizes[0] != T * DM || out_size != T * DM || ws_size < WS_END) { fprintf(stderr, "kernel_launch: unexpected shapes: n_in %d in0 %d out %d ws %zu (need %zu)\n", n_in, n_in > 0 ? in_sizes[0] : -1, out_size, ws_size, (size_t)WS_END); grid = -1; return; }
        int dev = 0, cus = 0, per_cu = 0;
        if (hipGetDevice(&dev) != hipSuccess || hipDeviceGetAttribute(&cus, hipDeviceAttributeMultiprocessorCount, dev) != hipSuccess) { grid = -1; return; }
        if (hipFuncSetAttribute((const void*)mk_fwd, hipFuncAttributeMaxDynamicSharedMemorySize, LDS_BYTES) != hipSuccess) { fprintf(stderr, "kernel_launch: hipFuncSetAttribute failed\n"); grid = -1; return; }
        if (hipOccupancyMaxActiveBlocksPerMultiprocessor(&per_cu, (const void*)mk_fwd, NWAVES * 64, LDS_BYTES) != hipSuccess || per_cu < 1) fprintf(stderr, "kernel_launch: occupancy query says %d\n", per_cu);
        (void)hipGetLastError();
        grid = cus;
    }
    if (grid < 0) return;
    if (hipMemsetAsync((char*)d_ws + WS_CTL, 0, CTL_ZERO_BYTES, stream) != hipSuccess) return;
    Args a{};
    for (int i = 0; i < 27; ++i) a.in[i] = (const float*)d_in[i];
    a.out = (float*)d_out; a.ws = (unsigned char*)d_ws;
#if MK_SINGLE
    a.ph_lo = 0; a.ph_hi = MK_PH_END;
    hipLaunchKernelGGL(mk_fwd, dim3(grid), dim3(NWAVES * 64), LDS_BYTES, stream, a);
#else
    for (int p = 0; p < MK_PH_END; ++p) { a.ph_lo = p; a.ph_hi = p + 1; hipLaunchKernelGGL(mk_fwd, dim3(grid), dim3(NWAVES * 64), LDS_BYTES, stream, a); }
#endif
    const hipError_t le = hipPeekAtLastError();
    if (le != hipSuccess) fprintf(stderr, "kernel_launch: launch failed: %s\n", hipGetErrorName(le));
}
```

```cpp
#include <hip/hip_runtime.h>
#include <cstdio>
#include <cstdint>
#define MK_ALIGN true
#ifndef MK_SINGLE
#define MK_SINGLE 1
#endif
#ifndef MK_PH_END
#define MK_PH_END NPH
#endif
#ifndef PH_MASK
#define PH_MASK 0x1FFF
#endif
#ifndef DBG_DELTA
#define DBG_DELTA C_RA
#endif
namespace pg8 {
#define PG8_LAS __attribute__((address_space(3)))
typedef unsigned short bf16_t;
typedef short bf16x8 __attribute__((ext_vector_type(8)));
typedef float f32x4 __attribute__((ext_vector_type(4)));
typedef unsigned u32x4 __attribute__((ext_vector_type(4)));
constexpr int BM = 256, BK = 64, HALF = 128, HTB = HALF * BK * 2  , STAGE_BYTES = 8 * HTB, NXCD = 8, WGM = 8;

__host__ __device__ __forceinline__ int lds_byte(int r, int c) { const int st = (r >> 4) * 2 + (c >> 5), rr = r & 15, cc = c & 31, ob = rr * 64 + cc * 2; return st * 1024 + (ob ^ (((ob >> 9) & 1) << 5)); }
__host__ __device__ __forceinline__ void stage_rc(int b, int& R, int& C) { const int st = b / 1024, sb = b % 1024, swz = sb ^ (((sb >> 9) & 1) << 5); R = (st >> 1) * 16 + swz / 64; C = (st & 1) * 32 + (swz % 64) / 2; }
__host__ __device__ __forceinline__ int perm32(int rho) { const int n = rho >> 4, i = rho & 15; return 8 * (i >> 2) + 4 * n + (i & 3); }

__device__ __forceinline__ int opaque_tid() { int t = threadIdx.x; asm volatile("" : "+v"(t)); return t; }
struct Unit { int pm, pn; };
struct Gemm { const bf16_t* A; const bf16_t* Bt; int M, N, K; };

struct StaticOrder {
    int nM, nN, nwg, G, c;
    __host__ __device__ void init(int M, int N, int G_, int c_) { nM = M / BM; nN = N / BM; nwg = nM * nN; G = G_; c = c_; }
    __host__ __device__ bool next(int i, Unit& u) const {
        const long L = (long)i * G + c; if (L >= nwg) return false;
        int wgid = (int)L; { const int q = nwg / NXCD, r = nwg % NXCD, xcd = wgid % NXCD, off = wgid / NXCD; wgid = (xcd < r ? xcd * (q + 1) : r * (q + 1) + (xcd - r) * q) + off; }
        const int nig = WGM * nN, gid = wgid / nig, fm = gid * WGM, gsz = (nM - fm) < WGM ? (nM - fm) : WGM;
        u.pm = fm + ((wgid % nig) % gsz); u.pn = (wgid % nig) / gsz; return true;
    }
    __device__ __forceinline__ void a_ready(const Unit&) const {}
    __device__ __forceinline__ void done(const Unit&) const {}
};

typedef __bf16 bf16x2_t __attribute__((ext_vector_type(2))); typedef float f32x2_t __attribute__((ext_vector_type(2)));
__device__ __forceinline__ unsigned cvt_pk_bf16(float lo, float hi) { const f32x2_t v = {lo, hi}; const bf16x2_t b = __builtin_convertvector(v, bf16x2_t); return __builtin_bit_cast(unsigned, b); }
template <class Epi, class Sched, bool ALIGN_EPI = false, bool SP2 = false>
__device__ __forceinline__ void gemm_phase(PG8_LAS unsigned char* lds, const Gemm g, const Sched& S, const Epi& E) {
    const int tid = opaque_tid(), wid = __builtin_amdgcn_readfirstlane(tid >> 6), lane = tid & 63, wr = wid >> 2, wc = wid & 3, fr = lane & 15, fq = lane >> 4;
    const int K = g.K, nt = K / BK;
    unsigned voffA[2], voffB[2];
#pragma unroll
    for (int i = 0; i < 2; ++i) { int R, C; stage_rc(tid * 16 + i * 8192, R, C); const int Rb = Epi::PERM ? ((R & ~31) + perm32(R & 31)) : R;
        voffA[i] = (unsigned)(R * K + C) * 2u; voffB[i] = (unsigned)(Rb * K + C) * 2u; }
    const size_t kstep = (size_t)(BK * 2);
    const size_t hstep = (size_t)HALF * K * 2;
    const size_t tstep = 2 * hstep;
    const unsigned ldsw = (unsigned)wid * 1024u;
    const int aoff = lds_byte(wr * 64 + fr, fq * 8), boff = lds_byte(wc * 32 + fr, fq * 8);
#define PG8_SA(b, h) (((b) * 2 + (h)) * HTB)
#define PG8_SB(b, h) ((4 + (b) * 2 + (h)) * HTB)
#define PG8_STAGE(bufoff, gbase, voff) do { _Pragma("unroll") for (int _i = 0; _i < 2; ++_i) \
        __builtin_amdgcn_global_load_lds((const unsigned*)((const char*)(gbase) + (voff)[_i]), (PG8_LAS unsigned*)(lds + (bufoff) + ldsw + _i * 8192), 16, 0, 0); } while (0)
#define PG8_LDA(dst, b, h) do { _Pragma("unroll") for (int m = 0; m < 4; ++m) _Pragma("unroll") for (int k = 0; k < 2; ++k) dst[m][k] = *(const PG8_LAS bf16x8*)(lds + PG8_SA(b, h) + aoff + m * 2048 + k * 1024); } while (0)
#define PG8_LDB(dst, b, h) do { _Pragma("unroll") for (int n = 0; n < 2; ++n) _Pragma("unroll") for (int k = 0; k < 2; ++k) dst[n][k] = *(const PG8_LAS bf16x8*)(lds + PG8_SB(b, h) + boff + n * 2048 + k * 1024); } while (0)
#define PG8_MMA(ai, bj, At, Bt) do { __builtin_amdgcn_s_setprio(1); _Pragma("unroll") for (int m = 0; m < 4; ++m) _Pragma("unroll") for (int n = 0; n < 2; ++n) _Pragma("unroll") for (int k = 0; k < 2; ++k) \
        acc[ai][bj][m][n] = __builtin_amdgcn_mfma_f32_16x16x32_bf16(Bt[n][k], At[m][k], acc[ai][bj][m][n], 0, 0, 0); __builtin_amdgcn_s_setprio(0); } while (0)
#define PG8_WAIT_V(n) asm volatile("s_waitcnt vmcnt(" #n ")" ::: "memory")
#define PG8_WAIT_L(n) asm volatile("s_waitcnt lgkmcnt(" #n ")" ::: "memory")
#define PG8_BAR __builtin_amdgcn_s_barrier()
#define PG8_SCHED __builtin_amdgcn_sched_barrier(0)
    Unit cur, nxt; int ui = 0;
    if (!S.next(0, cur)) return;
    f32x4 acc[2][2][4][2];
#pragma unroll
    for (int a = 0; a < 2; ++a)
#pragma unroll
        for (int b = 0; b < 2; ++b)
#pragma unroll
            for (int m = 0; m < 4; ++m)
#pragma unroll
                for (int n = 0; n < 2; ++n) acc[a][b][m][n] = (f32x4){0.f, 0.f, 0.f, 0.f};
    bf16x8 At[4][2], B0[2][2], B1[2][2];
    const char* cA = (const char*)g.A + (size_t)cur.pm * tstep; const char* cB = (const char*)g.Bt + (size_t)cur.pn * tstep;
    S.a_ready(cur);
    if constexpr (SP2) {
        PG8_STAGE(PG8_SB(0, 0), cB, voffB); PG8_STAGE(PG8_SB(0, 1), cB + hstep, voffB); PG8_STAGE(PG8_SA(0, 0), cA, voffA); PG8_STAGE(PG8_SA(0, 1), cA + hstep, voffA);
        if (wr == 1) PG8_BAR;
        PG8_WAIT_V(2); PG8_BAR;
        PG8_STAGE(PG8_SB(1, 0), cB + kstep, voffB); PG8_STAGE(PG8_SA(1, 0), cA + kstep, voffA); PG8_STAGE(PG8_SB(1, 1), cB + hstep + kstep, voffB);
        PG8_WAIT_V(6); PG8_BAR;
    } else {
        PG8_STAGE(PG8_SB(0, 0), cB, voffB); PG8_STAGE(PG8_SA(0, 0), cA, voffA); PG8_STAGE(PG8_SB(0, 1), cB + hstep, voffB); PG8_STAGE(PG8_SA(0, 1), cA + hstep, voffA);
        if (wr == 1) PG8_BAR;
        PG8_WAIT_V(4); PG8_BAR;
        PG8_STAGE(PG8_SB(1, 0), cB + kstep, voffB); PG8_STAGE(PG8_SA(1, 0), cA + kstep, voffA); PG8_STAGE(PG8_SB(1, 1), cB + hstep + kstep, voffB);
        PG8_WAIT_V(6); PG8_BAR;
    }
    for (;;) {
        const bool has_next = S.next(ui + 1, nxt);
        const char* nA = has_next ? (const char*)g.A + (size_t)nxt.pm * tstep : cA; const char* nB = has_next ? (const char*)g.Bt + (size_t)nxt.pn * tstep : cB;
        for (int t = 0; t < nt; t += 2) {
            const bool last = (t == nt - 2);
            const char* a1 = cA + (size_t)(t + 1) * kstep;
            const char* a2 = last ? nA : cA + (size_t)(t + 2) * kstep; const char* b2 = last ? nB : cB + (size_t)(t + 2) * kstep;
            const char* a3 = a2 + kstep; const char* b3 = b2 + kstep;
            if (last && has_next) S.a_ready(nxt);
            if constexpr (SP2) {
            PG8_LDB(B0, 0, 0); PG8_LDB(B1, 0, 1); PG8_SCHED; PG8_LDA(At, 0, 0); PG8_STAGE(PG8_SA(1, 1), a1 + hstep, voffA);
            PG8_WAIT_V(8); PG8_WAIT_L(0); PG8_BAR; PG8_MMA(0, 0, At, B0); PG8_MMA(0, 1, At, B1); PG8_BAR; PG8_SCHED;
            PG8_LDA(At, 0, 1); PG8_STAGE(PG8_SB(0, 0), b2, voffB); PG8_STAGE(PG8_SB(0, 1), b2 + hstep, voffB); PG8_STAGE(PG8_SA(0, 0), a2, voffA);
            PG8_WAIT_V(8); PG8_WAIT_L(0); PG8_BAR; PG8_MMA(1, 0, At, B0); PG8_MMA(1, 1, At, B1); PG8_BAR; PG8_SCHED;
            PG8_LDB(B0, 1, 0); PG8_LDB(B1, 1, 1); PG8_SCHED; PG8_LDA(At, 1, 0); PG8_STAGE(PG8_SA(0, 1), a2 + hstep, voffA);
            PG8_WAIT_V(8); PG8_WAIT_L(0); PG8_BAR; PG8_MMA(0, 0, At, B0); PG8_MMA(0, 1, At, B1); PG8_BAR; PG8_SCHED;
            PG8_LDA(At, 1, 1); PG8_STAGE(PG8_SB(1, 0), b3, voffB); PG8_STAGE(PG8_SB(1, 1), b3 + hstep, voffB); PG8_STAGE(PG8_SA(1, 0), a3, voffA);
            PG8_WAIT_V(8); PG8_WAIT_L(0); PG8_BAR; PG8_MMA(1, 0, At, B0); PG8_MMA(1, 1, At, B1); PG8_BAR; PG8_SCHED;
            } else {
            PG8_LDB(B0, 0, 0); PG8_SCHED; PG8_LDA(At, 0, 0); PG8_STAGE(PG8_SA(1, 1), a1 + hstep, voffA);
            PG8_WAIT_L(8); PG8_BAR; PG8_WAIT_L(0); PG8_MMA(0, 0, At, B0); PG8_BAR; PG8_SCHED;
            PG8_LDB(B1, 0, 1); PG8_STAGE(PG8_SB(0, 0), b2, voffB);
            PG8_BAR; PG8_WAIT_L(0); PG8_MMA(0, 1, At, B1); PG8_BAR;
            PG8_LDA(At, 0, 1); PG8_STAGE(PG8_SA(0, 0), a2, voffA);
            PG8_BAR; PG8_WAIT_L(0); PG8_MMA(1, 0, At, B0); PG8_BAR; PG8_SCHED;
            PG8_STAGE(PG8_SB(0, 1), b2 + hstep, voffB);
            PG8_WAIT_V(6); PG8_BAR; PG8_MMA(1, 1, At, B1); PG8_BAR;
            PG8_LDB(B0, 1, 0); PG8_SCHED; PG8_LDA(At, 1, 0); PG8_STAGE(PG8_SA(0, 1), a2 + hstep, voffA);
            PG8_WAIT_L(8); PG8_BAR; PG8_WAIT_L(0); PG8_MMA(0, 0, At, B0); PG8_BAR; PG8_SCHED;
            PG8_LDB(B1, 1, 1); PG8_STAGE(PG8_SB(1, 0), b3, voffB);
            PG8_BAR; PG8_WAIT_L(0); PG8_MMA(0, 1, At, B1); PG8_BAR;
            PG8_LDA(At, 1, 1); PG8_STAGE(PG8_SA(1, 0), a3, voffA);
            PG8_BAR; PG8_WAIT_L(0); PG8_MMA(1, 0, At, B0); PG8_BAR; PG8_SCHED;
            PG8_STAGE(PG8_SB(1, 1), b3 + hstep, voffB);
            PG8_WAIT_V(6); PG8_BAR; PG8_MMA(1, 1, At, B1); PG8_BAR;
            }
        }
        if constexpr (ALIGN_EPI) { if (wr == 0) PG8_BAR; }
        if constexpr (!Epi::AFTER_DRAIN) { E(acc, cur, wr, wc, fr, fq); S.done(cur); }
        if (!has_next) break;
#pragma unroll
        for (int a = 0; a < 2; ++a)
#pragma unroll
            for (int b = 0; b < 2; ++b)
#pragma unroll
                for (int m = 0; m < 4; ++m)
#pragma unroll
                    for (int n = 0; n < 2; ++n) acc[a][b][m][n] = (f32x4){0.f, 0.f, 0.f, 0.f};
        cur = nxt; cA = nA; cB = nB; ++ui;
        if constexpr (ALIGN_EPI) { if (wr == 1) PG8_BAR; }
    }
    PG8_WAIT_V(0);
    if constexpr (!ALIGN_EPI) { if (wr == 0) PG8_BAR; }
    PG8_BAR;
    if constexpr (Epi::AFTER_DRAIN) { E.fused(acc, cur, wr, wc, fr, fq, lds, wid, lane); S.done(cur); }
#undef PG8_SA
#undef PG8_SB
#undef PG8_STAGE
#undef PG8_LDA
#undef PG8_LDB
#undef PG8_MMA
#undef PG8_WAIT_V
#undef PG8_WAIT_L
#undef PG8_BAR
#undef PG8_SCHED
}
}

constexpr int BATCH = 8, SEQ = 4096, DM = 2048, DEPTH = 4, T = BATCH * SEQ;
constexpr int NH = 16, DQK = 192, QL = 512, KVL = 256;
constexpr int SW = 1024, SG = 64, SN = 64, SP = 16, FF = 5632;
constexpr int INW = 5952, OFF_SSM = 832, OFF_GATE = 1856;
constexpr int NIN = 6144;
constexpr float EPS = 1e-6f;
constexpr float QSCALE = 0.07216878364870322f * 1.4426950408889634f;
constexpr int NWAVES = 8;
constexpr int NPH = DEPTH * 12 + 1;

constexpr size_t MiB = 1u << 20;
constexpr size_t WS_CTL = 0, CTL_ZERO_BYTES = 1 * MiB;
constexpr size_t WS_COS = 1 * MiB, WS_SIN = 5 * MiB;
constexpr size_t WS_SSQQ = 9 * MiB, WS_SSQKV = 10 * MiB;
constexpr size_t WS_LP = 11 * MiB;
constexpr size_t WS_FB = WS_LP + 5 * MiB / 2;
constexpr size_t WS_KD = 14 * MiB;
constexpr size_t WS_MAT = 17 * MiB;
constexpr size_t WS_CCT = 33 * MiB;
constexpr size_t WS_XST = 49 * MiB;
constexpr size_t WS_W = 57 * MiB;
constexpr size_t WO_WIN = 0, WO_WUQ = 24 * MiB, WO_WUKV = 27 * MiB, WO_WO = 29 * MiB, WO_WGLU = 37 * MiB, WO_WOUT = 45 * MiB, WO_WGU = 53 * MiB, WO_WDN = 97 * MiB;
constexpr size_t WS_RA = 176 * MiB;
constexpr size_t WS_CQ = 304 * MiB, WS_CKV = 336 * MiB, WS_KPE = 352 * MiB, WS_U = 356 * MiB, WS_GA = 420 * MiB, WS_GB = 548 * MiB;
constexpr size_t WS_HID = 304 * MiB;
constexpr size_t WS_Q = 676 * MiB;
constexpr size_t WS_KV = 868 * MiB;
constexpr size_t WS_Z = 1124 * MiB;
constexpr size_t WS_END = 1188 * MiB;
static_assert(WS_HID + (size_t)T * FF * 2 <= WS_Q, "HID overlay");

constexpr int CW_TMO = 0, CW_CODE = 1, CW_BAR = 4096;

constexpr int RING_BYTES = 131072, MISC_OFF = RING_BYTES + 320, LDS_BYTES = 147456;

#define GAS __attribute__((address_space(1)))
#define LAS __attribute__((address_space(3)))
#define CAS __attribute__((address_space(4)))
typedef unsigned short bf16;
using pg8::bf16x8; using pg8::f32x4; using pg8::u32x4; using pg8::cvt_pk_bf16;
typedef float f32x2 __attribute__((ext_vector_type(2)));
typedef float f32x16 __attribute__((ext_vector_type(16)));
typedef unsigned u32x2 __attribute__((ext_vector_type(2)));
typedef short s16x4 __attribute__((ext_vector_type(4)));
typedef GAS unsigned gu32;
#define RLX_AGENT __ATOMIC_RELAXED, __HIP_MEMORY_SCOPE_AGENT
#define LDS_WAIT() asm volatile("s_waitcnt lgkmcnt(0)" ::: "memory")
#define VM_WAIT() asm volatile("s_waitcnt vmcnt(0)" ::: "memory")
__device__ __forceinline__ unsigned f2bf(float f) { unsigned u = __builtin_bit_cast(unsigned, f); return (u + 0x7fffu + ((u >> 16) & 1u)) >> 16; }
__device__ __forceinline__ unsigned pk2(float lo, float hi) { return f2bf(lo) | (f2bf(hi) << 16); }
__device__ __forceinline__ float bflo(unsigned w) { return __uint_as_float(w << 16); }
__device__ __forceinline__ float bfhi(unsigned w) { return __uint_as_float(w & 0xffff0000u); }
__device__ __forceinline__ float sigm(float x) { return __builtin_amdgcn_rcpf(1.0f + __builtin_amdgcn_exp2f(-1.4426950408889634f * x)); }
__device__ __forceinline__ void st8(bf16* p, f32x4 v0, f32x4 v1) { u32x4 w; w.x = cvt_pk_bf16(v0[0], v0[1]); w.y = cvt_pk_bf16(v0[2], v0[3]); w.z = cvt_pk_bf16(v1[0], v1[1]); w.w = cvt_pk_bf16(v1[2], v1[3]); *(u32x4*)p = w; }
__device__ __forceinline__ void ld8(const bf16* p, f32x4& v0, f32x4& v1) { const u32x4 w = *(const u32x4*)p; v0[0] = bflo(w.x); v0[1] = bfhi(w.x); v0[2] = bflo(w.y); v0[3] = bfhi(w.y); v1[0] = bflo(w.z); v1[1] = bfhi(w.z); v1[2] = bflo(w.w); v1[3] = bfhi(w.w); }
__device__ __forceinline__ float wave_sum(float v) {
#pragma unroll
    for (int o = 1; o < 64; o <<= 1) v += __shfl_xor(v, o);
    return v;
}

#define XB_TMO      128
#define XB_XCNT(j)  (256  + 64 * (j))
#define XB_XSUB(j)  (1280 + 64 * (j))
#define XB_XGEN(j)  (2304 + 64 * (j))
#define XB_TOP      3328
#define XB_TOPGEN   3392
#define XCD_BAR_WORDS 3456
#define XB_SPIN_CAP (1u << 18)

__device__ __forceinline__ unsigned xb_ld(unsigned* p)              { return __hip_atomic_load(p, __ATOMIC_RELAXED, __HIP_MEMORY_SCOPE_AGENT); }
__device__ __forceinline__ unsigned xb_add(unsigned* p, unsigned v) { return __hip_atomic_fetch_add(p, v, __ATOMIC_RELAXED, __HIP_MEMORY_SCOPE_AGENT); }
__device__ __forceinline__ unsigned xb_xcc_id() { return (unsigned)__builtin_amdgcn_s_getreg((3 << 11) | 20) & 0xFu; }
#define XB_SPIN(cond, bar) do { unsigned _sp = 0; while (cond) { __builtin_amdgcn_s_sleep(1); \
    if ((++_sp & 255u) == 0u) { if (xb_ld(&(bar)[XB_TMO])) break; if (_sp > XB_SPIN_CAP) { atomicAdd(&(bar)[XB_TMO], 1u); break; } } } } while (0)

struct XcdBarrier {
    unsigned* bar; unsigned x;
    volatile LAS unsigned* st;
};

__device__ __forceinline__ XcdBarrier xcd_barrier_post(unsigned* bar, volatile LAS unsigned* st) {
    XcdBarrier b; b.bar = bar; b.x = xb_xcc_id(); b.st = st;
    if (threadIdx.x == 0) (void)xb_add(&bar[XB_XCNT(b.x)], 1u);
    return b;
}
__device__ __forceinline__ void xcd_barrier_complete(unsigned* bar, unsigned x, unsigned& nloc, unsigned& nx) {
    const unsigned G = gridDim.x * gridDim.y * gridDim.z;
    unsigned sum, cnt, mine, sp = 0u;
    for (;;) {
        sum = 0u; cnt = 0u; mine = 0u;
#pragma unroll
        for (unsigned j = 0; j < 16; ++j) { const unsigned c = xb_ld(&bar[XB_XCNT(j)]); sum += c; cnt += (c > 0u) ? 1u : 0u; mine = (j == x) ? c : mine; }
        if (sum == G) break;
        __builtin_amdgcn_s_sleep(1);
        if ((++sp & 255u) == 0u) { if (xb_ld(&bar[XB_TMO])) break; if (sp > XB_SPIN_CAP) { atomicAdd(&bar[XB_TMO], 1u); break; } }
    }
    nloc = mine > 0u ? mine : 1u; nx = cnt > 0u ? cnt : 1u;
}

__device__ __forceinline__ void xcd_barrier(const XcdBarrier& b) {
    asm volatile("s_waitcnt vmcnt(0)" ::: "memory");
    __syncthreads();
    if (threadIdx.x == 0) {
        unsigned* bar = b.bar;
        __builtin_amdgcn_s_waitcnt(0);
        unsigned nloc = b.st[0], nx = b.st[1];
        if (nloc == 0u) { xcd_barrier_complete(bar, b.x, nloc, nx); b.st[0] = nloc; b.st[1] = nx; }
        const unsigned old = xb_add(&bar[XB_XSUB(b.x)], 1u);
        const unsigned gen = old / nloc;
        if (old + 1u == (gen + 1u) * nloc) {
            __builtin_amdgcn_fence(__ATOMIC_RELEASE, "agent");
            asm volatile("s_waitcnt vmcnt(0)" ::: "memory");
            const unsigned og = xb_add(&bar[XB_TOP], 1u);
            const unsigned tg = og / nx;
            if (og + 1u == (tg + 1u) * nx) xb_add(&bar[XB_TOPGEN], 1u);
            else XB_SPIN(xb_ld(&bar[XB_TOPGEN]) == tg, bar);
            __builtin_amdgcn_fence(__ATOMIC_ACQUIRE, "agent");
            xb_add(&bar[XB_XGEN(b.x)], 1u);
            asm volatile("s_waitcnt vmcnt(0)" ::: "memory");
        } else {
            XB_SPIN(xb_ld(&bar[XB_XGEN(b.x)]) == gen, bar);
            __builtin_amdgcn_fence(__ATOMIC_ACQUIRE, "agent");
            asm volatile("s_waitcnt vmcnt(0)" ::: "memory");
        }
    }
    __syncthreads();
}

struct Args { const float* in[27]; float* out; unsigned char* ws; int ph_lo, ph_hi; };
struct Ctx {
    LAS unsigned char* lds;
    int tid, lane, wave, G, bid;
    const CAS char* ka;
};
static_assert(sizeof(Args) == 240, "Args layout");
#define C_in(i) (*(const float* const CAS*)(C.ka + 8 * (i)))
#define C_out (*(float* const CAS*)(C.ka + 216))
#define C_ws (*(unsigned char* const CAS*)(C.ka + 224))
#define WSP(TY, off) ((TY*)(C_ws + (off)))
#define C_cosT WSP(float, WS_COS)
#define C_sinT WSP(float, WS_SIN)
#define C_ssqq WSP(float, WS_SSQQ)
#define C_ssqkv WSP(float, WS_SSQKV)
#define C_LP WSP(f32x2, WS_LP)
#define C_FB WSP(f32x2, WS_FB)
#define C_KD WSP(bf16, WS_KD)
#define C_MAT WSP(bf16, WS_MAT)
#define C_CCT WSP(bf16, WS_CCT)
#define C_XST WSP(bf16, WS_XST)
#define C_Win WSP(bf16, WS_W + WO_WIN)
#define C_Wuq WSP(bf16, WS_W + WO_WUQ)
#define C_Wukv WSP(bf16, WS_W + WO_WUKV)
#define C_Wo WSP(bf16, WS_W + WO_WO)
#define C_Wglu WSP(bf16, WS_W + WO_WGLU)
#define C_Wout WSP(bf16, WS_W + WO_WOUT)
#define C_Wgu WSP(bf16, WS_W + WO_WGU)
#define C_Wdn WSP(bf16, WS_W + WO_WDN)
#define C_RA WSP(bf16, WS_RA)
#define C_CQ WSP(bf16, WS_CQ)
#define C_CKV WSP(bf16, WS_CKV)
#define C_KPE WSP(bf16, WS_KPE)
#define C_U WSP(bf16, WS_U)
#define C_GA WSP(bf16, WS_GA)
#define C_GB WSP(bf16, WS_GB)
#define C_HID WSP(bf16, WS_HID)
#define C_Q WSP(bf16, WS_Q)
#define C_KV WSP(bf16, WS_KV)
#define C_Z WSP(bf16, WS_Z)
#define C_H2 WSP(bf16, WS_Q)
#define C_F WSP(bf16, WS_KV)
enum { I_X = 0, I_POS, I_PREMIX, I_WIN, I_BGATE, I_QNORM, I_KVNORM, I_WUQ, I_WUKV, I_WO, I_ARE, I_AIM, I_LOGDT, I_BRE, I_BIM, I_CRE, I_CIM, I_SSMD, I_WGLU, I_BGLU, I_WOUT, I_POSTMIX, I_PREFFN, I_WFG, I_WFU, I_WFD, I_POSTFFN };

using pg8::Unit;
#define EPI_HDR static constexpr bool PERM = true, AFTER_DRAIN = false;
#define EPI_ARGS const f32x4 (&acc)[2][2][4][2], const Unit& u, int wr, int wc, int fr, int fq
#define FOR_AI_M _Pragma("unroll") for (int ai = 0; ai < 2; ++ai) _Pragma("unroll") for (int m = 0; m < 4; ++m)

typedef __amdgpu_buffer_rsrc_t rsrc_t;
__device__ __forceinline__ rsrc_t mk_rsrc(const void* p, unsigned bytes) { return __builtin_amdgcn_make_buffer_rsrc((void*)p, (short)0, (int)bytes, 0x00020000); }
__device__ __forceinline__ void bst8(rsrc_t r, unsigned voff, unsigned soff, f32x4 v0, f32x4 v1) { u32x4 w; w.x = cvt_pk_bf16(v0[0], v0[1]); w.y = cvt_pk_bf16(v0[2], v0[3]); w.z = cvt_pk_bf16(v1[0], v1[1]); w.w = cvt_pk_bf16(v1[2], v1[3]); __builtin_amdgcn_raw_buffer_store_b128(w, r, voff + soff, 0, 0); }
__device__ __forceinline__ void bld8(rsrc_t r, unsigned voff, unsigned soff, f32x4& v0, f32x4& v1) { const u32x4 w = __builtin_amdgcn_raw_buffer_load_b128(r, voff, soff, 0); v0[0] = bflo(w.x); v0[1] = bfhi(w.x); v0[2] = bflo(w.y); v0[3] = bfhi(w.y); v1[0] = bflo(w.z); v1[1] = bfhi(w.z); v1[2] = bflo(w.w); v1[3] = bfhi(w.w); }
__device__ __forceinline__ f32x4 bldf4(rsrc_t r, unsigned voff, unsigned soff) { return __builtin_bit_cast(f32x4, __builtin_amdgcn_raw_buffer_load_b128(r, voff, soff, 0)); }
#define ROWG (ai * 128 + m * 16)
#define TILE_BYTES(PB) (255u * (PB) + (PB))

struct EpiInProj { EPI_HDR
    bf16 *CQ, *CKV, *KPE, *U, *GA, *GB; float *ssqq, *ssqkv; const float *bgate, *cosT, *sinT;
    __device__ __forceinline__ void operator()(EPI_ARGS) const {
        const int pn = u.pn, lr = wr * 64 + fr, cl = wc * 32 + 8 * fq; const size_t r0 = (size_t)u.pm * 256;
        if (pn < 2) {
            const rsrc_t rb = mk_rsrc(CQ + r0 * QL + pn * 256, TILE_BYTES(QL * 2)), rq = mk_rsrc(ssqq + r0 * 8, 256 * 32);
            const unsigned vo = (unsigned)(lr * QL + cl) * 2u, vs = (unsigned)(lr * 8 + pn * 4 + wc) * 4u;
            FOR_AI_M { float s = 0.f;
#pragma unroll
                for (int bj = 0; bj < 2; ++bj) { const f32x4 v0 = acc[ai][bj][m][0], v1 = acc[ai][bj][m][1];
                    s += (v0[0] * v0[0] + v0[1] * v0[1]) + (v0[2] * v0[2] + v0[3] * v0[3]) + (v1[0] * v1[0] + v1[1] * v1[1]) + (v1[2] * v1[2] + v1[3] * v1[3]);
                    bst8(rb, vo, ROWG * QL * 2 + bj * 256, v0, v1); }
                s += __shfl_xor(s, 16); s += __shfl_xor(s, 32);
                if (fq == 0) __builtin_amdgcn_raw_buffer_store_b32(__float_as_uint(s), rq, vs + ROWG * 32, 0, 0); }
        } else if (pn == 2) {
            const rsrc_t rb = mk_rsrc(CKV + r0 * KVL, TILE_BYTES(KVL * 2)), rq = mk_rsrc(ssqkv + r0 * 4, 256 * 16);
            const unsigned vo = (unsigned)(lr * KVL + cl) * 2u, vs = (unsigned)(lr * 4 + wc) * 4u;
            FOR_AI_M { float s = 0.f;
#pragma unroll
                for (int bj = 0; bj < 2; ++bj) { const f32x4 v0 = acc[ai][bj][m][0], v1 = acc[ai][bj][m][1];
                    s += (v0[0] * v0[0] + v0[1] * v0[1]) + (v0[2] * v0[2] + v0[3] * v0[3]) + (v1[0] * v1[0] + v1[1] * v1[1]) + (v1[2] * v1[2] + v1[3] * v1[3]);
                    bst8(rb, vo, ROWG * KVL * 2 + bj * 256, v0, v1); }
                s += __shfl_xor(s, 16); s += __shfl_xor(s, 32);
                if (fq == 0) __builtin_amdgcn_raw_buffer_store_b32(__float_as_uint(s), rq, vs + ROWG * 16, 0, 0); }
        } else if (pn < 7) {
            const rsrc_t rb = mk_rsrc(U + r0 * SW + (pn - 3) * 256, TILE_BYTES(SW * 2)); const unsigned vo = (unsigned)(lr * SW + cl) * 2u;
            FOR_AI_M {
#pragma unroll
                for (int bj = 0; bj < 2; ++bj) bst8(rb, vo, ROWG * SW * 2 + bj * 256, acc[ai][bj][m][0], acc[ai][bj][m][1]); }
        } else if (pn < 23) {
            const int colt = (pn - (pn < 15 ? 7 : 15)) * 256;
            const rsrc_t rb = mk_rsrc((pn < 15 ? GA : GB) + r0 * DM + colt, TILE_BYTES(DM * 2)); const unsigned vo = (unsigned)(lr * DM + cl) * 2u;
            const float* bb = bgate + (pn < 15 ? 0 : DM) + colt + cl;
            f32x4 bv[2][2];
#pragma unroll
            for (int bj = 0; bj < 2; ++bj) { bv[bj][0] = *(const f32x4*)(bb + bj * 128); bv[bj][1] = *(const f32x4*)(bb + bj * 128 + 4); }
            FOR_AI_M {
#pragma unroll
                for (int bj = 0; bj < 2; ++bj) { f32x4 v0 = acc[ai][bj][m][0] + bv[bj][0], v1 = acc[ai][bj][m][1] + bv[bj][1];
#pragma unroll
                    for (int e = 0; e < 4; ++e) { v0[e] = sigm(v0[e]); v1[e] = sigm(v1[e]); }
#ifdef DBG_PLAINGATE
                    v0 = acc[ai][bj][m][0]; v1 = acc[ai][bj][m][1];
#endif
#ifdef DBG_BIASONLY
#pragma unroll
                    for (int e = 0; e < 4; ++e) { float t0 = acc[ai][bj][m][0][e] + bv[bj][0][e], t1 = acc[ai][bj][m][1][e] + bv[bj][1][e]; asm volatile("" : "+v"(t0), "+v"(t1)); v0[e] = t0; v1[e] = t1; }
#endif
                    bst8(rb, vo, ROWG * DM * 2 + bj * 256, v0, v1); } }
        } else if (wc == 0) {
            const rsrc_t rb = mk_rsrc(KPE + r0 * 64, 256 * 128), rc = mk_rsrc(cosT + r0 * 32, 256 * 128), rs_ = mk_rsrc(sinT + r0 * 32, 256 * 128);
            const unsigned vo = (unsigned)(lr * 64 + 8 * fq) * 2u, vt = (unsigned)(lr * 32 + 8 * fq) * 4u;
            FOR_AI_M {
                const f32x4 c0 = bldf4(rc, vt, ROWG * 128), c1 = bldf4(rc, vt, ROWG * 128 + 16), s0 = bldf4(rs_, vt, ROWG * 128), s1 = bldf4(rs_, vt, ROWG * 128 + 16);
                const f32x4 x10 = acc[ai][0][m][0], x11 = acc[ai][0][m][1], x20 = acc[ai][1][m][0], x21 = acc[ai][1][m][1];
                bst8(rb, vo, ROWG * 128, x10 * c0 - x20 * s0, x11 * c1 - x21 * s1);
                bst8(rb, vo, ROWG * 128 + 64, x10 * s0 + x20 * c0, x11 * s1 + x21 * c1);
                asm volatile("" ::: "memory"); }
        }
    }
};
struct EpiQ { EPI_HDR
    bf16* Q; const float *ssqq, *cosT, *sinT;
    __device__ __forceinline__ void operator()(EPI_ARGS) const {
        constexpr int PQ = NH * DQK * 2;
        const int pn = u.pn, lr = wr * 64 + fr, cl = wc * 32 + 8 * fq; const size_t r0 = (size_t)u.pm * 256;
        const rsrc_t rq = mk_rsrc(ssqq + r0 * 8, 256 * 32), rb = mk_rsrc(Q + r0 * (NH * DQK), TILE_BYTES(PQ));
        const unsigned vs = (unsigned)lr * 32u;
        if (pn < 8) {
            const unsigned vo = (unsigned)lr * PQ + (unsigned)(2 * pn * DQK + cl) * 2u;
            FOR_AI_M { const f32x4 sa = bldf4(rq, vs, ROWG * 32), sb = bldf4(rq, vs, ROWG * 32 + 16);
                const float rs = rsqrtf((((sa[0] + sa[1]) + (sa[2] + sa[3])) + ((sb[0] + sb[1]) + (sb[2] + sb[3]))) * (1.0f / QL) + EPS) * QSCALE;
#pragma unroll
                for (int bj = 0; bj < 2; ++bj) bst8(rb, vo, ROWG * PQ + bj * DQK * 2, acc[ai][bj][m][0] * rs, acc[ai][bj][m][1] * rs);
                asm volatile("" ::: "memory"); }
        } else {
            const rsrc_t rc = mk_rsrc(cosT + r0 * 32, 256 * 128), rs_ = mk_rsrc(sinT + r0 * 32, 256 * 128);
            const unsigned vo = (unsigned)lr * PQ + (unsigned)((4 * (pn - 8) + wc) * DQK + 128 + 8 * fq) * 2u, vt = (unsigned)(lr * 32 + 8 * fq) * 4u;
            FOR_AI_M { const f32x4 sa = bldf4(rq, vs, ROWG * 32), sb = bldf4(rq, vs, ROWG * 32 + 16);
                const float rs = rsqrtf((((sa[0] + sa[1]) + (sa[2] + sa[3])) + ((sb[0] + sb[1]) + (sb[2] + sb[3]))) * (1.0f / QL) + EPS) * QSCALE;
                const f32x4 c0 = bldf4(rc, vt, ROWG * 128) * rs, c1 = bldf4(rc, vt, ROWG * 128 + 16) * rs, s0 = bldf4(rs_, vt, ROWG * 128) * rs, s1 = bldf4(rs_, vt, ROWG * 128 + 16) * rs;
                const f32x4 x10 = acc[ai][0][m][0], x11 = acc[ai][0][m][1], x20 = acc[ai][1][m][0], x21 = acc[ai][1][m][1];
                bst8(rb, vo, ROWG * PQ, x10 * c0 - x20 * s0, x11 * c1 - x21 * s1);
                bst8(rb, vo, ROWG * PQ + 64, x10 * s0 + x20 * c0, x11 * s1 + x21 * c1);
                asm volatile("" ::: "memory"); }
        }
    }
};
struct EpiKV { EPI_HDR
    bf16* KV; const float* ssqkv;
    __device__ __forceinline__ void operator()(EPI_ARGS) const {
        const int lr = wr * 64 + fr, cl = wc * 32 + 8 * fq; const size_t r0 = (size_t)u.pm * 256;
        const rsrc_t rq = mk_rsrc(ssqkv + r0 * 4, 256 * 16), rb = mk_rsrc(KV + r0 * 4096 + u.pn * 256, TILE_BYTES(8192));
        const unsigned vs = (unsigned)lr * 16u, vo = (unsigned)(lr * 4096 + cl) * 2u;
        FOR_AI_M { const f32x4 sa = bldf4(rq, vs, ROWG * 16);
            const float rs = rsqrtf(((sa[0] + sa[1]) + (sa[2] + sa[3])) * (1.0f / KVL) + EPS);
#pragma unroll
            for (int bj = 0; bj < 2; ++bj) bst8(rb, vo, ROWG * 8192 + bj * 256, acc[ai][bj][m][0] * rs, acc[ai][bj][m][1] * rs);
            asm volatile("" ::: "memory"); }
    }
};
struct EpiWo { EPI_HDR
    bf16* GA;
    __device__ __forceinline__ void operator()(EPI_ARGS) const {
        const int lr = wr * 64 + fr, cl = wc * 32 + 8 * fq; const size_t r0 = (size_t)u.pm * 256;
        const rsrc_t rb = mk_rsrc(GA + r0 * DM + u.pn * 256, TILE_BYTES(DM * 2)); const unsigned vo = (unsigned)(lr * DM + cl) * 2u;
        FOR_AI_M {
#pragma unroll
            for (int bj = 0; bj < 2; ++bj) { f32x4 g0, g1; bld8(rb, vo, ROWG * DM * 2 + bj * 256, g0, g1); bst8(rb, vo, ROWG * DM * 2 + bj * 256, g0 * acc[ai][bj][m][0], g1 * acc[ai][bj][m][1]); }
            asm volatile("" ::: "memory"); }
    }
};
struct EpiGlu { EPI_HDR
    bf16 *GA, *GB; const float* bglu;
    __device__ __forceinline__ void operator()(EPI_ARGS) const {
        const int lr = wr * 64 + fr, j0 = u.pn * 128 + wc * 32 + 8 * fq; const size_t r0 = (size_t)u.pm * 256;
        const rsrc_t ra = mk_rsrc(GA + r0 * DM, TILE_BYTES(DM * 2)), rb = mk_rsrc(GB + r0 * DM, TILE_BYTES(DM * 2)); const unsigned vo = (unsigned)(lr * DM + j0) * 2u;
        const f32x4 bv0 = *(const f32x4*)(bglu + j0), bv1 = *(const f32x4*)(bglu + j0 + 4), bg0 = *(const f32x4*)(bglu + DM + j0), bg1 = *(const f32x4*)(bglu + DM + j0 + 4);
        FOR_AI_M {
            f32x4 v0 = acc[ai][0][m][0] + bv0, v1 = acc[ai][0][m][1] + bv1, g0 = acc[ai][1][m][0] + bg0, g1 = acc[ai][1][m][1] + bg1;
#pragma unroll
            for (int e = 0; e < 4; ++e) { v0[e] *= sigm(g0[e]); v1[e] *= sigm(g1[e]); }
            f32x4 m0, m1, q0, q1; bld8(ra, vo, ROWG * DM * 2, m0, m1); bld8(rb, vo, ROWG * DM * 2, q0, q1);
            bst8(ra, vo, ROWG * DM * 2, m0 + q0 * v0, m1 + q1 * v1);
            asm volatile("" ::: "memory"); }
    }
};
struct EpiPlain { EPI_HDR
    bf16* O;
    __device__ __forceinline__ void operator()(EPI_ARGS) const {
        const int lr = wr * 64 + fr, cl = wc * 32 + 8 * fq; const size_t r0 = (size_t)u.pm * 256;
        const rsrc_t rb = mk_rsrc(O + r0 * DM + u.pn * 256, TILE_BYTES(DM * 2)); const unsigned vo = (unsigned)(lr * DM + cl) * 2u;
        FOR_AI_M {
#pragma unroll
            for (int bj = 0; bj < 2; ++bj) bst8(rb, vo, ROWG * DM * 2 + bj * 256, acc[ai][bj][m][0], acc[ai][bj][m][1]); }
    }
};
struct EpiSwiGlu { EPI_HDR
    bf16* HID;
    __device__ __forceinline__ void operator()(EPI_ARGS) const {
        const int lr = wr * 64 + fr, j0 = u.pn * 128 + wc * 32 + 8 * fq; const size_t r0 = (size_t)u.pm * 256;
        const rsrc_t rb = mk_rsrc(HID + r0 * FF, TILE_BYTES(FF * 2)); const unsigned vo = (unsigned)(lr * FF + j0) * 2u;
        FOR_AI_M {
            f32x4 g0 = acc[ai][0][m][0], g1 = acc[ai][0][m][1];
#pragma unroll
            for (int e = 0; e < 4; ++e) { g0[e] *= sigm(g0[e]); g1[e] *= sigm(g1[e]); }
            bst8(rb, vo, ROWG * FF * 2, g0 * acc[ai][1][m][0], g1 * acc[ai][1][m][1]); }
    }
};

template <class Epi> __device__ __forceinline__ void run_gemm(Ctx& C, const bf16* A, const bf16* Bt, int N, int K, const Epi& E) {
    int Kv = K, Nv = N; asm volatile("" : "+s"(Kv), "+s"(Nv));
    pg8::Gemm g{A, Bt, T, Nv, Kv}; pg8::StaticOrder S; S.init(T, Nv, C.G, C.bid);
    pg8::gemm_phase<Epi, pg8::StaticOrder, MK_ALIGN, true>(C.lds, g, S, E);
}

__device__ __forceinline__ void row_pass(const float* xin, const bf16* delta, const float* wpost, float* xout, const float* wpre, bf16* hout, int lane) {
    f32x4 x[8];
#pragma unroll
    for (int j = 0; j < 8; ++j) x[j] = ((const f32x4*)xin)[64 * j + lane];
    if (delta) {
        f32x4 d[8]; float s = 0.f;
#pragma unroll
        for (int j = 0; j < 8; ++j) { const u32x2 w = ((const u32x2*)delta)[64 * j + lane]; d[j] = (f32x4){bflo(w.x), bfhi(w.x), bflo(w.y), bfhi(w.y)};
            s += (d[j][0] * d[j][0] + d[j][1] * d[j][1]) + (d[j][2] * d[j][2] + d[j][3] * d[j][3]); }
        const float rs = rsqrtf(wave_sum(s) * (1.0f / DM) + EPS);
#pragma unroll
        for (int j = 0; j < 8; ++j) { const f32x4 w = ((const f32x4*)wpost)[64 * j + lane]; x[j] = x[j] + d[j] * rs * w; }
        if (xout) {
#pragma unroll
            for (int j = 0; j < 8; ++j) ((f32x4*)xout)[64 * j + lane] = x[j]; }
    }
    if (hout) {
        float s = 0.f;
#pragma unroll
        for (int j = 0; j < 8; ++j) s += (x[j][0] * x[j][0] + x[j][1] * x[j][1]) + (x[j][2] * x[j][2] + x[j][3] * x[j][3]);
        const float rs = rsqrtf(wave_sum(s) * (1.0f / DM) + EPS);
#pragma unroll
        for (int j = 0; j < 8; ++j) { const f32x4 w = ((const f32x4*)wpre)[64 * j + lane]; const f32x4 h = x[j] * rs * w;
            u32x2 o; o.x = cvt_pk_bf16(h[0], h[1]); o.y = cvt_pk_bf16(h[2], h[3]); ((u32x2*)hout)[64 * j + lane] = o; }
    }
}

__device__ __forceinline__ void tr_item(const float* src, int lds_, bf16* dst, int ldd, const float* ksc, LAS float* scr, int lane) {
#pragma unroll 8
    for (int i = 0; i < 32; ++i) { const int kk = 2 * i + (lane >> 5); float v = src ? src[(size_t)kk * lds_ + (lane & 31)] : 0.f; if (ksc) v *= ksc[kk]; scr[kk * 33 + (lane & 31)] = v; }
    LDS_WAIT(); asm volatile("" ::: "memory");
    const int c = lane & 7;
#pragma unroll
    for (int j = 0; j < 4; ++j) { const int n = (lane >> 3) + 8 * j; const LAS float* s = scr + (8 * c) * 33 + n;
        u32x4 o; o.x = pk2(s[0 * 33], s[1 * 33]); o.y = pk2(s[2 * 33], s[3 * 33]); o.z = pk2(s[4 * 33], s[5 * 33]); o.w = pk2(s[6 * 33], s[7 * 33]);
        *(u32x4*)(dst + (size_t)n * ldd + 8 * c) = o; }
    LDS_WAIT(); asm volatile("" ::: "memory");
}
constexpr int IT_WIN = 32 * 192, IT_WUQ = 8 * 96, IT_WUKV = 4 * 128, IT_WO = 32 * 64, IT_WGLU = 16 * 128, IT_WOUT = 32 * 64, IT_WGU = 32 * 352, IT_WDN = 88 * 64;
constexpr int IT_ALL = IT_WIN + IT_WUQ + IT_WUKV + IT_WO + IT_WGLU + IT_WOUT + IT_WGU + IT_WDN;
__device__ __forceinline__ void convert_weights(Ctx& C, int l) {
    LAS float* scr = (LAS float*)(C.lds + C.wave * 16384);
    const int gw = C.bid * NWAVES + C.wave, NGW = C.G * NWAVES, lane = C.lane;
    for (int it = gw; it < IT_ALL; it += NGW) {
        int r = it;
        if (r < IT_WIN) { const int kb = r / 192, nb = r % 192, n0 = nb * 32, k0 = kb * 64; int sc = -1;
            if (n0 < 768) sc = n0; else if (n0 < 5888) sc = n0 + 64; else if (n0 == 5888) sc = 768; else if (n0 == 5888 + 128) sc = 800;
            const float* W = C_in(I_WIN) + (size_t)l * DM * INW;
            tr_item(sc >= 0 ? W + (size_t)k0 * INW + sc : nullptr, INW, C_Win + (size_t)n0 * DM + k0, DM, nullptr, scr, lane); continue; } r -= IT_WIN;
        if (r < IT_WUQ) { const int kb = r / 96, nb = r % 96, n0 = nb * 32, k0 = kb * 64; int sc;
            if (n0 < 2048) sc = (n0 >> 7) * DQK + (n0 & 127); else { const int rr = n0 - 2048, t = rr >> 8, c = rr & 255, bj = c >> 7, hh = (c & 127) >> 5; sc = (4 * t + hh) * DQK + 128 + bj * 32; }
            const float* W = C_in(I_WUQ) + (size_t)l * QL * (NH * DQK);
            tr_item(W + (size_t)k0 * (NH * DQK) + sc, NH * DQK, C_Wuq + (size_t)n0 * QL + k0, QL, C_in(I_QNORM) + l * QL + k0, scr, lane); continue; } r -= IT_WUQ;
        if (r < IT_WUKV) { const int kb = r / 128, nb = r % 128, n0 = nb * 32, k0 = kb * 64;
            const float* W = C_in(I_WUKV) + (size_t)l * KVL * 4096;
            tr_item(W + (size_t)k0 * 4096 + n0, 4096, C_Wukv + (size_t)n0 * KVL + k0, KVL, C_in(I_KVNORM) + l * KVL + k0, scr, lane); continue; } r -= IT_WUKV;
        if (r < IT_WO) { const int kb = r / 64, nb = r % 64, n0 = nb * 32, k0 = kb * 64;
            const float* W = C_in(I_WO) + (size_t)l * DM * DM;
            tr_item(W + (size_t)k0 * DM + n0, DM, C_Wo + (size_t)n0 * DM + k0, DM, nullptr, scr, lane); continue; } r -= IT_WO;
        if (r < IT_WGLU) { const int kb = r / 128, nb = r % 128, n0 = nb * 32, k0 = kb * 64; const int t = n0 >> 8, bj = (n0 >> 7) & 1, i0 = n0 & 127;
            const float* W = C_in(I_WGLU) + (size_t)l * SW * 4096;
            tr_item(W + (size_t)k0 * 4096 + bj * DM + t * 128 + i0, 4096, C_Wglu + (size_t)n0 * SW + k0, SW, nullptr, scr, lane); continue; } r -= IT_WGLU;
        if (r < IT_WOUT) { const int kb = r / 64, nb = r % 64, n0 = nb * 32, k0 = kb * 64;
            const float* W = C_in(I_WOUT) + (size_t)l * DM * DM;
            tr_item(W + (size_t)k0 * DM + n0, DM, C_Wout + (size_t)n0 * DM + k0, DM, nullptr, scr, lane); continue; } r -= IT_WOUT;
        if (r < IT_WGU) { const int kb = r / 352, nb = r % 352, n0 = nb * 32, k0 = kb * 64; const int t = n0 >> 8, bj = (n0 >> 7) & 1, i0 = n0 & 127;
            const float* W = (bj ? C_in(I_WFU) : C_in(I_WFG)) + (size_t)l * DM * FF;
            tr_item(W + (size_t)k0 * FF + t * 128 + i0, FF, C_Wgu + (size_t)n0 * DM + k0, DM, nullptr, scr, lane); continue; } r -= IT_WGU;
        { const int kb = r / 64, nb = r % 64, n0 = nb * 32, k0 = kb * 64;
            const float* W = C_in(I_WFD) + (size_t)l * FF * DM;
            tr_item(W + (size_t)k0 * DM + n0, DM, C_Wdn + (size_t)n0 * FF + k0, FF, nullptr, scr, lane); }
    }
}

__device__ __forceinline__ void rope_tables(Ctx& C) {
    const int* pos = (const int*)C_in(I_POS); float* cT = C_cosT; float* sT = C_sinT;
    for (int i = C.bid * 512 + C.tid; i < T * 32; i += C.G * 512) { const int row = i >> 5, k = i & 31;
        const float inv = __builtin_amdgcn_exp2f(-(float)k * (13.287712379549449f / 32.0f));
        const float ang = (float)pos[row] * inv;
        cT[i] = cosf(ang); sT[i] = sinf(ang); }
}
__device__ __forceinline__ void ssm_lp(Ctx& C, int l) {
    const float* are = C_in(I_ARE) + l * SG * SN; const float* aim = C_in(I_AIM) + l * SG * SN; const float* ldt = C_in(I_LOGDT) + l * SG; f32x2* LPp = C_LP; f32x2* FBp = C_FB;
    for (int i = C.bid * 512 + C.tid; i < SG * 65 * SN; i += C.G * 512) { const int n = i & 63, d = (i >> 6) % 65, g = i / (65 * 64);
        const float dt = expf(ldt[g]), ar = are[g * SN + n], ai = aim[g * SN + n];
        const float e = expf((float)d * (ar * dt)), ang = (float)d * (ai * dt); const float s = sinf(ang), c = cosf(ang);
        LPp[i] = (f32x2){e * c, e * s};
        if (d == 1) { const float lr = e * c, li = e * s, nr = lr - 1.0f, den = ar * ar + ai * ai;
            FBp[g * SN + n] = (f32x2){(nr * ar + li * ai) / den, (li * ar - nr * ai) / den}; } }
}
__device__ __forceinline__ void ssm_tables(Ctx& C, int l) {
    const float* bre = C_in(I_BRE) + (size_t)l * SG * SN * SP; const float* bim = C_in(I_BIM) + (size_t)l * SG * SN * SP;
    const float* cre = C_in(I_CRE) + (size_t)l * SG * SP * SN; const float* cim = C_in(I_CIM) + (size_t)l * SG * SP * SN;
    const int gt = C.bid * 512 + C.tid, NT_ = C.G * 512;
    for (int i = gt; i < SG * 65 * 256; i += NT_) { const int pp = i & 15, p = (i >> 4) & 15, dd = (i >> 8) % 65, g = i / (65 * 256); float sum = 0.f;
        if (dd > 0) { const f32x2* lp = C_LP + (size_t)(g * 65 + dd - 1) * 64; const f32x2* fb = C_FB + g * SN;
            for (int n = 0; n < SN; ++n) { const f32x2 L = lp[n], f = fb[n]; const float br = bre[(g * SN + n) * SP + pp], bi = bim[(g * SN + n) * SP + pp];
                const float Br = f.x * br - f.y * bi, Bi = f.x * bi + f.y * br, wr_ = L.x * Br - L.y * Bi, wi_ = L.x * Bi + L.y * Br;
                sum += cre[(g * SP + p) * SN + n] * wr_ - cim[(g * SP + p) * SN + n] * wi_; } }
        C_KD[i] = (bf16)f2bf(sum); }
    for (int i = gt; i < SG * 64 * 128; i += NT_) { const int ncol = i & 127, j = (i >> 7) & 63, g = i >> 13, n = ncol & 63, part = ncol >> 6;
        const f32x2 L = C_LP[(size_t)(g * 65 + 63 - j) * 64 + n], f = C_FB[g * SN + n]; float o[16];
#pragma unroll
        for (int pp = 0; pp < 16; ++pp) { const float br = bre[(g * SN + n) * SP + pp], bi = bim[(g * SN + n) * SP + pp];
            const float Br = f.x * br - f.y * bi, Bi = f.x * bi + f.y * br; o[pp] = part ? (L.x * Bi + L.y * Br) : (L.x * Br - L.y * Bi); }
        u32x4 w0, w1; w0.x = pk2(o[0], o[1]); w0.y = pk2(o[2], o[3]); w0.z = pk2(o[4], o[5]); w0.w = pk2(o[6], o[7]); w1.x = pk2(o[8], o[9]); w1.y = pk2(o[10], o[11]); w1.z = pk2(o[12], o[13]); w1.w = pk2(o[14], o[15]);
        u32x4* dst = (u32x4*)(C_MAT + (size_t)i * 16); dst[0] = w0; dst[1] = w1; }
    for (int i = gt; i < SG * 8 * 1024; i += NT_) { const int p = i & 15, j = (i >> 4) & 63, kk = (i >> 10) & 7, g = i >> 13; float o[16];
#pragma unroll
        for (int k = 0; k < 16; ++k) { const int kq = kk * 16 + k, n = kq & 63, part = kq >> 6; const f32x2 L = C_LP[(size_t)(g * 65 + j + 1) * 64 + n];
            const float cr = cre[(g * SP + p) * SN + n], ci = cim[(g * SP + p) * SN + n]; o[k] = part ? -(cr * L.y + ci * L.x) : (cr * L.x - ci * L.y); }
        u32x4 w0, w1; w0.x = pk2(o[0], o[1]); w0.y = pk2(o[2], o[3]); w0.z = pk2(o[4], o[5]); w0.w = pk2(o[6], o[7]); w1.x = pk2(o[8], o[9]); w1.y = pk2(o[10], o[11]); w1.z = pk2(o[12], o[13]); w1.w = pk2(o[14], o[15]);
        u32x4* dst = (u32x4*)(C_CCT + (size_t)i * 16); dst[0] = w0; dst[1] = w1; }
}

__device__ __forceinline__ int crow(int r, int hi) { return (r & 3) + 8 * (r >> 2) + 4 * hi; }
__device__ __forceinline__ f32x16 mfma32(bf16x8 a, bf16x8 b, f32x16 c) { return __builtin_amdgcn_mfma_f32_32x32x16_bf16(a, b, c, 0, 0, 0); }
__device__ __forceinline__ void ssm_states(Ctx& C) {
    const int lane = C.lane, r32 = lane & 31, hi = lane >> 5, mt = C.wave >> 2, nblk = C.wave & 3;
    LAS float* SL = (LAS float*)C.lds;
    for (int unit = C.bid; unit < SG * BATCH; unit += C.G) { const int g = unit >> 3, b = unit & 7;
        f32x16 acc = {};
        const bf16* ap = C_U + ((size_t)(b * SEQ + (32 * mt + r32) * 64)) * SW + g * 16 + hi * 8;
        const bf16* bp = C_MAT + ((size_t)(g * 64) * 128 + nblk * 32 + r32) * 16 + hi * 8;
#pragma unroll 8
        for (int j = 0; j < 64; ++j) { const bf16x8 a = *(const bf16x8*)(ap + (size_t)j * SW), bb = *(const bf16x8*)(bp + (size_t)j * 128 * 16); acc = mfma32(a, bb, acc); }
#pragma unroll
        for (int r = 0; r < 16; ++r) SL[(32 * mt + crow(r, hi)) * 128 + 32 * nblk + r32] = acc[r];
        LDS_WAIT(); __syncthreads();
        if (C.tid < 64) { const int n = C.tid; const f32x2 lam = C_LP[(size_t)(g * 65 + 64) * 64 + n]; float xr = 0.f, xi = 0.f;
            bf16* xp = C_XST + ((size_t)(b * 64) * 64 + g) * 128 + n;
            for (int c = 0; c < 64; ++c) { xp[(size_t)c * 64 * 128] = (bf16)f2bf(xr); xp[(size_t)c * 64 * 128 + 64] = (bf16)f2bf(xi);
                const float sr = SL[c * 128 + n], si = SL[c * 128 + 64 + n]; const float nr = lam.x * xr - lam.y * xi + sr, ni = lam.x * xi + lam.y * xr + si; xr = nr; xi = ni; } }
        LDS_WAIT(); __syncthreads();
    }
}
__device__ __forceinline__ float gelu_tanh(float y) { return y * sigm(1.5957691216057308f * (y + 0.044715f * y * y * y)); }
__device__ __forceinline__ void ssm_outputs(Ctx& C, int l) {
    const int lane = C.lane, r32 = lane & 31, hi = lane >> 5, half = C.wave & 1;
    const float* dsk = C_in(I_SSMD) + l * SW;
    for (int unit = C.bid; unit < 16 * 16; unit += C.G) { const int gb = unit >> 4, mt = unit & 15, g = 4 * gb + (C.wave >> 1), b = mt >> 1, c0 = 32 * (mt & 1);
        const bf16* up = C_U + ((size_t)(b * SEQ + (c0 + r32) * 64)) * SW + g * 16 + hi * 8;
        const bf16* xp = C_XST + ((size_t)((b * 64 + c0 + r32) * 64 + g)) * 128 + hi * 8;
        const bf16* kd = C_KD + (size_t)g * (65 * 256) + r32 * 16 + hi * 8;
        const bf16* cc = C_CCT + ((size_t)(g * 8) * 1024 + r32) * 16 + hi * 8;
        for (int s2 = 0; s2 < 2; ++s2) { const int sp = half ? (2 - s2) : (s2 ? 0 : 3);
            f32x16 acc[8];
#pragma unroll
            for (int nb = 0; nb < 8; ++nb) acc[nb] = (f32x16){};
#pragma unroll 2
            for (int kk = 0; kk < 8; ++kk) { const bf16x8 a = *(const bf16x8*)(xp + kk * 16);
#pragma unroll
                for (int nb = 0; nb < 8; ++nb) { const bf16x8 bb = *(const bf16x8*)(cc + ((size_t)kk * 1024 + (16 * sp + 2 * nb) * 16) * 16); acc[nb] = mfma32(a, bb, acc[nb]); } }
            const int iend = 16 * sp + 15;
            for (int i = 0; i <= iend; ++i) { const bf16x8 a = *(const bf16x8*)(up + (size_t)i * SW);
#pragma unroll
                for (int nb = 0; nb < 8; ++nb) { const int d = 16 * sp + 2 * nb - i;
                    if (d >= -1) { const bf16x8 bb = *(const bf16x8*)(kd + (d + 1) * 256); acc[nb] = mfma32(a, bb, acc[nb]); } } }
            const int p = r32 & 15, toff = r32 >> 4; const float dv = dsk[g * 16 + p];
#pragma unroll
            for (int nb = 0; nb < 8; ++nb)
#pragma unroll
                for (int r = 0; r < 16; ++r) { const size_t tok = (size_t)(b * SEQ + (c0 + crow(r, hi)) * 64 + 16 * sp + 2 * nb + toff); const size_t off = tok * SW + g * 16 + p;
                    const float uu = bflo((unsigned)C_U[off]); const float y = acc[nb][r] + dv * uu; C_Z[off] = (bf16)f2bf(gelu_tanh(y)); }
        }
    }
}

namespace att {
constexpr int LDQ = NH * DQK, LDKV = 4096, LDO = DM;
constexpr int SHM_V = 16384, SHM_K = 16384, SHM_KP = 8192;
constexpr int OFF_V = 0, OFF_K = 2 * SHM_V, OFF_KP = OFF_K + 2 * SHM_K, OFF_WS = OFF_KP + 2 * SHM_KP, ATT_LDS = OFF_WS + NWAVES * 64 * 4;
constexpr float THRL = 11.5f;
#define KSWZ(row, colB) ((row) * 256 + ((colB) ^ (((row) & 7) << 4)))
#define KPSWZ(row, colB) ((row) * 128 + ((colB) ^ (((row) & 7) << 4)))
#define SBAR() __builtin_amdgcn_sched_barrier(0)
__device__ __forceinline__ void partialSM(f32x16& p0, f32x16& p1, float& m_reg, float& mn, float& alpha, bool dead) {
    if (dead) {
#pragma unroll
        for (int r = 0; r < 16; ++r) { p0[r] = -1e30f; p1[r] = -1e30f; } }
    float pmax = p0[0];
#pragma unroll
    for (int r = 1; r < 16; ++r) pmax = fmaxf(pmax, p0[r]);
#pragma unroll
    for (int r = 0; r < 16; ++r) pmax = fmaxf(pmax, p1[r]);
    { auto rr = __builtin_amdgcn_permlane32_swap(__float_as_uint(pmax), __float_as_uint(pmax), false, false); pmax = fmaxf(__uint_as_float(rr[0]), __uint_as_float(rr[1])); }
    if (__builtin_expect(__all(pmax - m_reg <= THRL), 1)) { mn = m_reg; alpha = 1.f; }
    else { mn = fmaxf(m_reg, pmax); alpha = __builtin_amdgcn_exp2f(m_reg - mn); m_reg = mn; }
#pragma unroll
    for (int r = 0; r < 16; ++r) p0[r] = p0[r] - mn;
#pragma unroll
    for (int r = 0; r < 16; ++r) p1[r] = p1[r] - mn;
#pragma unroll
    for (int r = 0; r < 16; ++r) p0[r] = __builtin_amdgcn_exp2f(p0[r]);
}
__device__ __forceinline__ void finishSM(f32x16& p0, f32x16& p1, float alpha, float& l_reg, bf16x8& pa0, bf16x8& pa1, bf16x8& pa2, bf16x8& pa3) {
#pragma unroll
    for (int r = 0; r < 16; ++r) p1[r] = __builtin_amdgcn_exp2f(p1[r]);
    float ps = 0;
#pragma unroll
    for (int r = 0; r < 16; ++r) ps += p0[r];
#pragma unroll
    for (int r = 0; r < 16; ++r) ps += p1[r];
    { auto rr = __builtin_amdgcn_permlane32_swap(__float_as_uint(ps), __float_as_uint(ps), false, false); ps = __uint_as_float(rr[0]) + __uint_as_float(rr[1]); }
    l_reg = l_reg * alpha + ps;
#define PK4(P, BASE, OUT) do { unsigned a0 = cvt_pk_bf16(P[BASE + 0], P[BASE + 1]), a1 = cvt_pk_bf16(P[BASE + 2], P[BASE + 3]);   \
    unsigned b0 = cvt_pk_bf16(P[BASE + 4], P[BASE + 5]), b1 = cvt_pk_bf16(P[BASE + 6], P[BASE + 7]);                              \
    auto r0 = __builtin_amdgcn_permlane32_swap(a0, b0, false, false); auto r1 = __builtin_amdgcn_permlane32_swap(a1, b1, false, false); \
    u32x4 w = {r0[0], r1[0], r0[1], r1[1]}; OUT = *reinterpret_cast<bf16x8*>(&w); } while (0)
    PK4(p0, 0, pa0); PK4(p0, 8, pa1); PK4(p1, 0, pa2); PK4(p1, 8, pa3);
#undef PK4
}
__device__ __forceinline__ void qkt(f32x16& p0, f32x16& p1, const LAS char* Ks, const LAS char* KPs, const bf16x8* qr, int r32, int hi) {
    p0 = f32x16{}; p1 = f32x16{};
#pragma unroll
    for (int d0 = 0; d0 < 8; ++d0) { const int cb = (d0 * 16 + hi * 8) * 2;
        const bf16x8 b0 = *(const LAS bf16x8*)(Ks + KSWZ(r32, cb)), b1 = *(const LAS bf16x8*)(Ks + KSWZ(32 + r32, cb));
        p0 = mfma32(b0, qr[d0], p0); p1 = mfma32(b1, qr[d0], p1); }
#pragma unroll
    for (int d0 = 0; d0 < 4; ++d0) { const int cb = (d0 * 16 + hi * 8) * 2;
        const bf16x8 b0 = *(const LAS bf16x8*)(KPs + KPSWZ(r32, cb)), b1 = *(const LAS bf16x8*)(KPs + KPSWZ(32 + r32, cb));
        p0 = mfma32(b0, qr[8 + d0], p0); p1 = mfma32(b1, qr[8 + d0], p1); }
}
__device__ __forceinline__ int v_st(int k, int c) { const int kk = (k & ~0xC) | ((k & 4) << 1) | ((k & 8) >> 1); return ((kk >> 3) * 4 + (c >> 5)) * 512 + ((kk & 7) * 32 + (c & 31)) * 2; }
__device__ __forceinline__ int v_rd_base(int lane) { return ((lane & 3) << 3) | (((lane >> 2) & 3) << 6) | (((lane >> 4) & 1) << 5) | (((lane >> 5) & 1) << 8); }
constexpr int v_rd_off(int d0, int ks, int half) { return d0 * 512 + ks * 4096 + half * 2048; }
template <int OFF> __device__ __forceinline__ s16x4 tr_read(int vb) { s16x4 r; asm volatile("ds_read_b64_tr_b16 %0, %1 offset:%2" : "=&v"(r) : "v"(vb), "i"(OFF) : "memory"); return r; }
template <int D0> __device__ __forceinline__ void pv_one(f32x16& od, int vb, bf16x8 pa0, bf16x8 pa1, bf16x8 pa2, bf16x8 pa3) {
    const s16x4 l0 = tr_read<v_rd_off(D0, 0, 0)>(vb), h0 = tr_read<v_rd_off(D0, 0, 1)>(vb), l1 = tr_read<v_rd_off(D0, 1, 0)>(vb), h1 = tr_read<v_rd_off(D0, 1, 1)>(vb);
    const s16x4 l2 = tr_read<v_rd_off(D0, 2, 0)>(vb), h2 = tr_read<v_rd_off(D0, 2, 1)>(vb), l3 = tr_read<v_rd_off(D0, 3, 0)>(vb), h3 = tr_read<v_rd_off(D0, 3, 1)>(vb);
    asm volatile("s_waitcnt lgkmcnt(0)" ::: "memory"); SBAR();
#define PK(L, H) (bf16x8){L[0], L[1], L[2], L[3], H[0], H[1], H[2], H[3]}
    od = mfma32(pa0, PK(l0, h0), od); od = mfma32(pa1, PK(l1, h1), od); od = mfma32(pa2, PK(l2, h2), od); od = mfma32(pa3, PK(l3, h3), od);
#undef PK
}
__device__ __forceinline__ void pv_d0(f32x16* o, int vb, bf16x8 pa0, bf16x8 pa1, bf16x8 pa2, bf16x8 pa3) {
    pv_one<0>(o[0], vb, pa0, pa1, pa2, pa3); pv_one<1>(o[1], vb, pa0, pa1, pa2, pa3); pv_one<2>(o[2], vb, pa0, pa1, pa2, pa3); pv_one<3>(o[3], vb, pa0, pa1, pa2, pa3);
}
__device__ __forceinline__ void attn_unit(const bf16* __restrict__ Q, const bf16* __restrict__ KV, const bf16* __restrict__ KPE, bf16* __restrict__ O, int b, int h, int qb, LAS char* lds) {
    const int tid = pg8::opaque_tid(), wid = __builtin_amdgcn_readfirstlane(tid >> 6), lane = tid & 63, r32 = lane & 31, hi = lane >> 5;
    LAS char* V_lds = lds + OFF_V; LAS char* K_lds = lds + OFF_K; LAS char* KP_lds = lds + OFF_KP;
    LAS float* ws = (LAS float*)(lds + OFF_WS) + wid * 64; LAS float* li_l = ws; LAS float* al_l = ws + 32;
    const bf16* Kh = KV + (size_t)(b * SEQ) * LDKV + h * 256; const bf16* Vh = Kh + 128; const bf16* Pb = KPE + (size_t)(b * SEQ) * 64;
    const int NT = 4 * qb + 4, NTw = 4 * qb + (wid >> 1) + 1;
    float m_reg = -1e30f, l_reg = 0; f32x16 o[4] = {}; bf16x8 qr[12];
    const bf16* Qw = Q + (size_t)(b * SEQ + qb * 256 + wid * 32 + r32) * LDQ + h * DQK + hi * 8;
#pragma unroll
    for (int d0 = 0; d0 < 12; ++d0) qr[d0] = *(const bf16x8*)(Qw + d0 * 16);
    const int sr = tid >> 4, sc = (tid & 15) * 8, vst0 = v_st(sr, sc), vst1 = v_st(32 + sr, sc), pr = tid >> 3, pc = (tid & 7) * 8;
    const int vb0 = (int)(unsigned)(uintptr_t)V_lds + v_rd_base(lane);
    bf16x8 vs0, vs1, ks0, ks1, kp0;
#define SLOAD(k0) do { vs0 = *(const bf16x8*)(Vh + (size_t)((k0) + sr) * LDKV + sc); vs1 = *(const bf16x8*)(Vh + (size_t)((k0) + 32 + sr) * LDKV + sc); \
    ks0 = *(const bf16x8*)(Kh + (size_t)((k0) + sr) * LDKV + sc); ks1 = *(const bf16x8*)(Kh + (size_t)((k0) + 32 + sr) * LDKV + sc); kp0 = *(const bf16x8*)(Pb + (size_t)((k0) + pr) * 64 + pc); } while (0)
#define SWRITE(bb) do { *(LAS bf16x8*)(V_lds + (bb) * SHM_V + vst0) = vs0; *(LAS bf16x8*)(V_lds + (bb) * SHM_V + vst1) = vs1; \
    *(LAS bf16x8*)(K_lds + (bb) * SHM_K + KSWZ(sr, sc * 2)) = ks0; *(LAS bf16x8*)(K_lds + (bb) * SHM_K + KSWZ(32 + sr, sc * 2)) = ks1; \
    *(LAS bf16x8*)(KP_lds + (bb) * SHM_KP + KPSWZ(pr, pc * 2)) = kp0; } while (0)
#define RESC(a) do { if (__any((a) < 1.f)) { if (hi == 0) al_l[r32] = (a); asm volatile("s_waitcnt lgkmcnt(0)" ::: "memory"); \
    _Pragma("unroll") for (int d = 0; d < 4; ++d) _Pragma("unroll") for (int r = 0; r < 16; ++r) o[d][r] *= al_l[crow(r, hi)]; } } while (0)
    f32x16 p0, p1; float mn, al; bf16x8 pa0, pa1, pa2, pa3;
    SLOAD(0); asm volatile("s_waitcnt vmcnt(0)" ::: "memory"); SWRITE(0); __syncthreads();
    for (int j = 0; j < NT; ++j) {
        const int bsel = j & 1;
        if (j + 1 < NT) SLOAD((j + 1) * 64);
        SBAR();
        if (j < NTw) {
            qkt(p0, p1, K_lds + bsel * SHM_K, KP_lds + bsel * SHM_KP, qr, r32, hi);
            partialSM(p0, p1, m_reg, mn, al, false);
            RESC(al);
            finishSM(p0, p1, al, l_reg, pa0, pa1, pa2, pa3); SBAR();
            pv_d0(o, vb0 + bsel * SHM_V, pa0, pa1, pa2, pa3);
        }
        SBAR();
        if (j + 1 < NT) { asm volatile("s_waitcnt vmcnt(0)" ::: "memory"); SWRITE(bsel ^ 1); }
        __syncthreads();
    }
    if (hi == 0) li_l[r32] = l_reg; asm volatile("s_waitcnt lgkmcnt(0)" ::: "memory");
    float rli[16];
#pragma unroll
    for (int r = 0; r < 16; ++r) rli[r] = __builtin_amdgcn_rcpf(li_l[crow(r, hi)]);
    bf16* Ow = O + (size_t)(b * SEQ + qb * 256 + wid * 32) * LDO + h * 128;
#pragma unroll
    for (int r = 0; r < 16; ++r) { const int orow = crow(r, hi);
#pragma unroll
        for (int d0 = 0; d0 < 4; ++d0) Ow[(size_t)orow * LDO + d0 * 32 + r32] = (bf16)f2bf(o[d0][r] * rli[r]); }
    __syncthreads();
#undef SLOAD
#undef SWRITE
#undef RESC
}
}
__device__ __forceinline__ void attn_phase(Ctx& C) {
    const int x = C.bid & 7, idx = C.bid >> 3, per = C.G >> 3;
    for (int p = idx; p < 128; p += per) { const int bh = 16 * x + (p >> 3), pr = p & 7, b = bh >> 4, h = bh & 15;
        att::attn_unit(C_Q, C_KV, C_KPE, C_RA, b, h, 15 - pr, (LAS char*)C.lds);
        att::attn_unit(C_Q, C_KV, C_KPE, C_RA, b, h, pr, (LAS char*)C.lds); }
}

#ifndef DBG_DELTA
#define DBG_DELTA C_RA
#endif
__global__ void __launch_bounds__(NWAVES * 64, 2) mk_fwd(Args args) {
    extern __shared__ __attribute__((aligned(16))) unsigned char lds_raw[];
    Ctx C;
    C.lds = (LAS unsigned char*)lds_raw;
    volatile LAS unsigned* MISC = (volatile LAS unsigned*)(C.lds + MISC_OFF);
    C.tid = threadIdx.x; C.lane = C.tid & 63; C.wave = __builtin_amdgcn_readfirstlane(C.tid >> 6); C.G = gridDim.x; C.bid = blockIdx.x;
    C.ka = (const CAS char*)__builtin_amdgcn_kernarg_segment_ptr(); gu32* ctl = (gu32*)(args.ws + WS_CTL);
    for (int u = C.tid; u < (LDS_BYTES - RING_BYTES) / 4; u += NWAVES * 64) ((LAS unsigned*)(C.lds + RING_BYTES))[u] = 0u;
    __syncthreads();
    const int lo = args.ph_lo, hi = args.ph_hi;
    const bool fused = (hi - lo) > 1;
    XcdBarrier bar; bar.bar = (unsigned*)(ctl + CW_BAR); bar.x = 0; bar.st = nullptr;
    if (fused) bar = xcd_barrier_post((unsigned*)(ctl + CW_BAR), MISC + 8);
#ifndef PH_MASK
#define PH_MASK 0x1FFF
#endif
#define IN(k) ((((PH_MASK) >> ((k) >= DEPTH * 12 ? 12 : (k) % 12)) & 1) && lo <= (k) && (k) < hi)
#define PH_FENCE() do { asm volatile("" : "+s"(C.ka), "+v"(C.tid)); C.lane = C.tid & 63; C.wave = __builtin_amdgcn_readfirstlane(C.tid >> 6); } while (0)
#define SEAM(k) do { if ((k) + 1 < hi) { XcdBarrier b2_ = bar; asm volatile("" : "+s"(b2_.bar)); xcd_barrier(b2_); } } while (0)
#define gw (C.bid * NWAVES + C.wave)
#define NGW (C.G * NWAVES)

    for (int l = 0; l < DEPTH; ++l) {
        const int pb = l * 12;
        if (IN(pb + 0)) { PH_FENCE();
            convert_weights(C, l);
            ssm_lp(C, l);
            if (l == 0) rope_tables(C);
            const float* wpre = C_in(I_PREMIX) + l * DM;
            if (l == 0) { for (int m = gw; m < T; m += NGW) row_pass(C_in(I_X) + (size_t)m * DM, nullptr, nullptr, nullptr, wpre, C_RA + (size_t)m * DM, C.lane); }
            else { const float* wpost = C_in(I_POSTFFN) + (l - 1) * DM;
                for (int m = gw; m < T; m += NGW) row_pass(C_out + (size_t)m * DM, C_F + (size_t)m * DM, wpost, C_out + (size_t)m * DM, wpre, C_RA + (size_t)m * DM, C.lane); }
            SEAM(pb + 0);
        }
        if (IN(pb + 1)) { PH_FENCE();
            EpiInProj E{C_CQ, C_CKV, C_KPE, C_U, C_GA, C_GB, C_ssqq, C_ssqkv, C_in(I_BGATE) + l * 2 * DM, C_cosT, C_sinT};
            run_gemm(C, C_RA, C_Win, NIN, DM, E);
            ssm_tables(C, l);
            SEAM(pb + 1);
        }
        if (IN(pb + 2)) { PH_FENCE(); ssm_states(C); SEAM(pb + 2); }
        if (IN(pb + 3)) { PH_FENCE();
#ifndef NO_Q
            { EpiQ E{C_Q, C_ssqq, C_cosT, C_sinT}; run_gemm(C, C_CQ, C_Wuq, NH * DQK, QL, E); }
#endif
#ifndef NO_KV
            { EpiKV E{C_KV, C_ssqkv}; run_gemm(C, C_CKV, C_Wukv, 4096, KVL, E); }
#endif
            SEAM(pb + 3);
        }
        if (IN(pb + 4)) { PH_FENCE(); ssm_outputs(C, l); SEAM(pb + 4); }
        if (IN(pb + 5)) { PH_FENCE(); attn_phase(C); SEAM(pb + 5); }
        if (IN(pb + 6)) { PH_FENCE(); EpiWo E{C_GA}; run_gemm(C, C_RA, C_Wo, DM, DM, E); SEAM(pb + 6); }
        if (IN(pb + 7)) { PH_FENCE(); EpiGlu E{C_GA, C_GB, C_in(I_BGLU) + l * 2 * DM}; run_gemm(C, C_Z, C_Wglu, 4096, SW, E); SEAM(pb + 7); }
        #ifdef DBG_K8
        if (IN(pb + 8)) { PH_FENCE(); EpiPlain E{C_GA}; run_gemm(C, C_RA, C_Wout, DM, DM, E); SEAM(pb + 8); }
#else
        if (IN(pb + 8)) { PH_FENCE(); EpiPlain E{C_RA}; run_gemm(C, C_GA, C_Wout, DM, DM, E); SEAM(pb + 8); }
#endif
        if (IN(pb + 9)) { PH_FENCE();
            const float* xin = (l == 0) ? C_in(I_X) : C_out; const float* wpost = C_in(I_POSTMIX) + l * DM; const float* wpre = C_in(I_PREFFN) + l * DM;
            for (int m = gw; m < T; m += NGW) row_pass(xin + (size_t)m * DM, DBG_DELTA + (size_t)m * DM, wpost, C_out + (size_t)m * DM, wpre, C_H2 + (size_t)m * DM, C.lane);
            SEAM(pb + 9);
        }
        if (IN(pb + 10)) { PH_FENCE(); EpiSwiGlu E{C_HID}; run_gemm(C, C_H2, C_Wgu, 2 * FF, DM, E); SEAM(pb + 10); }
        if (IN(pb + 11)) { PH_FENCE(); EpiPlain E{C_F}; run_gemm(C, C_HID, C_Wdn, DM, FF, E); SEAM(pb + 11); }
    }
    if (IN(DEPTH * 12)) { PH_FENCE();
        const float* wpost = C_in(I_POSTFFN) + (DEPTH - 1) * DM;
        for (int m = gw; m < T; m += NGW) row_pass(C_out + (size_t)m * DM, C_F + (size_t)m * DM, wpost, C_out + (size_t)m * DM, nullptr, nullptr, C.lane);
    }
#undef IN
#undef SEAM
#undef gw
#undef NGW
}

#ifndef MK_SINGLE
#define MK_SINGLE 0
#endif
#ifndef MK_PH_END
#define MK_PH_END NPH
#endif
extern "C" void kernel_launch(void* const* d_in, const int* in_sizes, int n_in, void* d_out, int out_size, void* d_ws, size_t ws_size, hipStream_t stream) {
    static int grid = 0;
    if (grid == 0) {
        if (n_in != 27 || in_sizes[0] != T * DM || out_size != T * DM || ws_size < WS_END) { fprintf(stderr, "kernel_launch: unexpected shapes: n_in %d in0 %d out %d ws %zu (need %zu)\n", n_in, n_in > 0 ? in_sizes[0] : -1, out_size, ws_size, (size_t)WS_END); grid = -1; return; }
        int dev = 0, cus = 0, per_cu = 0;
        if (hipGetDevice(&dev) != hipSuccess || hipDeviceGetAttribute(&cus, hipDeviceAttributeMultiprocessorCount, dev) != hipSuccess) { grid = -1; return; }
        if (hipFuncSetAttribute((const void*)mk_fwd, hipFuncAttributeMaxDynamicSharedMemorySize, LDS_BYTES) != hipSuccess) { fprintf(stderr, "kernel_launch: hipFuncSetAttribute failed\n"); grid = -1; return; }
        if (hipOccupancyMaxActiveBlocksPerMultiprocessor(&per_cu, (const void*)mk_fwd, NWAVES * 64, LDS_BYTES) != hipSuccess || per_cu < 1) fprintf(stderr, "kernel_launch: occupancy query says %d\n", per_cu);
        (void)hipGetLastError();
        grid = cus;
    }
    if (grid < 0) return;
    if (hipMemsetAsync((char*)d_ws + WS_CTL, 0, CTL_ZERO_BYTES, stream) != hipSuccess) return;
    Args a{};
    for (int i = 0; i < 27; ++i) a.in[i] = (const float*)d_in[i];
    a.out = (float*)d_out; a.ws = (unsigned char*)d_ws;
#if MK_SINGLE
    a.ph_lo = 0; a.ph_hi = MK_PH_END;
    hipLaunchKernelGGL(mk_fwd, dim3(grid), dim3(NWAVES * 64), LDS_BYTES, stream, a);
#else
    for (int p = 0; p < MK_PH_END; ++p) { a.ph_lo = p; a.ph_hi = p + 1; hipLaunchKernelGGL(mk_fwd, dim3(grid), dim3(NWAVES * 64), LDS_BYTES, stream, a); }
#endif
    const hipError_t le = hipPeekAtLastError();
    if (le != hipSuccess) fprintf(stderr, "kernel_launch: launch failed: %s\n", hipGetErrorName(le));
}
```

```cpp
#include <hip/hip_runtime.h>
#include <cstdio>
#include <cstdint>
#define REPS3 1
#define PROBE_STAMP 0
#define PROBE_STAMP_SEL 0xFFF
#define PROBE_REP_MASK 0
#define MK_ALIGN true
#define MK_SP2 true
#ifndef MK_SINGLE
#define MK_SINGLE 1
#endif
#ifndef MK_PH_END
#define MK_PH_END NPH
#endif
#ifndef PH_MASK
#define PH_MASK 0x1FFF
#endif
#ifndef DBG_DELTA
#define DBG_DELTA C_RA
#endif
namespace pg8 {
#define PG8_LAS __attribute__((address_space(3)))
typedef unsigned short bf16_t;
typedef short bf16x8 __attribute__((ext_vector_type(8)));
typedef float f32x4 __attribute__((ext_vector_type(4)));
typedef unsigned u32x4 __attribute__((ext_vector_type(4)));
constexpr int BM = 256, BK = 64, HALF = 128, HTB = HALF * BK * 2  , STAGE_BYTES = 8 * HTB, NXCD = 8, WGM = 8;

__host__ __device__ __forceinline__ int lds_byte(int r, int c) { const int st = (r >> 4) * 2 + (c >> 5), rr = r & 15, cc = c & 31, ob = rr * 64 + cc * 2; return st * 1024 + (ob ^ (((ob >> 9) & 1) << 5)); }
__host__ __device__ __forceinline__ void stage_rc(int b, int& R, int& C) { const int st = b / 1024, sb = b % 1024, swz = sb ^ (((sb >> 9) & 1) << 5); R = (st >> 1) * 16 + swz / 64; C = (st & 1) * 32 + (swz % 64) / 2; }
__host__ __device__ __forceinline__ int perm32(int rho) { const int n = rho >> 4, i = rho & 15; return 8 * (i >> 2) + 4 * n + (i & 3); }

__device__ __forceinline__ int opaque_tid() { int t = threadIdx.x; asm volatile("" : "+v"(t)); return t; }
struct Unit { int pm, pn; };
struct Gemm { const bf16_t* A; const bf16_t* Bt; int M, N, K; };

struct StaticOrder {
    int nM, nN, nwg, G, c;
    __host__ __device__ void init(int M, int N, int G_, int c_) { nM = M / BM; nN = N / BM; nwg = nM * nN; G = G_; c = c_; }
    __host__ __device__ bool next(int i, Unit& u) const {
        const long L = (long)i * G + c; if (L >= nwg) return false;
        int wgid = (int)L; { const int q = nwg / NXCD, r = nwg % NXCD, xcd = wgid % NXCD, off = wgid / NXCD; wgid = (xcd < r ? xcd * (q + 1) : r * (q + 1) + (xcd - r) * q) + off; }
        const int nig = WGM * nN, gid = wgid / nig, fm = gid * WGM, gsz = (nM - fm) < WGM ? (nM - fm) : WGM;
        u.pm = fm + ((wgid % nig) % gsz); u.pn = (wgid % nig) / gsz; return true;
    }
    __device__ __forceinline__ void a_ready(const Unit&) const {}
    __device__ __forceinline__ void done(const Unit&) const {}
};

typedef __bf16 bf16x2_t __attribute__((ext_vector_type(2))); typedef float f32x2_t __attribute__((ext_vector_type(2)));
__device__ __forceinline__ unsigned cvt_pk_bf16(float lo, float hi) { const f32x2_t v = {lo, hi}; const bf16x2_t b = __builtin_convertvector(v, bf16x2_t); return __builtin_bit_cast(unsigned, b); }
template <class Epi, class Sched, bool ALIGN_EPI = false, bool SP2 = false>
__device__ __forceinline__ void gemm_phase(PG8_LAS unsigned char* lds, const Gemm g, const Sched& S, const Epi& E) {
    const int tid = opaque_tid(), wid = __builtin_amdgcn_readfirstlane(tid >> 6), lane = tid & 63, wr = wid >> 2, wc = wid & 3, fr = lane & 15, fq = lane >> 4;
    const int K = g.K, nt = K / BK;
    unsigned voffA[2], voffB[2];
#pragma unroll
    for (int i = 0; i < 2; ++i) { int R, C; stage_rc(tid * 16 + i * 8192, R, C); const int Rb = Epi::PERM ? ((R & ~31) + perm32(R & 31)) : R;
        voffA[i] = (unsigned)(R * K + C) * 2u; voffB[i] = (unsigned)(Rb * K + C) * 2u; }
    const size_t kstep = (size_t)(BK * 2);
    const size_t hstep = (size_t)HALF * K * 2;
    const size_t tstep = 2 * hstep;
    const unsigned ldsw = (unsigned)wid * 1024u;
    const int aoff = lds_byte(wr * 64 + fr, fq * 8), boff = lds_byte(wc * 32 + fr, fq * 8);
#define PG8_SA(b, h) (((b) * 2 + (h)) * HTB)
#define PG8_SB(b, h) ((4 + (b) * 2 + (h)) * HTB)
#define PG8_STAGE(bufoff, gbase, voff) do { _Pragma("unroll") for (int _i = 0; _i < 2; ++_i) \
        __builtin_amdgcn_global_load_lds((const unsigned*)((const char*)(gbase) + (voff)[_i]), (PG8_LAS unsigned*)(lds + (bufoff) + ldsw + _i * 8192), 16, 0, 0); } while (0)
#define PG8_LDA(dst, b, h) do { _Pragma("unroll") for (int m = 0; m < 4; ++m) _Pragma("unroll") for (int k = 0; k < 2; ++k) dst[m][k] = *(const PG8_LAS bf16x8*)(lds + PG8_SA(b, h) + aoff + m * 2048 + k * 1024); } while (0)
#define PG8_LDB(dst, b, h) do { _Pragma("unroll") for (int n = 0; n < 2; ++n) _Pragma("unroll") for (int k = 0; k < 2; ++k) dst[n][k] = *(const PG8_LAS bf16x8*)(lds + PG8_SB(b, h) + boff + n * 2048 + k * 1024); } while (0)
#define PG8_MMA(ai, bj, At, Bt) do { __builtin_amdgcn_s_setprio(1); _Pragma("unroll") for (int m = 0; m < 4; ++m) _Pragma("unroll") for (int n = 0; n < 2; ++n) _Pragma("unroll") for (int k = 0; k < 2; ++k) \
        acc[ai][bj][m][n] = __builtin_amdgcn_mfma_f32_16x16x32_bf16(Bt[n][k], At[m][k], acc[ai][bj][m][n], 0, 0, 0); __builtin_amdgcn_s_setprio(0); } while (0)
#define PG8_WAIT_V(n) asm volatile("s_waitcnt vmcnt(" #n ")" ::: "memory")
#define PG8_WAIT_L(n) asm volatile("s_waitcnt lgkmcnt(" #n ")" ::: "memory")
#define PG8_BAR __builtin_amdgcn_s_barrier()
#define PG8_SCHED __builtin_amdgcn_sched_barrier(0)
    Unit cur, nxt; int ui = 0;
    if (!S.next(0, cur)) return;
    f32x4 acc[2][2][4][2];
#pragma unroll
    for (int a = 0; a < 2; ++a)
#pragma unroll
        for (int b = 0; b < 2; ++b)
#pragma unroll
            for (int m = 0; m < 4; ++m)
#pragma unroll
                for (int n = 0; n < 2; ++n) acc[a][b][m][n] = (f32x4){0.f, 0.f, 0.f, 0.f};
    bf16x8 At[4][2], B0[2][2], B1[2][2];
    const char* cA = (const char*)g.A + (size_t)cur.pm * tstep; const char* cB = (const char*)g.Bt + (size_t)cur.pn * tstep;
    S.a_ready(cur);
    if constexpr (SP2) {
        PG8_STAGE(PG8_SB(0, 0), cB, voffB); PG8_STAGE(PG8_SB(0, 1), cB + hstep, voffB); PG8_STAGE(PG8_SA(0, 0), cA, voffA); PG8_STAGE(PG8_SA(0, 1), cA + hstep, voffA);
        if (wr == 1) PG8_BAR;
        PG8_WAIT_V(2); PG8_BAR;
        PG8_STAGE(PG8_SB(1, 0), cB + kstep, voffB); PG8_STAGE(PG8_SA(1, 0), cA + kstep, voffA); PG8_STAGE(PG8_SB(1, 1), cB + hstep + kstep, voffB);
        PG8_WAIT_V(6); PG8_BAR;
    } else {
        PG8_STAGE(PG8_SB(0, 0), cB, voffB); PG8_STAGE(PG8_SA(0, 0), cA, voffA); PG8_STAGE(PG8_SB(0, 1), cB + hstep, voffB); PG8_STAGE(PG8_SA(0, 1), cA + hstep, voffA);
        if (wr == 1) PG8_BAR;
        PG8_WAIT_V(4); PG8_BAR;
        PG8_STAGE(PG8_SB(1, 0), cB + kstep, voffB); PG8_STAGE(PG8_SA(1, 0), cA + kstep, voffA); PG8_STAGE(PG8_SB(1, 1), cB + hstep + kstep, voffB);
        PG8_WAIT_V(6); PG8_BAR;
    }
    for (;;) {
        const bool has_next = S.next(ui + 1, nxt);
        const char* nA = has_next ? (const char*)g.A + (size_t)nxt.pm * tstep : cA; const char* nB = has_next ? (const char*)g.Bt + (size_t)nxt.pn * tstep : cB;
        for (int t = 0; t < nt; t += 2) {
            const bool last = (t == nt - 2);
            const char* a1 = cA + (size_t)(t + 1) * kstep;
            const char* a2 = last ? nA : cA + (size_t)(t + 2) * kstep; const char* b2 = last ? nB : cB + (size_t)(t + 2) * kstep;
            const char* a3 = a2 + kstep; const char* b3 = b2 + kstep;
            if (last && has_next) S.a_ready(nxt);
            if constexpr (Epi::PRE) { if (last) E.pre(cur, wid, lane); }
            if constexpr (SP2) {
            PG8_LDB(B0, 0, 0); PG8_LDB(B1, 0, 1); PG8_SCHED; PG8_LDA(At, 0, 0); PG8_STAGE(PG8_SA(1, 1), a1 + hstep, voffA);
            PG8_WAIT_V(8); PG8_WAIT_L(0); PG8_BAR; PG8_MMA(0, 0, At, B0); PG8_MMA(0, 1, At, B1); PG8_BAR; PG8_SCHED;
            PG8_LDA(At, 0, 1); PG8_STAGE(PG8_SB(0, 0), b2, voffB); PG8_STAGE(PG8_SB(0, 1), b2 + hstep, voffB); PG8_STAGE(PG8_SA(0, 0), a2, voffA);
            PG8_WAIT_V(8); PG8_WAIT_L(0); PG8_BAR; PG8_MMA(1, 0, At, B0); PG8_MMA(1, 1, At, B1); PG8_BAR; PG8_SCHED;
            PG8_LDB(B0, 1, 0); PG8_LDB(B1, 1, 1); PG8_SCHED; PG8_LDA(At, 1, 0); PG8_STAGE(PG8_SA(0, 1), a2 + hstep, voffA);
            PG8_WAIT_V(8); PG8_WAIT_L(0); PG8_BAR; PG8_MMA(0, 0, At, B0); PG8_MMA(0, 1, At, B1); PG8_BAR; PG8_SCHED;
            PG8_LDA(At, 1, 1); PG8_STAGE(PG8_SB(1, 0), b3, voffB); PG8_STAGE(PG8_SB(1, 1), b3 + hstep, voffB); PG8_STAGE(PG8_SA(1, 0), a3, voffA);
            PG8_WAIT_V(8); PG8_WAIT_L(0); PG8_BAR; PG8_MMA(1, 0, At, B0); PG8_MMA(1, 1, At, B1); PG8_BAR; PG8_SCHED;
            } else {
            PG8_LDB(B0, 0, 0); PG8_SCHED; PG8_LDA(At, 0, 0); PG8_STAGE(PG8_SA(1, 1), a1 + hstep, voffA);
            PG8_WAIT_L(8); PG8_BAR; PG8_WAIT_L(0); PG8_MMA(0, 0, At, B0); PG8_BAR; PG8_SCHED;
            PG8_LDB(B1, 0, 1); PG8_STAGE(PG8_SB(0, 0), b2, voffB);
            PG8_BAR; PG8_WAIT_L(0); PG8_MMA(0, 1, At, B1); PG8_BAR;
            PG8_LDA(At, 0, 1); PG8_STAGE(PG8_SA(0, 0), a2, voffA);
            PG8_BAR; PG8_WAIT_L(0); PG8_MMA(1, 0, At, B0); PG8_BAR; PG8_SCHED;
            PG8_STAGE(PG8_SB(0, 1), b2 + hstep, voffB);
            PG8_WAIT_V(6); PG8_BAR; PG8_MMA(1, 1, At, B1); PG8_BAR;
            PG8_LDB(B0, 1, 0); PG8_SCHED; PG8_LDA(At, 1, 0); PG8_STAGE(PG8_SA(0, 1), a2 + hstep, voffA);
            PG8_WAIT_L(8); PG8_BAR; PG8_WAIT_L(0); PG8_MMA(0, 0, At, B0); PG8_BAR; PG8_SCHED;
            PG8_LDB(B1, 1, 1); PG8_STAGE(PG8_SB(1, 0), b3, voffB);
            PG8_BAR; PG8_WAIT_L(0); PG8_MMA(0, 1, At, B1); PG8_BAR;
            PG8_LDA(At, 1, 1); PG8_STAGE(PG8_SA(1, 0), a3, voffA);
            PG8_BAR; PG8_WAIT_L(0); PG8_MMA(1, 0, At, B0); PG8_BAR; PG8_SCHED;
            PG8_STAGE(PG8_SB(1, 1), b3 + hstep, voffB);
            PG8_WAIT_V(6); PG8_BAR; PG8_MMA(1, 1, At, B1); PG8_BAR;
            }
        }
        if constexpr (ALIGN_EPI) { if (wr == 0) PG8_BAR; }
        if constexpr (!Epi::AFTER_DRAIN) { E(acc, cur, wr, wc, fr, fq); S.done(cur); }
        if (!has_next) break;
#pragma unroll
        for (int a = 0; a < 2; ++a)
#pragma unroll
            for (int b = 0; b < 2; ++b)
#pragma unroll
                for (int m = 0; m < 4; ++m)
#pragma unroll
                    for (int n = 0; n < 2; ++n) acc[a][b][m][n] = (f32x4){0.f, 0.f, 0.f, 0.f};
        cur = nxt; cA = nA; cB = nB; ++ui;
        if constexpr (ALIGN_EPI) { if (wr == 1) PG8_BAR; }
    }
    PG8_WAIT_V(0);
    if constexpr (!ALIGN_EPI) { if (wr == 0) PG8_BAR; }
    PG8_BAR;
    if constexpr (Epi::AFTER_DRAIN) { E.fused(acc, cur, wr, wc, fr, fq, lds, wid, lane); S.done(cur); }
#undef PG8_SA
#undef PG8_SB
#undef PG8_STAGE
#undef PG8_LDA
#undef PG8_LDB
#undef PG8_MMA
#undef PG8_WAIT_V
#undef PG8_WAIT_L
#undef PG8_BAR
#undef PG8_SCHED
}
}

constexpr int BATCH = 8, SEQ = 4096, DM = 2048, DEPTH = 4, T = BATCH * SEQ;
constexpr int NH = 16, DQK = 192, QL = 512, KVL = 256;
constexpr int SW = 1024, SG = 64, SN = 64, SP = 16, FF = 5632;
constexpr int INW = 5952, OFF_SSM = 832, OFF_GATE = 1856;
constexpr int NIN = 6144;
constexpr float EPS = 1e-6f;
constexpr float QSCALE = 0.07216878364870322f * 1.4426950408889634f;
constexpr int NWAVES = 8;
constexpr int NPH = DEPTH * 12 + 1;

constexpr size_t MiB = 1u << 20;
constexpr size_t WS_CTL = 0, CTL_ZERO_BYTES = 1 * MiB;
constexpr size_t WS_COS = 1 * MiB, WS_SIN = 5 * MiB;
constexpr size_t WS_SSQQ = 9 * MiB, WS_SSQKV = 10 * MiB;
constexpr size_t WS_RS1 = 10 * MiB + 512 * 1024, WS_RS2 = 10 * MiB + 768 * 1024;
constexpr size_t WS_LP = 11 * MiB;
constexpr size_t WS_FB = WS_LP + 5 * MiB / 2;
constexpr size_t WS_KD = 14 * MiB;
constexpr size_t WS_MAT = 17 * MiB;
constexpr size_t WS_CCT = 33 * MiB;
constexpr size_t WS_XST = 49 * MiB;
constexpr size_t WS_W = 57 * MiB;
constexpr size_t WO_WIN = 0, WO_WUQ = 24 * MiB, WO_WUKV = 27 * MiB, WO_WO = 29 * MiB, WO_WGLU = 37 * MiB, WO_WOUT = 45 * MiB, WO_WGU = 53 * MiB, WO_WDN = 97 * MiB;
constexpr size_t WS_RA = 176 * MiB;
constexpr size_t WS_CQ = 304 * MiB, WS_CKV = 336 * MiB, WS_KPE = 352 * MiB, WS_U = 356 * MiB, WS_GA = 420 * MiB, WS_GB = 548 * MiB;
constexpr size_t WS_HID = 304 * MiB;
constexpr size_t WS_Q = 676 * MiB;
constexpr size_t WS_KV = 868 * MiB;
constexpr size_t WS_Z = 1124 * MiB;
constexpr size_t WS_END = 1188 * MiB;
static_assert(WS_HID + (size_t)T * FF * 2 <= WS_Q, "HID overlay");

constexpr int CW_TMO = 0, CW_CODE = 1, CW_BAR = 4096;

constexpr int RING_BYTES = 131072, KD_LDS_BYTES = 4 * 65 * 256 * 2, LDS_BYTES = 163840, MISC_OFF = LDS_BYTES - 512;

#define GAS __attribute__((address_space(1)))
#define LAS __attribute__((address_space(3)))
#define CAS __attribute__((address_space(4)))
typedef unsigned short bf16;
using pg8::bf16x8; using pg8::f32x4; using pg8::u32x4; using pg8::cvt_pk_bf16;
typedef float f32x2 __attribute__((ext_vector_type(2)));
typedef float f32x16 __attribute__((ext_vector_type(16)));
typedef unsigned u32x2 __attribute__((ext_vector_type(2)));
typedef short s16x4 __attribute__((ext_vector_type(4)));
typedef GAS unsigned gu32;
#define RLX_AGENT __ATOMIC_RELAXED, __HIP_MEMORY_SCOPE_AGENT
#define LDS_WAIT() asm volatile("s_waitcnt lgkmcnt(0)" ::: "memory")
#define VM_WAIT() asm volatile("s_waitcnt vmcnt(0)" ::: "memory")
__device__ __forceinline__ unsigned f2bf(float f) { unsigned u = __builtin_bit_cast(unsigned, f); return (u + 0x7fffu + ((u >> 16) & 1u)) >> 16; }
__device__ __forceinline__ unsigned pk2(float lo, float hi) { return f2bf(lo) | (f2bf(hi) << 16); }
__device__ __forceinline__ float bflo(unsigned w) { return __uint_as_float(w << 16); }
__device__ __forceinline__ float bfhi(unsigned w) { return __uint_as_float(w & 0xffff0000u); }
__device__ __forceinline__ float sigm(float x) { return __builtin_amdgcn_rcpf(1.0f + __builtin_amdgcn_exp2f(-1.4426950408889634f * x)); }
__device__ __forceinline__ void st8(bf16* p, f32x4 v0, f32x4 v1) { u32x4 w; w.x = cvt_pk_bf16(v0[0], v0[1]); w.y = cvt_pk_bf16(v0[2], v0[3]); w.z = cvt_pk_bf16(v1[0], v1[1]); w.w = cvt_pk_bf16(v1[2], v1[3]); *(u32x4*)p = w; }
__device__ __forceinline__ void ld8(const bf16* p, f32x4& v0, f32x4& v1) { const u32x4 w = *(const u32x4*)p; v0[0] = bflo(w.x); v0[1] = bfhi(w.x); v0[2] = bflo(w.y); v0[3] = bfhi(w.y); v1[0] = bflo(w.z); v1[1] = bfhi(w.z); v1[2] = bflo(w.w); v1[3] = bfhi(w.w); }
__device__ __forceinline__ float wave_sum(float v) {
#pragma unroll
    for (int o = 1; o < 64; o <<= 1) v += __shfl_xor(v, o);
    return v;
}

#define XB_TMO      128
#define XB_XCNT(j)  (256  + 64 * (j))
#define XB_XSUB(j)  (1280 + 64 * (j))
#define XB_XGEN(j)  (2304 + 64 * (j))
#define XB_TOP      3328
#define XB_TOPGEN   3392
#define XCD_BAR_WORDS 3456
#define XB_SPIN_CAP (1u << 18)

__device__ __forceinline__ unsigned xb_ld(unsigned* p)              { return __hip_atomic_load(p, __ATOMIC_RELAXED, __HIP_MEMORY_SCOPE_AGENT); }
__device__ __forceinline__ unsigned xb_add(unsigned* p, unsigned v) { return __hip_atomic_fetch_add(p, v, __ATOMIC_RELAXED, __HIP_MEMORY_SCOPE_AGENT); }
__device__ __forceinline__ unsigned xb_xcc_id() { return (unsigned)__builtin_amdgcn_s_getreg((3 << 11) | 20) & 0xFu; }
#define XB_SPIN(cond, bar) do { unsigned _sp = 0; while (cond) { __builtin_amdgcn_s_sleep(1); \
    if ((++_sp & 255u) == 0u) { if (xb_ld(&(bar)[XB_TMO])) break; if (_sp > XB_SPIN_CAP) { atomicAdd(&(bar)[XB_TMO], 1u); break; } } } } while (0)

struct XcdBarrier {
    unsigned* bar; unsigned x;
    volatile LAS unsigned* st;
};

__device__ __forceinline__ XcdBarrier xcd_barrier_post(unsigned* bar, volatile LAS unsigned* st) {
    XcdBarrier b; b.bar = bar; b.x = xb_xcc_id(); b.st = st;
    if (threadIdx.x == 0) (void)xb_add(&bar[XB_XCNT(b.x)], 1u);
    return b;
}
__device__ __forceinline__ void xcd_barrier_complete(unsigned* bar, unsigned x, unsigned& nloc, unsigned& nx) {
    const unsigned G = gridDim.x * gridDim.y * gridDim.z;
    unsigned sum, cnt, mine, sp = 0u;
    for (;;) {
        sum = 0u; cnt = 0u; mine = 0u;
#pragma unroll
        for (unsigned j = 0; j < 16; ++j) { const unsigned c = xb_ld(&bar[XB_XCNT(j)]); sum += c; cnt += (c > 0u) ? 1u : 0u; mine = (j == x) ? c : mine; }
        if (sum == G) break;
        __builtin_amdgcn_s_sleep(1);
        if ((++sp & 255u) == 0u) { if (xb_ld(&bar[XB_TMO])) break; if (sp > XB_SPIN_CAP) { atomicAdd(&bar[XB_TMO], 1u); break; } }
    }
    nloc = mine > 0u ? mine : 1u; nx = cnt > 0u ? cnt : 1u;
}

__device__ __forceinline__ void xcd_barrier(const XcdBarrier& b) {
    asm volatile("s_waitcnt vmcnt(0)" ::: "memory");
    __syncthreads();
    if (threadIdx.x == 0) {
        unsigned* bar = b.bar;
        __builtin_amdgcn_s_waitcnt(0);
        unsigned nloc = b.st[0], nx = b.st[1];
        if (nloc == 0u) { xcd_barrier_complete(bar, b.x, nloc, nx); b.st[0] = nloc; b.st[1] = nx; }
        const unsigned old = xb_add(&bar[XB_XSUB(b.x)], 1u);
        const unsigned gen = old / nloc;
        if (old + 1u == (gen + 1u) * nloc) {
            __builtin_amdgcn_fence(__ATOMIC_RELEASE, "agent");
            asm volatile("s_waitcnt vmcnt(0)" ::: "memory");
            const unsigned og = xb_add(&bar[XB_TOP], 1u);
            const unsigned tg = og / nx;
            if (og + 1u == (tg + 1u) * nx) xb_add(&bar[XB_TOPGEN], 1u);
            else XB_SPIN(xb_ld(&bar[XB_TOPGEN]) == tg, bar);
            __builtin_amdgcn_fence(__ATOMIC_ACQUIRE, "agent");
            xb_add(&bar[XB_XGEN(b.x)], 1u);
            asm volatile("s_waitcnt vmcnt(0)" ::: "memory");
        } else {
            XB_SPIN(xb_ld(&bar[XB_XGEN(b.x)]) == gen, bar);
            __builtin_amdgcn_fence(__ATOMIC_ACQUIRE, "agent");
            asm volatile("s_waitcnt vmcnt(0)" ::: "memory");
        }
    }
    __syncthreads();
}

struct Args { const float* in[27]; float* out; unsigned char* ws; int ph_lo, ph_hi; };
struct Ctx {
    LAS unsigned char* lds;
    int tid, lane, wave, G, bid;
    const CAS char* ka;
};
static_assert(sizeof(Args) == 240, "Args layout");
#define C_in(i) (*(const float* const CAS*)(C.ka + 8 * (i)))
#define C_out (*(float* const CAS*)(C.ka + 216))
#define C_ws (*(unsigned char* const CAS*)(C.ka + 224))
#define WSP(TY, off) ((TY*)(C_ws + (off)))
#define C_cosT WSP(float, WS_COS)
#define C_sinT WSP(float, WS_SIN)
#define C_ssqq WSP(float, WS_SSQQ)
#define C_ssqkv WSP(float, WS_SSQKV)
#define C_LP WSP(f32x2, WS_LP)
#define C_FB WSP(f32x2, WS_FB)
#define C_KD WSP(bf16, WS_KD)
#define C_MAT WSP(bf16, WS_MAT)
#define C_CCT WSP(bf16, WS_CCT)
#define C_XST WSP(bf16, WS_XST)
#define C_Win WSP(bf16, WS_W + WO_WIN)
#define C_Wuq WSP(bf16, WS_W + WO_WUQ)
#define C_Wukv WSP(bf16, WS_W + WO_WUKV)
#define C_Wo WSP(bf16, WS_W + WO_WO)
#define C_Wglu WSP(bf16, WS_W + WO_WGLU)
#define C_Wout WSP(bf16, WS_W + WO_WOUT)
#define C_Wgu WSP(bf16, WS_W + WO_WGU)
#define C_Wdn WSP(bf16, WS_W + WO_WDN)
#define C_RA WSP(bf16, WS_RA)
#define C_CQ WSP(bf16, WS_CQ)
#define C_CKV WSP(bf16, WS_CKV)
#define C_KPE WSP(bf16, WS_KPE)
#define C_U WSP(bf16, WS_U)
#define C_GA WSP(bf16, WS_GA)
#define C_GB WSP(bf16, WS_GB)
#define C_HID WSP(bf16, WS_HID)
#define C_Q WSP(bf16, WS_Q)
#define C_KV WSP(bf16, WS_KV)
#define C_Z WSP(bf16, WS_Z)
#define C_XB2 WSP(bf16, WS_Q)
#define C_XB ((bf16*)C_out)
#define C_RS1 WSP(float, WS_RS1)
#define C_RS2 WSP(float, WS_RS2)
#define C_F WSP(bf16, WS_KV)
enum { I_X = 0, I_POS, I_PREMIX, I_WIN, I_BGATE, I_QNORM, I_KVNORM, I_WUQ, I_WUKV, I_WO, I_ARE, I_AIM, I_LOGDT, I_BRE, I_BIM, I_CRE, I_CIM, I_SSMD, I_WGLU, I_BGLU, I_WOUT, I_POSTMIX, I_PREFFN, I_WFG, I_WFU, I_WFD, I_POSTFFN };

using pg8::Unit;
#define EPI_HDR static constexpr bool PERM = true, AFTER_DRAIN = false, PRE = false;
#define EPI_HDR_PRE static constexpr bool PERM = true, AFTER_DRAIN = false, PRE = true;
#define EPI_ARGS const f32x4 (&acc)[2][2][4][2], const Unit& u, int wr, int wc, int fr, int fq
#define FOR_AI_M _Pragma("unroll") for (int ai = 0; ai < 2; ++ai) _Pragma("unroll") for (int m = 0; m < 4; ++m)

#ifndef MK_ST_AUX
#define MK_ST_AUX 16
#endif
typedef __amdgpu_buffer_rsrc_t rsrc_t;
__device__ __forceinline__ rsrc_t mk_rsrc(const void* p, unsigned bytes) { return __builtin_amdgcn_make_buffer_rsrc((void*)p, (short)0, (int)bytes, 0x00020000); }
__device__ __forceinline__ void bst8(rsrc_t r, unsigned voff, unsigned soff, f32x4 v0, f32x4 v1) { u32x4 w; w.x = cvt_pk_bf16(v0[0], v0[1]); w.y = cvt_pk_bf16(v0[2], v0[3]); w.z = cvt_pk_bf16(v1[0], v1[1]); w.w = cvt_pk_bf16(v1[2], v1[3]); __builtin_amdgcn_raw_buffer_store_b128(w, r, voff + soff, 0, MK_ST_AUX); }
__device__ __forceinline__ void bld8(rsrc_t r, unsigned voff, unsigned soff, f32x4& v0, f32x4& v1) { const u32x4 w = __builtin_amdgcn_raw_buffer_load_b128(r, voff, soff, 0); v0[0] = bflo(w.x); v0[1] = bfhi(w.x); v0[2] = bflo(w.y); v0[3] = bfhi(w.y); v1[0] = bflo(w.z); v1[1] = bfhi(w.z); v1[2] = bflo(w.w); v1[3] = bfhi(w.w); }
__device__ __forceinline__ f32x4 bldf4(rsrc_t r, unsigned voff, unsigned soff) { return __builtin_bit_cast(f32x4, __builtin_amdgcn_raw_buffer_load_b128(r, voff, soff, 0)); }
#define ROWG (ai * 128 + m * 16)
#define TILE_BYTES(PB) (255u * (PB) + (PB))
#define RS_LDS_OFF (RING_BYTES + 4096)
#define RS_PRE(P) __device__ __forceinline__ void pre(const Unit& u, int wid, int lane) const { if (wid < 4) __builtin_amdgcn_global_load_lds((const unsigned*)((P) + (size_t)u.pm * 256 + wid * 64 + lane), (LAS unsigned*)(ldsx + RS_LDS_OFF + wid * 256), 4, 0, 0); }
#define RS_LOAD() float rsv[2][4]; { const LAS float* rl_ = (const LAS float*)(ldsx + RS_LDS_OFF) + lr; FOR_AI_M rsv[ai][m] = rl_[ROWG]; }

struct EpiInProj { EPI_HDR_PRE
    bf16 *CQ, *CKV, *KPE, *U, *GA, *GB; float *ssqq, *ssqkv; const float *bgate, *cosT, *sinT, *rsr; LAS unsigned char* ldsx;
    RS_PRE(rsr)
    __device__ __forceinline__ void operator()(EPI_ARGS) const {
        const int pn = u.pn, lr = wr * 64 + fr, cl = wc * 32 + 8 * fq; const size_t r0 = (size_t)u.pm * 256;
        RS_LOAD();
        if (pn < 2) {
            const rsrc_t rb = mk_rsrc(CQ + r0 * QL + pn * 256, TILE_BYTES(QL * 2)), rq = mk_rsrc(ssqq + r0 * 8, 256 * 32);
            const unsigned vo = (unsigned)(lr * QL + cl) * 2u, vs = (unsigned)(lr * 8 + pn * 4 + wc) * 4u;
            FOR_AI_M { float s = 0.f;
#pragma unroll
                for (int bj = 0; bj < 2; ++bj) { const f32x4 v0 = acc[ai][bj][m][0] * rsv[ai][m], v1 = acc[ai][bj][m][1] * rsv[ai][m];
                    s += (v0[0] * v0[0] + v0[1] * v0[1]) + (v0[2] * v0[2] + v0[3] * v0[3]) + (v1[0] * v1[0] + v1[1] * v1[1]) + (v1[2] * v1[2] + v1[3] * v1[3]);
                    bst8(rb, vo, ROWG * QL * 2 + bj * 256, v0, v1); }
                s += __shfl_xor(s, 16); s += __shfl_xor(s, 32);
                if (fq == 0) __builtin_amdgcn_raw_buffer_store_b32(__float_as_uint(s), rq, vs + ROWG * 32, 0, 0); }
        } else if (pn == 2) {
            const rsrc_t rb = mk_rsrc(CKV + r0 * KVL, TILE_BYTES(KVL * 2)), rq = mk_rsrc(ssqkv + r0 * 4, 256 * 16);
            const unsigned vo = (unsigned)(lr * KVL + cl) * 2u, vs = (unsigned)(lr * 4 + wc) * 4u;
            FOR_AI_M { float s = 0.f;
#pragma unroll
                for (int bj = 0; bj < 2; ++bj) { const f32x4 v0 = acc[ai][bj][m][0] * rsv[ai][m], v1 = acc[ai][bj][m][1] * rsv[ai][m];
                    s += (v0[0] * v0[0] + v0[1] * v0[1]) + (v0[2] * v0[2] + v0[3] * v0[3]) + (v1[0] * v1[0] + v1[1] * v1[1]) + (v1[2] * v1[2] + v1[3] * v1[3]);
                    bst8(rb, vo, ROWG * KVL * 2 + bj * 256, v0, v1); }
                s += __shfl_xor(s, 16); s += __shfl_xor(s, 32);
                if (fq == 0) __builtin_amdgcn_raw_buffer_store_b32(__float_as_uint(s), rq, vs + ROWG * 16, 0, 0); }
        } else if (pn < 7) {
            const rsrc_t rb = mk_rsrc(U + r0 * SW + (pn - 3) * 256, TILE_BYTES(SW * 2)); const unsigned vo = (unsigned)(lr * SW + cl) * 2u;
            FOR_AI_M {
#pragma unroll
                for (int bj = 0; bj < 2; ++bj) bst8(rb, vo, ROWG * SW * 2 + bj * 256, acc[ai][bj][m][0] * rsv[ai][m], acc[ai][bj][m][1] * rsv[ai][m]); }
        } else if (pn < 23) {
            const int colt = (pn - (pn < 15 ? 7 : 15)) * 256;
            const rsrc_t rb = mk_rsrc((pn < 15 ? GA : GB) + r0 * DM + colt, TILE_BYTES(DM * 2)); const unsigned vo = (unsigned)(lr * DM + cl) * 2u;
            const float* bb = bgate + (pn < 15 ? 0 : DM) + colt + cl;
            f32x4 bv[2][2];
#pragma unroll
            for (int bj = 0; bj < 2; ++bj) { bv[bj][0] = *(const f32x4*)(bb + bj * 128); bv[bj][1] = *(const f32x4*)(bb + bj * 128 + 4); }
            FOR_AI_M {
#pragma unroll
                for (int bj = 0; bj < 2; ++bj) { f32x4 v0 = acc[ai][bj][m][0] * rsv[ai][m] + bv[bj][0], v1 = acc[ai][bj][m][1] * rsv[ai][m] + bv[bj][1];
#pragma unroll
                    for (int e = 0; e < 4; ++e) { v0[e] = sigm(v0[e]); v1[e] = sigm(v1[e]); }
#ifdef DBG_PLAINGATE
                    v0 = acc[ai][bj][m][0]; v1 = acc[ai][bj][m][1];
#endif
#ifdef DBG_BIASONLY
#pragma unroll
                    for (int e = 0; e < 4; ++e) { float t0 = acc[ai][bj][m][0][e] + bv[bj][0][e], t1 = acc[ai][bj][m][1][e] + bv[bj][1][e]; asm volatile("" : "+v"(t0), "+v"(t1)); v0[e] = t0; v1[e] = t1; }
#endif
                    bst8(rb, vo, ROWG * DM * 2 + bj * 256, v0, v1); } }
        } else if (wc == 0) {
            const rsrc_t rb = mk_rsrc(KPE + r0 * 64, 256 * 128), rc = mk_rsrc(cosT + r0 * 32, 256 * 128), rs_ = mk_rsrc(sinT + r0 * 32, 256 * 128);
            const unsigned vo = (unsigned)(lr * 64 + 8 * fq) * 2u, vt = (unsigned)(lr * 32 + 8 * fq) * 4u;
            FOR_AI_M {
                const f32x4 c0 = bldf4(rc, vt, ROWG * 128), c1 = bldf4(rc, vt, ROWG * 128 + 16), s0 = bldf4(rs_, vt, ROWG * 128), s1 = bldf4(rs_, vt, ROWG * 128 + 16);
                const f32x4 x10 = acc[ai][0][m][0] * rsv[ai][m], x11 = acc[ai][0][m][1] * rsv[ai][m], x20 = acc[ai][1][m][0] * rsv[ai][m], x21 = acc[ai][1][m][1] * rsv[ai][m];
                bst8(rb, vo, ROWG * 128, x10 * c0 - x20 * s0, x11 * c1 - x21 * s1);
                bst8(rb, vo, ROWG * 128 + 64, x10 * s0 + x20 * c0, x11 * s1 + x21 * c1);
                asm volatile("" ::: "memory"); }
        }
    }
};
struct EpiQ { EPI_HDR
    bf16* Q; const float *ssqq, *cosT, *sinT;
    __device__ __forceinline__ void operator()(EPI_ARGS) const {
        constexpr int PQ = NH * DQK * 2;
        const int pn = u.pn, lr = wr * 64 + fr, cl = wc * 32 + 8 * fq; const size_t r0 = (size_t)u.pm * 256;
        const rsrc_t rq = mk_rsrc(ssqq + r0 * 8, 256 * 32), rb = mk_rsrc(Q + r0 * (NH * DQK), TILE_BYTES(PQ));
        const unsigned vs = (unsigned)lr * 32u;
        if (pn < 8) {
            const unsigned vo = (unsigned)lr * PQ + (unsigned)(2 * pn * DQK + cl) * 2u;
            FOR_AI_M { const f32x4 sa = bldf4(rq, vs, ROWG * 32), sb = bldf4(rq, vs, ROWG * 32 + 16);
                const float rs = rsqrtf((((sa[0] + sa[1]) + (sa[2] + sa[3])) + ((sb[0] + sb[1]) + (sb[2] + sb[3]))) * (1.0f / QL) + EPS) * QSCALE;
#pragma unroll
                for (int bj = 0; bj < 2; ++bj) bst8(rb, vo, ROWG * PQ + bj * DQK * 2, acc[ai][bj][m][0] * rs, acc[ai][bj][m][1] * rs);
                asm volatile("" ::: "memory"); }
        } else {
            const rsrc_t rc = mk_rsrc(cosT + r0 * 32, 256 * 128), rs_ = mk_rsrc(sinT + r0 * 32, 256 * 128);
            const unsigned vo = (unsigned)lr * PQ + (unsigned)((4 * (pn - 8) + wc) * DQK + 128 + 8 * fq) * 2u, vt = (unsigned)(lr * 32 + 8 * fq) * 4u;
            FOR_AI_M { const f32x4 sa = bldf4(rq, vs, ROWG * 32), sb = bldf4(rq, vs, ROWG * 32 + 16);
                const float rs = rsqrtf((((sa[0] + sa[1]) + (sa[2] + sa[3])) + ((sb[0] + sb[1]) + (sb[2] + sb[3]))) * (1.0f / QL) + EPS) * QSCALE;
                const f32x4 c0 = bldf4(rc, vt, ROWG * 128) * rs, c1 = bldf4(rc, vt, ROWG * 128 + 16) * rs, s0 = bldf4(rs_, vt, ROWG * 128) * rs, s1 = bldf4(rs_, vt, ROWG * 128 + 16) * rs;
                const f32x4 x10 = acc[ai][0][m][0], x11 = acc[ai][0][m][1], x20 = acc[ai][1][m][0], x21 = acc[ai][1][m][1];
                bst8(rb, vo, ROWG * PQ, x10 * c0 - x20 * s0, x11 * c1 - x21 * s1);
                bst8(rb, vo, ROWG * PQ + 64, x10 * s0 + x20 * c0, x11 * s1 + x21 * c1);
                asm volatile("" ::: "memory"); }
        }
    }
};
struct EpiKV { EPI_HDR
    bf16* KV; const float* ssqkv;
    __device__ __forceinline__ void operator()(EPI_ARGS) const {
        const int lr = wr * 64 + fr, cl = wc * 32 + 8 * fq; const size_t r0 = (size_t)u.pm * 256;
        const rsrc_t rq = mk_rsrc(ssqkv + r0 * 4, 256 * 16), rb = mk_rsrc(KV + r0 * 4096 + u.pn * 256, TILE_BYTES(8192));
        const unsigned vs = (unsigned)lr * 16u, vo = (unsigned)(lr * 4096 + cl) * 2u;
        FOR_AI_M { const f32x4 sa = bldf4(rq, vs, ROWG * 16);
            const float rs = rsqrtf(((sa[0] + sa[1]) + (sa[2] + sa[3])) * (1.0f / KVL) + EPS);
#pragma unroll
            for (int bj = 0; bj < 2; ++bj) bst8(rb, vo, ROWG * 8192 + bj * 256, acc[ai][bj][m][0] * rs, acc[ai][bj][m][1] * rs);
            asm volatile("" ::: "memory"); }
    }
};
struct EpiWo { EPI_HDR
    bf16* GA;
    __device__ __forceinline__ void operator()(EPI_ARGS) const {
        const int lr = wr * 64 + fr, cl = wc * 32 + 8 * fq; const size_t r0 = (size_t)u.pm * 256;
        const rsrc_t rb = mk_rsrc(GA + r0 * DM + u.pn * 256, TILE_BYTES(DM * 2)); const unsigned vo = (unsigned)(lr * DM + cl) * 2u;
        FOR_AI_M {
#pragma unroll
            for (int bj = 0; bj < 2; ++bj) { f32x4 g0, g1; bld8(rb, vo, ROWG * DM * 2 + bj * 256, g0, g1); bst8(rb, vo, ROWG * DM * 2 + bj * 256, g0 * acc[ai][bj][m][0], g1 * acc[ai][bj][m][1]); }
            asm volatile("" ::: "memory"); }
    }
};
struct EpiGlu { EPI_HDR
    bf16 *GA, *GB; const float* bglu;
    __device__ __forceinline__ void operator()(EPI_ARGS) const {
        const int lr = wr * 64 + fr, j0 = u.pn * 128 + wc * 32 + 8 * fq; const size_t r0 = (size_t)u.pm * 256;
        const rsrc_t ra = mk_rsrc(GA + r0 * DM, TILE_BYTES(DM * 2)), rb = mk_rsrc(GB + r0 * DM, TILE_BYTES(DM * 2)); const unsigned vo = (unsigned)(lr * DM + j0) * 2u;
        const f32x4 bv0 = *(const f32x4*)(bglu + j0), bv1 = *(const f32x4*)(bglu + j0 + 4), bg0 = *(const f32x4*)(bglu + DM + j0), bg1 = *(const f32x4*)(bglu + DM + j0 + 4);
        FOR_AI_M {
            f32x4 v0 = acc[ai][0][m][0] + bv0, v1 = acc[ai][0][m][1] + bv1, g0 = acc[ai][1][m][0] + bg0, g1 = acc[ai][1][m][1] + bg1;
#pragma unroll
            for (int e = 0; e < 4; ++e) { v0[e] *= sigm(g0[e]); v1[e] *= sigm(g1[e]); }
            f32x4 m0, m1, q0, q1; bld8(ra, vo, ROWG * DM * 2, m0, m1); bld8(rb, vo, ROWG * DM * 2, q0, q1);
            bst8(ra, vo, ROWG * DM * 2, m0 + q0 * v0, m1 + q1 * v1);
            asm volatile("" ::: "memory"); }
    }
};
struct EpiPlain { EPI_HDR
    bf16* O;
    __device__ __forceinline__ void operator()(EPI_ARGS) const {
        const int lr = wr * 64 + fr, cl = wc * 32 + 8 * fq; const size_t r0 = (size_t)u.pm * 256;
        const rsrc_t rb = mk_rsrc(O + r0 * DM + u.pn * 256, TILE_BYTES(DM * 2)); const unsigned vo = (unsigned)(lr * DM + cl) * 2u;
        FOR_AI_M {
#pragma unroll
            for (int bj = 0; bj < 2; ++bj) bst8(rb, vo, ROWG * DM * 2 + bj * 256, acc[ai][bj][m][0], acc[ai][bj][m][1]); }
    }
};
struct EpiSwiGlu { EPI_HDR_PRE
    bf16* HID; const float* rsr; LAS unsigned char* ldsx;
    RS_PRE(rsr)
    __device__ __forceinline__ void operator()(EPI_ARGS) const {
        const int lr = wr * 64 + fr, j0 = u.pn * 128 + wc * 32 + 8 * fq; const size_t r0 = (size_t)u.pm * 256;
        const rsrc_t rb = mk_rsrc(HID + r0 * FF, TILE_BYTES(FF * 2)); const unsigned vo = (unsigned)(lr * FF + j0) * 2u;
        RS_LOAD();
        FOR_AI_M {
            f32x4 g0 = acc[ai][0][m][0] * rsv[ai][m], g1 = acc[ai][0][m][1] * rsv[ai][m];
#pragma unroll
            for (int e = 0; e < 4; ++e) { g0[e] *= sigm(g0[e]); g1[e] *= sigm(g1[e]); }
            bst8(rb, vo, ROWG * FF * 2, g0 * (acc[ai][1][m][0] * rsv[ai][m]), g1 * (acc[ai][1][m][1] * rsv[ai][m])); }
    }
};

template <class Epi> __device__ __forceinline__ void run_gemm(Ctx& C, const bf16* A, const bf16* Bt, int N, int K, const Epi& E) {
    int Kv = K, Nv = N; asm volatile("" : "+s"(Kv), "+s"(Nv));
    pg8::Gemm g{A, Bt, T, Nv, Kv}; pg8::StaticOrder S; S.init(T, Nv, C.G, C.bid);
    pg8::gemm_phase<Epi, pg8::StaticOrder, MK_ALIGN, MK_SP2>(C.lds, g, S, E);
}

__device__ __forceinline__ void row_pass(const float* xin, const bf16* delta, const float* wpost, float* xout, const float* wpre, bf16* hout, int lane) {
    f32x4 x[8];
#pragma unroll
    for (int j = 0; j < 8; ++j) x[j] = ((const f32x4*)xin)[64 * j + lane];
    if (delta) {
        f32x4 d[8]; float s = 0.f;
#pragma unroll
        for (int j = 0; j < 8; ++j) { const u32x2 w = ((const u32x2*)delta)[64 * j + lane]; d[j] = (f32x4){bflo(w.x), bfhi(w.x), bflo(w.y), bfhi(w.y)};
            s += (d[j][0] * d[j][0] + d[j][1] * d[j][1]) + (d[j][2] * d[j][2] + d[j][3] * d[j][3]); }
        const float rs = rsqrtf(wave_sum(s) * (1.0f / DM) + EPS);
#pragma unroll
        for (int j = 0; j < 8; ++j) { const f32x4 w = ((const f32x4*)wpost)[64 * j + lane]; x[j] = x[j] + d[j] * rs * w; }
        if (xout) {
#pragma unroll
            for (int j = 0; j < 8; ++j) ((f32x4*)xout)[64 * j + lane] = x[j]; }
    }
    if (hout) {
        float s = 0.f;
#pragma unroll
        for (int j = 0; j < 8; ++j) s += (x[j][0] * x[j][0] + x[j][1] * x[j][1]) + (x[j][2] * x[j][2] + x[j][3] * x[j][3]);
        const float rs = rsqrtf(wave_sum(s) * (1.0f / DM) + EPS);
#pragma unroll
        for (int j = 0; j < 8; ++j) { const f32x4 w = ((const f32x4*)wpre)[64 * j + lane]; const f32x4 h = x[j] * rs * w;
            u32x2 o; o.x = cvt_pk_bf16(h[0], h[1]); o.y = cvt_pk_bf16(h[2], h[3]); ((u32x2*)hout)[64 * j + lane] = o; }
    }
}

template <int MODE>
__device__ __forceinline__ void row_phase(Ctx& C, const float* xf, const bf16* xb, const bf16* delta, const float* wpost, bf16* xo, float* of, float* rso) {
    const int lane = C.lane, rpb = T / C.G, row0 = C.bid * rpb;
    LAS unsigned* ctr = (LAS unsigned*)(C.lds + MISC_OFF + 64);
    if (C.tid == 0) *ctr = 0u;
    LDS_WAIT(); __syncthreads();
#define ROW_GRAB(dst) do { unsigned v_ = 0; if (lane == 0) v_ = __hip_atomic_fetch_add(ctr, 1u, __ATOMIC_RELAXED, __HIP_MEMORY_SCOPE_WORKGROUP); dst = (int)__builtin_amdgcn_readfirstlane(v_); } while (0)
#define ROW_LOAD(R, mrow) do { const size_t m_ = (size_t)(mrow); _Pragma("unroll") for (int j = 0; j < 4; ++j) { \
        if (MODE == 0) { R[2 * j] = __builtin_nontemporal_load(((const u32x4*)(xf + m_ * DM)) + (64 * j + lane) * 2); R[2 * j + 1] = __builtin_nontemporal_load(((const u32x4*)(xf + m_ * DM)) + (64 * j + lane) * 2 + 1); } \
        else { R[j] = __builtin_nontemporal_load(((const u32x4*)(xb + m_ * DM)) + 64 * j + lane); R[4 + j] = __builtin_nontemporal_load(((const u32x4*)(delta + m_ * DM)) + 64 * j + lane); } } } while (0)
    f32x4 wp[8];
#pragma unroll
    for (int j = 0; j < 4; ++j) { wp[2 * j] = MODE ? ((const f32x4*)wpost)[(64 * j + lane) * 2] : (f32x4){0.f, 0.f, 0.f, 0.f}; wp[2 * j + 1] = MODE ? ((const f32x4*)wpost)[(64 * j + lane) * 2 + 1] : (f32x4){0.f, 0.f, 0.f, 0.f}; }
    u32x4 raw[8]; int cur, nxt; ROW_GRAB(cur);
    if (cur < rpb) ROW_LOAD(raw, row0 + cur);
    while (cur < rpb) {
        ROW_GRAB(nxt);
        u32x4 rn[8];
        if (nxt < rpb) ROW_LOAD(rn, row0 + nxt);
        else {
#pragma unroll
            for (int j = 0; j < 8; ++j) rn[j] = (u32x4){0u, 0u, 0u, 0u}; }
        const size_t m = (size_t)(row0 + cur);
        f32x4 x[8];
        if (MODE == 0) {
#pragma unroll
            for (int j = 0; j < 8; ++j) x[j] = __builtin_bit_cast(f32x4, raw[j]);
        } else {
            f32x4 d[8]; float s = 0.f;
#pragma unroll
            for (int j = 0; j < 4; ++j) { const u32x4 xw = raw[j], dw = raw[4 + j];
                x[2 * j] = (f32x4){bflo(xw.x), bfhi(xw.x), bflo(xw.y), bfhi(xw.y)}; x[2 * j + 1] = (f32x4){bflo(xw.z), bfhi(xw.z), bflo(xw.w), bfhi(xw.w)};
                d[2 * j] = (f32x4){bflo(dw.x), bfhi(dw.x), bflo(dw.y), bfhi(dw.y)}; d[2 * j + 1] = (f32x4){bflo(dw.z), bfhi(dw.z), bflo(dw.w), bfhi(dw.w)}; }
#pragma unroll
            for (int j = 0; j < 8; ++j) s += (d[j][0] * d[j][0] + d[j][1] * d[j][1]) + (d[j][2] * d[j][2] + d[j][3] * d[j][3]);
            const float rs = rsqrtf(wave_sum(s) * (1.0f / DM) + EPS);
#pragma unroll
            for (int j = 0; j < 8; ++j) x[j] = x[j] + d[j] * rs * wp[j];
        }
        if (MODE == 2) {
#pragma unroll
            for (int j = 0; j < 4; ++j) { __builtin_nontemporal_store(x[2 * j], ((f32x4*)(of + m * DM)) + (64 * j + lane) * 2); __builtin_nontemporal_store(x[2 * j + 1], ((f32x4*)(of + m * DM)) + (64 * j + lane) * 2 + 1); }
        } else {
            float s = 0.f;
#pragma unroll
            for (int j = 0; j < 4; ++j) { u32x4 o; o.x = cvt_pk_bf16(x[2 * j][0], x[2 * j][1]); o.y = cvt_pk_bf16(x[2 * j][2], x[2 * j][3]); o.z = cvt_pk_bf16(x[2 * j + 1][0], x[2 * j + 1][1]); o.w = cvt_pk_bf16(x[2 * j + 1][2], x[2 * j + 1][3]);
                ((u32x4*)(xo + m * DM))[64 * j + lane] = o;
                const float a0 = bflo(o.x), a1 = bfhi(o.x), a2 = bflo(o.y), a3 = bfhi(o.y), a4 = bflo(o.z), a5 = bfhi(o.z), a6 = bflo(o.w), a7 = bfhi(o.w);
                s += ((a0 * a0 + a1 * a1) + (a2 * a2 + a3 * a3)) + ((a4 * a4 + a5 * a5) + (a6 * a6 + a7 * a7)); }
            const float rs = rsqrtf(wave_sum(s) * (1.0f / DM) + EPS);
            if (lane == 0) rso[m] = rs;
        }
#pragma unroll
        for (int j = 0; j < 8; ++j) raw[j] = rn[j];
        cur = nxt;
    }
#undef ROW_LOAD
#undef ROW_GRAB
}

__device__ __forceinline__ void tr_item(const float* src, int lds_, bf16* dst, int ldd, const float* ksc, LAS float* scr, int lane) {
    float tv[32];
#pragma unroll
    for (int i = 0; i < 32; ++i) { const int kk = 2 * i + (lane >> 5); tv[i] = src ? __builtin_nontemporal_load(src + (size_t)kk * lds_ + (lane & 31)) : 0.f; }
#pragma unroll
    for (int i = 0; i < 32; ++i) { const int kk = 2 * i + (lane >> 5); float v = tv[i]; if (ksc) v *= ksc[kk]; scr[kk * 33 + (lane & 31)] = v; }
    LDS_WAIT(); asm volatile("" ::: "memory");
    const int c = lane & 7;
#pragma unroll
    for (int j = 0; j < 4; ++j) { const int n = (lane >> 3) + 8 * j; const LAS float* s = scr + (8 * c) * 33 + n;
        u32x4 o; o.x = pk2(s[0 * 33], s[1 * 33]); o.y = pk2(s[2 * 33], s[3 * 33]); o.z = pk2(s[4 * 33], s[5 * 33]); o.w = pk2(s[6 * 33], s[7 * 33]);
        *(u32x4*)(dst + (size_t)n * ldd + 8 * c) = o; }
    LDS_WAIT(); asm volatile("" ::: "memory");
}
constexpr int IT_WIN = 32 * 192, IT_WUQ = 8 * 96, IT_WUKV = 4 * 128, IT_WO = 32 * 64, IT_WGLU = 16 * 128, IT_WOUT = 32 * 64, IT_WGU = 32 * 352, IT_WDN = 88 * 64;
constexpr int IT_ALL = IT_WIN + IT_WUQ + IT_WUKV + IT_WO + IT_WGLU + IT_WOUT + IT_WGU + IT_WDN;
__device__ __forceinline__ void convert_weights(Ctx& C, int l) {
    LAS float* scr = (LAS float*)(C.lds + C.wave * 16384);
    const int gw = C.bid * NWAVES + C.wave, NGW = C.G * NWAVES, lane = C.lane;
    for (int it = gw; it < IT_ALL; it += NGW) {
        int r = it; const float* src; int lds_; bf16* dst; int ldd; const float* ksc = nullptr;
        if (r < IT_WIN) { const int kb = r / 192, nb = r % 192, n0 = nb * 32, k0 = kb * 64; int sc = -1;
            if (n0 < 768) sc = n0; else if (n0 < 5888) sc = n0 + 64; else if (n0 == 5888) sc = 768; else if (n0 == 5888 + 128) sc = 800;
            const float* W = C_in(I_WIN) + (size_t)l * DM * INW;
            src = sc >= 0 ? W + (size_t)k0 * INW + sc : nullptr; lds_ = INW; dst = C_Win + (size_t)n0 * DM + k0; ldd = DM; ksc = C_in(I_PREMIX) + l * DM + k0; }
        else if ((r -= IT_WIN) < IT_WUQ) { const int kb = r / 96, nb = r % 96, n0 = nb * 32, k0 = kb * 64; int sc;
            if (n0 < 2048) sc = (n0 >> 7) * DQK + (n0 & 127); else { const int rr = n0 - 2048, t = rr >> 8, c = rr & 255, bj = c >> 7, hh = (c & 127) >> 5; sc = (4 * t + hh) * DQK + 128 + bj * 32; }
            const float* W = C_in(I_WUQ) + (size_t)l * QL * (NH * DQK);
            src = W + (size_t)k0 * (NH * DQK) + sc; lds_ = NH * DQK; dst = C_Wuq + (size_t)n0 * QL + k0; ldd = QL; ksc = C_in(I_QNORM) + l * QL + k0; }
        else if ((r -= IT_WUQ) < IT_WUKV) { const int kb = r / 128, nb = r % 128, n0 = nb * 32, k0 = kb * 64;
            const float* W = C_in(I_WUKV) + (size_t)l * KVL * 4096;
            src = W + (size_t)k0 * 4096 + n0; lds_ = 4096; dst = C_Wukv + (size_t)n0 * KVL + k0; ldd = KVL; ksc = C_in(I_KVNORM) + l * KVL + k0; }
        else if ((r -= IT_WUKV) < IT_WO) { const int kb = r / 64, nb = r % 64, n0 = nb * 32, k0 = kb * 64;
            const float* W = C_in(I_WO) + (size_t)l * DM * DM;
            src = W + (size_t)k0 * DM + n0; lds_ = DM; dst = C_Wo + (size_t)n0 * DM + k0; ldd = DM; }
        else if ((r -= IT_WO) < IT_WGLU) { const int kb = r / 128, nb = r % 128, n0 = nb * 32, k0 = kb * 64; const int t = n0 >> 8, bj = (n0 >> 7) & 1, i0 = n0 & 127;
            const float* W = C_in(I_WGLU) + (size_t)l * SW * 4096;
            src = W + (size_t)k0 * 4096 + bj * DM + t * 128 + i0; lds_ = 4096; dst = C_Wglu + (size_t)n0 * SW + k0; ldd = SW; }
        else if ((r -= IT_WGLU) < IT_WOUT) { const int kb = r / 64, nb = r % 64, n0 = nb * 32, k0 = kb * 64;
            const float* W = C_in(I_WOUT) + (size_t)l * DM * DM;
            src = W + (size_t)k0 * DM + n0; lds_ = DM; dst = C_Wout + (size_t)n0 * DM + k0; ldd = DM; }
        else if ((r -= IT_WOUT) < IT_WGU) { const int kb = r / 352, nb = r % 352, n0 = nb * 32, k0 = kb * 64; const int t = n0 >> 8, bj = (n0 >> 7) & 1, i0 = n0 & 127;
            const float* W = (bj ? C_in(I_WFU) : C_in(I_WFG)) + (size_t)l * DM * FF;
            src = W + (size_t)k0 * FF + t * 128 + i0; lds_ = FF; dst = C_Wgu + (size_t)n0 * DM + k0; ldd = DM; ksc = C_in(I_PREFFN) + l * DM + k0; }
        else { r -= IT_WGU; const int kb = r / 64, nb = r % 64, n0 = nb * 32, k0 = kb * 64;
            const float* W = C_in(I_WFD) + (size_t)l * FF * DM;
            src = W + (size_t)k0 * DM + n0; lds_ = DM; dst = C_Wdn + (size_t)n0 * FF + k0; ldd = FF; }
        tr_item(src, lds_, dst, ldd, ksc, scr, lane);
    }
}

__device__ __forceinline__ void rope_tables(Ctx& C) {
    const int* pos = (const int*)C_in(I_POS); float* cT = C_cosT; float* sT = C_sinT;
    for (int i = C.bid * 512 + C.tid; i < T * 32; i += C.G * 512) { const int row = i >> 5, k = i & 31;
        const float inv = __builtin_amdgcn_exp2f(-(float)k * (13.287712379549449f / 32.0f));
        const float ang = (float)pos[row] * inv;
        cT[i] = cosf(ang); sT[i] = sinf(ang); }
}
__device__ __forceinline__ void ssm_lp(Ctx& C, int l) {
    const float* are = C_in(I_ARE) + l * SG * SN; const float* aim = C_in(I_AIM) + l * SG * SN; const float* ldt = C_in(I_LOGDT) + l * SG; f32x2* LPp = C_LP; f32x2* FBp = C_FB;
    for (int i = C.bid * 512 + C.tid; i < SG * 65 * SN; i += C.G * 512) { const int n = i & 63, d = (i >> 6) % 65, g = i / (65 * 64);
        const float dt = expf(ldt[g]), ar = are[g * SN + n], ai = aim[g * SN + n];
        const float e = expf((float)d * (ar * dt)), ang = (float)d * (ai * dt); const float s = sinf(ang), c = cosf(ang);
        LPp[i] = (f32x2){e * c, e * s};
        if (d == 1) { const float lr = e * c, li = e * s, nr = lr - 1.0f, den = ar * ar + ai * ai;
            FBp[g * SN + n] = (f32x2){(nr * ar + li * ai) / den, (li * ar - nr * ai) / den}; } }
}
__device__ __forceinline__ void ssm_tables(Ctx& C, int l) {
    const float* bre = C_in(I_BRE) + (size_t)l * SG * SN * SP; const float* bim = C_in(I_BIM) + (size_t)l * SG * SN * SP;
    const float* cre = C_in(I_CRE) + (size_t)l * SG * SP * SN; const float* cim = C_in(I_CIM) + (size_t)l * SG * SP * SN; const float* dsk_ = C_in(I_SSMD) + l * SW;
    const int gt = C.bid * 512 + C.tid, NT_ = C.G * 512;
    { LAS float* LC = (LAS float*)C.lds; LAS float* LB = LC + 2048; LAS float* LL = LB + 2048; bf16* KDp = C_KD; const f32x2* LPp = C_LP; const f32x2* FBp = C_FB;
      for (int unit = C.bid; unit < SG * 4; unit += C.G) { const int g = unit >> 2, d0 = (unit & 3) * 17, nd = (65 - d0) < 17 ? (65 - d0) : 17;
        for (int i = C.tid; i < 1024; i += NWAVES * 64) { const int n = i >> 4, p = i & 15; const f32x2 f = FBp[g * SN + n]; const float br = bre[(g * SN + n) * SP + p], bi = bim[(g * SN + n) * SP + p];
            LC[2 * i] = cre[(g * SP + p) * SN + n]; LC[2 * i + 1] = cim[(g * SP + p) * SN + n]; LB[2 * i] = f.x * br - f.y * bi; LB[2 * i + 1] = f.x * bi + f.y * br; }
        for (int i = C.tid; i < nd * 64; i += NWAVES * 64) { const int dd = d0 + (i >> 6), n = i & 63; f32x2 L = {0.f, 0.f}; if (dd > 0) L = LPp[(size_t)(g * 65 + dd - 1) * 64 + n]; LL[2 * i] = L.x; LL[2 * i + 1] = L.y; }
        LDS_WAIT(); __syncthreads();
        const int p = (C.tid >> 4) & 15, pp = C.tid & 15, half = C.tid >> 8; float acc[9];
#pragma unroll
        for (int k = 0; k < 9; ++k) acc[k] = 0.f;
        for (int n = 0; n < SN; ++n) { const float cr = LC[(n * 16 + p) * 2], ci = LC[(n * 16 + p) * 2 + 1], br = LB[(n * 16 + pp) * 2], bi = LB[(n * 16 + pp) * 2 + 1];
            const float wr_ = cr * br - ci * bi, wi_ = cr * bi + ci * br;
#pragma unroll
            for (int k = 0; k < 9; ++k) { const int dl = half * 9 + k; if (dl < nd) acc[k] += wr_ * LL[(dl * 64 + n) * 2] - wi_ * LL[(dl * 64 + n) * 2 + 1]; } }
#pragma unroll
        for (int k = 0; k < 9; ++k) { const int dl = half * 9 + k; if (dl < nd) { float v = acc[k]; if (d0 + dl == 1 && p == pp) v += dsk_[g * 16 + p];
                KDp[(size_t)g * (65 * 256) + (d0 + dl) * 256 + p * 16 + pp] = (bf16)f2bf(v); } }
        LDS_WAIT(); __syncthreads(); } }
    for (int i = gt; i < SG * 64 * 128; i += NT_) { const int ncol = i & 127, j = (i >> 7) & 63, g = i >> 13, n = ncol & 63, part = ncol >> 6;
        const f32x2 L = C_LP[(size_t)(g * 65 + 63 - j) * 64 + n], f = C_FB[g * SN + n]; float o[16];
#pragma unroll
        for (int pp = 0; pp < 16; ++pp) { const float br = bre[(g * SN + n) * SP + pp], bi = bim[(g * SN + n) * SP + pp];
            const float Br = f.x * br - f.y * bi, Bi = f.x * bi + f.y * br; o[pp] = part ? (L.x * Bi + L.y * Br) : (L.x * Br - L.y * Bi); }
        u32x4 w0, w1; w0.x = pk2(o[0], o[1]); w0.y = pk2(o[2], o[3]); w0.z = pk2(o[4], o[5]); w0.w = pk2(o[6], o[7]); w1.x = pk2(o[8], o[9]); w1.y = pk2(o[10], o[11]); w1.z = pk2(o[12], o[13]); w1.w = pk2(o[14], o[15]);
        u32x4* dst = (u32x4*)(C_MAT + (size_t)i * 16); dst[0] = w0; dst[1] = w1; }
    for (int i = gt; i < SG * 8 * 1024; i += NT_) { const int p = i & 15, j = (i >> 4) & 63, kk = (i >> 10) & 7, g = i >> 13; float o[16];
#pragma unroll
        for (int k = 0; k < 16; ++k) { const int kq = kk * 16 + k, n = kq & 63, part = kq >> 6; const f32x2 L = C_LP[(size_t)(g * 65 + j + 1) * 64 + n];
            const float cr = cre[(g * SP + p) * SN + n], ci = cim[(g * SP + p) * SN + n]; o[k] = part ? -(cr * L.y + ci * L.x) : (cr * L.x - ci * L.y); }
        u32x4 w0, w1; w0.x = pk2(o[0], o[1]); w0.y = pk2(o[2], o[3]); w0.z = pk2(o[4], o[5]); w0.w = pk2(o[6], o[7]); w1.x = pk2(o[8], o[9]); w1.y = pk2(o[10], o[11]); w1.z = pk2(o[12], o[13]); w1.w = pk2(o[14], o[15]);
        u32x4* dst = (u32x4*)(C_CCT + (size_t)i * 16); dst[0] = w0; dst[1] = w1; }
}

__device__ __forceinline__ int crow(int r, int hi) { return (r & 3) + 8 * (r >> 2) + 4 * hi; }
__device__ __forceinline__ f32x16 mfma32(bf16x8 a, bf16x8 b, f32x16 c) { return __builtin_amdgcn_mfma_f32_32x32x16_bf16(a, b, c, 0, 0, 0); }
__device__ __forceinline__ void ssm_states(Ctx& C) {
    const int lane = C.lane, r32 = lane & 31, hi = lane >> 5, mt = C.wave >> 2, nblk = C.wave & 3;
    LAS float* SL = (LAS float*)C.lds;
    for (int unit = C.bid; unit < SG * BATCH; unit += C.G) { const int g = unit >> 3, b = unit & 7;
        f32x16 acc = {};
        const bf16* ap = C_U + ((size_t)(b * SEQ + (32 * mt + r32) * 64)) * SW + g * 16 + hi * 8;
        const bf16* bp = C_MAT + ((size_t)(g * 64) * 128 + nblk * 32 + r32) * 16 + hi * 8;
#pragma unroll 8
        for (int j = 0; j < 64; ++j) { const bf16x8 a = *(const bf16x8*)(ap + (size_t)j * SW), bb = *(const bf16x8*)(bp + (size_t)j * 128 * 16); acc = mfma32(a, bb, acc); }
#pragma unroll
        for (int r = 0; r < 16; ++r) SL[(32 * mt + crow(r, hi)) * 128 + 32 * nblk + r32] = acc[r];
        LDS_WAIT(); __syncthreads();
        if (C.tid < 64) { const int n = C.tid; const f32x2 lam = C_LP[(size_t)(g * 65 + 64) * 64 + n]; float xr = 0.f, xi = 0.f;
            bf16* xp = C_XST + ((size_t)(b * 64) * 64 + g) * 128 + n;
            for (int c = 0; c < 64; ++c) { xp[(size_t)c * 64 * 128] = (bf16)f2bf(xr); xp[(size_t)c * 64 * 128 + 64] = (bf16)f2bf(xi);
                const float sr = SL[c * 128 + n], si = SL[c * 128 + 64 + n]; const float nr = lam.x * xr - lam.y * xi + sr, ni = lam.x * xi + lam.y * xr + si; xr = nr; xi = ni; } }
        LDS_WAIT(); __syncthreads();
    }
}
#ifndef REPS3
#define REPS3 1
#endif
__device__ __forceinline__ float gelu_tanh(float y) { return y * sigm(1.5957691216057308f * (y + 0.044715f * y * y * y)); }
__device__ __forceinline__ void ssm_outputs(Ctx& C, int l) {
    const int lane = C.lane, r32 = lane & 31, hi = lane >> 5, half = C.wave & 1;
    for (int unit = C.bid; unit < 16 * 16; unit += C.G) { const int gb = unit >> 4, mt = unit & 15, g = 4 * gb + (C.wave >> 1), b = mt >> 1, c0 = 32 * (mt & 1);
        const bf16* up = C_U + ((size_t)(b * SEQ + (c0 + r32) * 64)) * SW + g * 16 + hi * 8;
        const bf16* xp = C_XST + ((size_t)((b * 64 + c0 + r32) * 64 + g)) * 128 + hi * 8;
        { const u32x4* src = (const u32x4*)(C_KD + (size_t)(4 * gb) * (65 * 256)); LAS u32x4* dstl = (LAS u32x4*)C.lds;
          for (int i = C.tid; i < KD_LDS_BYTES / 16; i += NWAVES * 64) dstl[i] = src[i];
          LDS_WAIT(); __syncthreads(); }
        const LAS bf16* kd = (const LAS bf16*)C.lds + (size_t)(C.wave >> 1) * (65 * 256) + r32 * 16 + hi * 8;
        const bf16* cc = C_CCT + ((size_t)(g * 8) * 1024 + r32) * 16 + hi * 8;
        for (int s2 = 0; s2 < 2; ++s2) { const int sp = half ? (2 - s2) : (s2 ? 0 : 3);
            f32x16 acc[8];
_Pragma("unroll")
            for (int rep_ = 0; rep_ < REPS3; ++rep_) {
#pragma unroll
            for (int nb = 0; nb < 8; ++nb) acc[nb] = (f32x16){};
#pragma unroll 2
            for (int kk = 0; kk < 8; ++kk) { const bf16x8 a = *(const bf16x8*)(xp + kk * 16);
#pragma unroll
                for (int nb = 0; nb < 8; ++nb) { const bf16x8 bb = *(const bf16x8*)(cc + ((size_t)kk * 1024 + (16 * sp + 2 * nb) * 16) * 16); acc[nb] = mfma32(a, bb, acc[nb]); } }
            const int iend = 16 * sp + 15;
            for (int i0 = 0; i0 <= iend; i0 += 8) {
                bf16x8 a8[8];
#pragma unroll
                for (int u = 0; u < 8; ++u) a8[u] = *(const bf16x8*)(up + (size_t)(i0 + u) * SW);
#pragma unroll
                for (int u = 0; u < 8; ++u) {
#pragma unroll
                    for (int nb = 0; nb < 8; ++nb) { const int d = 16 * sp + 2 * nb - (i0 + u);
                        if (d >= -1) { const bf16x8 bb = *(const LAS bf16x8*)(kd + (d + 1) * 256); acc[nb] = mfma32(a8[u], bb, acc[nb]); } } } }
            }
            {
                const int p = r32 & 15, toff = r32 >> 4;
                const rsrc_t rz = mk_rsrc(C_Z + ((size_t)(b * SEQ + c0 * 64 + 16 * sp)) * SW + g * 16, (unsigned)((31 * 64 + 16) * SW * 2));
                const unsigned vz = (unsigned)((4 * hi * 64 + toff) * SW + p) * 2u;
#pragma unroll
                for (int nb = 0; nb < 8; ++nb)
#pragma unroll
                    for (int r = 0; r < 16; ++r) __builtin_amdgcn_raw_buffer_store_b16((unsigned short)f2bf(gelu_tanh(acc[nb][r])), rz, vz, (((r & 3) + 8 * (r >> 2)) * 64 + 2 * nb) * SW * 2, 0);
            }
        }
        __syncthreads();
    }
}

namespace att {
constexpr int LDQ = NH * DQK, LDKV = 4096, LDO = DM;
constexpr int SHM_V = 16384, SHM_K = 16384, SHM_KP = 8192;
constexpr int OFF_V = 0, OFF_K = 2 * SHM_V, OFF_KP = OFF_K + 2 * SHM_K, OFF_WS = OFF_KP + 2 * SHM_KP, ATT_LDS = OFF_WS + NWAVES * 64 * 4;
constexpr float THRL = 11.5f;
#define KSWZ(row, colB) ((row) * 256 + ((colB) ^ (((row) & 7) << 4)))
#define KPSWZ(row, colB) ((row) * 128 + ((colB) ^ (((row) & 7) << 4)))
#define SBAR() __builtin_amdgcn_sched_barrier(0)
__device__ __forceinline__ void partialSM(f32x16& p0, f32x16& p1, float& m_reg, float& mn, float& alpha, bool dead) {
    if (dead) {
#pragma unroll
        for (int r = 0; r < 16; ++r) { p0[r] = -1e30f; p1[r] = -1e30f; } }
    float pmax = p0[0];
#pragma unroll
    for (int r = 1; r < 16; ++r) pmax = fmaxf(pmax, p0[r]);
#pragma unroll
    for (int r = 0; r < 16; ++r) pmax = fmaxf(pmax, p1[r]);
    { auto rr = __builtin_amdgcn_permlane32_swap(__float_as_uint(pmax), __float_as_uint(pmax), false, false); pmax = fmaxf(__uint_as_float(rr[0]), __uint_as_float(rr[1])); }
    if (__builtin_expect(__all(pmax - m_reg <= THRL), 1)) { mn = m_reg; alpha = 1.f; }
    else { mn = fmaxf(m_reg, pmax); alpha = __builtin_amdgcn_exp2f(m_reg - mn); m_reg = mn; }
#pragma unroll
    for (int r = 0; r < 16; ++r) p0[r] = p0[r] - mn;
#pragma unroll
    for (int r = 0; r < 16; ++r) p1[r] = p1[r] - mn;
#pragma unroll
    for (int r = 0; r < 16; ++r) p0[r] = __builtin_amdgcn_exp2f(p0[r]);
}
__device__ __forceinline__ void finishSM(f32x16& p0, f32x16& p1, float alpha, float& l_reg, bf16x8& pa0, bf16x8& pa1, bf16x8& pa2, bf16x8& pa3) {
#pragma unroll
    for (int r = 0; r < 16; ++r) p1[r] = __builtin_amdgcn_exp2f(p1[r]);
    float ps = 0;
#pragma unroll
    for (int r = 0; r < 16; ++r) ps += p0[r];
#pragma unroll
    for (int r = 0; r < 16; ++r) ps += p1[r];
    { auto rr = __builtin_amdgcn_permlane32_swap(__float_as_uint(ps), __float_as_uint(ps), false, false); ps = __uint_as_float(rr[0]) + __uint_as_float(rr[1]); }
    l_reg = l_reg * alpha + ps;
#define PK4(P, BASE, OUT) do { unsigned a0 = cvt_pk_bf16(P[BASE + 0], P[BASE + 1]), a1 = cvt_pk_bf16(P[BASE + 2], P[BASE + 3]);   \
    unsigned b0 = cvt_pk_bf16(P[BASE + 4], P[BASE + 5]), b1 = cvt_pk_bf16(P[BASE + 6], P[BASE + 7]);                              \
    auto r0 = __builtin_amdgcn_permlane32_swap(a0, b0, false, false); auto r1 = __builtin_amdgcn_permlane32_swap(a1, b1, false, false); \
    u32x4 w = {r0[0], r1[0], r0[1], r1[1]}; OUT = *reinterpret_cast<bf16x8*>(&w); } while (0)
    PK4(p0, 0, pa0); PK4(p0, 8, pa1); PK4(p1, 0, pa2); PK4(p1, 8, pa3);
#undef PK4
}
__device__ __forceinline__ void qkt(f32x16& p0, f32x16& p1, const LAS char* Ks, const LAS char* KPs, const bf16x8* qr, int r32, int hi) {
    p0 = f32x16{}; p1 = f32x16{};
#pragma unroll
    for (int d0 = 0; d0 < 8; ++d0) { const int cb = (d0 * 16 + hi * 8) * 2;
        const bf16x8 b0 = *(const LAS bf16x8*)(Ks + KSWZ(r32, cb)), b1 = *(const LAS bf16x8*)(Ks + KSWZ(32 + r32, cb));
        p0 = mfma32(b0, qr[d0], p0); p1 = mfma32(b1, qr[d0], p1); }
#pragma unroll
    for (int d0 = 0; d0 < 4; ++d0) { const int cb = (d0 * 16 + hi * 8) * 2;
        const bf16x8 b0 = *(const LAS bf16x8*)(KPs + KPSWZ(r32, cb)), b1 = *(const LAS bf16x8*)(KPs + KPSWZ(32 + r32, cb));
        p0 = mfma32(b0, qr[8 + d0], p0); p1 = mfma32(b1, qr[8 + d0], p1); }
}
__device__ __forceinline__ int v_st(int k, int c) { const int kk = (k & ~0xC) | ((k & 4) << 1) | ((k & 8) >> 1); return ((kk >> 3) * 4 + (c >> 5)) * 512 + ((kk & 7) * 32 + (c & 31)) * 2; }
__device__ __forceinline__ int v_rd_base(int lane) { return ((lane & 3) << 3) | (((lane >> 2) & 3) << 6) | (((lane >> 4) & 1) << 5) | (((lane >> 5) & 1) << 8); }
constexpr int v_rd_off(int d0, int ks, int half) { return d0 * 512 + ks * 4096 + half * 2048; }
template <int OFF> __device__ __forceinline__ s16x4 tr_read(int vb) { s16x4 r; asm volatile("ds_read_b64_tr_b16 %0, %1 offset:%2" : "=&v"(r) : "v"(vb), "i"(OFF) : "memory"); return r; }
template <int D0> __device__ __forceinline__ void pv_one(f32x16& od, int vb, bf16x8 pa0, bf16x8 pa1, bf16x8 pa2, bf16x8 pa3) {
    const s16x4 l0 = tr_read<v_rd_off(D0, 0, 0)>(vb), h0 = tr_read<v_rd_off(D0, 0, 1)>(vb), l1 = tr_read<v_rd_off(D0, 1, 0)>(vb), h1 = tr_read<v_rd_off(D0, 1, 1)>(vb);
    const s16x4 l2 = tr_read<v_rd_off(D0, 2, 0)>(vb), h2 = tr_read<v_rd_off(D0, 2, 1)>(vb), l3 = tr_read<v_rd_off(D0, 3, 0)>(vb), h3 = tr_read<v_rd_off(D0, 3, 1)>(vb);
    asm volatile("s_waitcnt lgkmcnt(0)" ::: "memory"); SBAR();
#define PK(L, H) (bf16x8){L[0], L[1], L[2], L[3], H[0], H[1], H[2], H[3]}
    od = mfma32(pa0, PK(l0, h0), od); od = mfma32(pa1, PK(l1, h1), od); od = mfma32(pa2, PK(l2, h2), od); od = mfma32(pa3, PK(l3, h3), od);
#undef PK
}
__device__ __forceinline__ void pv_d0(f32x16* o, int vb, bf16x8 pa0, bf16x8 pa1, bf16x8 pa2, bf16x8 pa3) {
    pv_one<0>(o[0], vb, pa0, pa1, pa2, pa3); pv_one<1>(o[1], vb, pa0, pa1, pa2, pa3); pv_one<2>(o[2], vb, pa0, pa1, pa2, pa3); pv_one<3>(o[3], vb, pa0, pa1, pa2, pa3);
}
__device__ __forceinline__ void attn_unit(const bf16* __restrict__ Q, const bf16* __restrict__ KV, const bf16* __restrict__ KPE, bf16* __restrict__ O, int b, int h, int qb, LAS char* lds) {
    const int tid = pg8::opaque_tid(), wid = __builtin_amdgcn_readfirstlane(tid >> 6), lane = tid & 63, r32 = lane & 31, hi = lane >> 5;
    LAS char* V_lds = lds + OFF_V; LAS char* K_lds = lds + OFF_K; LAS char* KP_lds = lds + OFF_KP;
    LAS float* ws = (LAS float*)(lds + OFF_WS) + wid * 64; LAS float* li_l = ws; LAS float* al_l = ws + 32;
    const bf16* Kh = KV + (size_t)(b * SEQ) * LDKV + h * 256; const bf16* Vh = Kh + 128; const bf16* Pb = KPE + (size_t)(b * SEQ) * 64;
    const int NT = 4 * qb + 4, NTw = 4 * qb + (wid >> 1) + 1;
    float m_reg = -1e30f, l_reg = 0; f32x16 o[4] = {}; bf16x8 qr[12];
    const bf16* Qw = Q + (size_t)(b * SEQ + qb * 256 + wid * 32 + r32) * LDQ + h * DQK + hi * 8;
#pragma unroll
    for (int d0 = 0; d0 < 12; ++d0) qr[d0] = *(const bf16x8*)(Qw + d0 * 16);
    const int sr = tid >> 4, sc = (tid & 15) * 8, vst0 = v_st(sr, sc), vst1 = v_st(32 + sr, sc), pr = tid >> 3, pc = (tid & 7) * 8;
    const int vb0 = (int)(unsigned)(uintptr_t)V_lds + v_rd_base(lane);
    bf16x8 vs0, vs1, ks0, ks1, kp0;
#define SLOAD(k0) do { vs0 = *(const bf16x8*)(Vh + (size_t)((k0) + sr) * LDKV + sc); vs1 = *(const bf16x8*)(Vh + (size_t)((k0) + 32 + sr) * LDKV + sc); \
    ks0 = *(const bf16x8*)(Kh + (size_t)((k0) + sr) * LDKV + sc); ks1 = *(const bf16x8*)(Kh + (size_t)((k0) + 32 + sr) * LDKV + sc); kp0 = *(const bf16x8*)(Pb + (size_t)((k0) + pr) * 64 + pc); } while (0)
#define SWRITE(bb) do { *(LAS bf16x8*)(V_lds + (bb) * SHM_V + vst0) = vs0; *(LAS bf16x8*)(V_lds + (bb) * SHM_V + vst1) = vs1; \
    *(LAS bf16x8*)(K_lds + (bb) * SHM_K + KSWZ(sr, sc * 2)) = ks0; *(LAS bf16x8*)(K_lds + (bb) * SHM_K + KSWZ(32 + sr, sc * 2)) = ks1; \
    *(LAS bf16x8*)(KP_lds + (bb) * SHM_KP + KPSWZ(pr, pc * 2)) = kp0; } while (0)
#define RESC(a) do { if (__any((a) < 1.f)) { if (hi == 0) al_l[r32] = (a); asm volatile("s_waitcnt lgkmcnt(0)" ::: "memory"); \
    _Pragma("unroll") for (int d = 0; d < 4; ++d) _Pragma("unroll") for (int r = 0; r < 16; ++r) o[d][r] *= al_l[crow(r, hi)]; } } while (0)
    f32x16 p0, p1; float mn, al; bf16x8 pa0, pa1, pa2, pa3;
    SLOAD(0); asm volatile("s_waitcnt vmcnt(0)" ::: "memory"); SWRITE(0); __syncthreads();
    for (int j = 0; j < NT; ++j) {
        const int bsel = j & 1;
        if (j + 1 < NT) SLOAD((j + 1) * 64);
        SBAR();
        if (j < NTw) {
            qkt(p0, p1, K_lds + bsel * SHM_K, KP_lds + bsel * SHM_KP, qr, r32, hi);
            partialSM(p0, p1, m_reg, mn, al, false);
            RESC(al);
            finishSM(p0, p1, al, l_reg, pa0, pa1, pa2, pa3); SBAR();
            pv_d0(o, vb0 + bsel * SHM_V, pa0, pa1, pa2, pa3);
        }
        SBAR();
        if (j + 1 < NT) { asm volatile("s_waitcnt vmcnt(0)" ::: "memory"); SWRITE(bsel ^ 1); }
        __syncthreads();
    }
    if (hi == 0) li_l[r32] = l_reg; asm volatile("s_waitcnt lgkmcnt(0)" ::: "memory");
    float rli[16];
#pragma unroll
    for (int r = 0; r < 16; ++r) rli[r] = __builtin_amdgcn_rcpf(li_l[crow(r, hi)]);
    bf16* Ow = O + (size_t)(b * SEQ + qb * 256 + wid * 32) * LDO + h * 128;
#pragma unroll
    for (int r = 0; r < 16; ++r) { const int orow = crow(r, hi);
#pragma unroll
        for (int d0 = 0; d0 < 4; ++d0) Ow[(size_t)orow * LDO + d0 * 32 + r32] = (bf16)f2bf(o[d0][r] * rli[r]); }
    __syncthreads();
#undef SLOAD
#undef SWRITE
#undef RESC
}
}
__device__ __forceinline__ void attn_phase(Ctx& C) {
    const int x = C.bid & 7, idx = C.bid >> 3, per = C.G >> 3;
    for (int p = idx; p < 128; p += per) { const int bh = 16 * x + (p >> 3), pr = p & 7, b = bh >> 4, h = bh & 15;
        att::attn_unit(C_Q, C_KV, C_KPE, C_RA, b, h, 15 - pr, (LAS char*)C.lds);
        att::attn_unit(C_Q, C_KV, C_KPE, C_RA, b, h, pr, (LAS char*)C.lds); }
}

#ifndef DBG_DELTA
#define DBG_DELTA C_RA
#endif
__global__ void __launch_bounds__(NWAVES * 64, 2) mk_fwd(Args args) {
    extern __shared__ __attribute__((aligned(16))) unsigned char lds_raw[];
    Ctx C;
    C.lds = (LAS unsigned char*)lds_raw;
    volatile LAS unsigned* MISC = (volatile LAS unsigned*)(C.lds + MISC_OFF);
    C.tid = threadIdx.x; C.lane = C.tid & 63; C.wave = __builtin_amdgcn_readfirstlane(C.tid >> 6); C.G = gridDim.x; C.bid = blockIdx.x;
    C.ka = (const CAS char*)__builtin_amdgcn_kernarg_segment_ptr(); gu32* ctl = (gu32*)(args.ws + WS_CTL);
    for (int u = C.tid; u < (LDS_BYTES - MISC_OFF) / 4; u += NWAVES * 64) ((LAS unsigned*)(C.lds + MISC_OFF))[u] = 0u;
    __syncthreads();
    const int lo = args.ph_lo, hi = args.ph_hi;
    const bool fused = (hi - lo) > 1;
    XcdBarrier bar; bar.bar = (unsigned*)(ctl + CW_BAR); bar.x = 0; bar.st = nullptr;
    if (fused) bar = xcd_barrier_post((unsigned*)(ctl + CW_BAR), MISC + 8);
#ifndef PH_MASK
#define PH_MASK 0x1FFF
#endif
#define IN(k) ((((PH_MASK) >> ((k) >= DEPTH * 12 ? 12 : (k) % 12)) & 1) && lo <= (k) && (k) < hi)
#define PH_FENCE() do { asm volatile("" : "+s"(C.ka), "+v"(C.tid)); C.lane = C.tid & 63; C.wave = __builtin_amdgcn_readfirstlane(C.tid >> 6); } while (0)
#ifndef PROBE_STAMP
#define PROBE_STAMP 0
#endif
#ifndef PROBE_STAMP_SEL
#define PROBE_STAMP_SEL 0xFFF
#endif
#define STAMP_AT(k) do { if (PROBE_STAMP && C.tid == 0) ((unsigned long long*)(args.ws + 262144))[C.bid * 64 + (k)] = __builtin_amdgcn_s_memrealtime(); } while (0)
#define STAMP2_AT(k) do { if (PROBE_STAMP && C.tid == 0) ((unsigned long long*)(args.ws + 262144 + 131072))[C.bid * 64 + (k)] = __builtin_amdgcn_s_memrealtime(); } while (0)
#define SEAM(k) do { STAMP_AT(k); if ((k) + 1 < hi) { _Pragma("unroll") for (int rb_ = 0; rb_ < REPN(15); ++rb_) { XcdBarrier b2_ = bar; asm volatile("" : "+s"(b2_.bar)); xcd_barrier(b2_); } } STAMP2_AT(k); } while (0)
#ifndef PROBE_REP_MASK
#define PROBE_REP_MASK 0
#endif
#define REPN(k) ((((PROBE_REP_MASK) >> (k)) & 1) ? 2 : 1)
#define gw (C.bid * NWAVES + C.wave)
#define NGW (C.G * NWAVES)

    for (int l = 0; l < DEPTH; ++l) {
        const int pb = l * 12;
        if (IN(pb + 0)) { PH_FENCE();
_Pragma("unroll")
            for (int rep = 0; rep < REPN(12); ++rep) convert_weights(C, l);
_Pragma("unroll")
            for (int rep = 0; rep < REPN(14); ++rep) { ssm_lp(C, l); if (l == 0) rope_tables(C); }
            if (l == 0) { row_phase<0>(C, C_in(I_X), nullptr, nullptr, nullptr, C_XB, nullptr, C_RS1); }
            else { const float* wpost = C_in(I_POSTFFN) + (l - 1) * DM;
                if (REPN(0) > 1) row_phase<1>(C, nullptr, C_XB, C_F, wpost, C_XB2, nullptr, C_RS1);
                row_phase<1>(C, nullptr, C_XB, C_F, wpost, C_XB, nullptr, C_RS1); }
            SEAM(pb + 0);
        }
        if (IN(pb + 1)) { PH_FENCE();
            EpiInProj E{C_CQ, C_CKV, C_KPE, C_U, C_GA, C_GB, C_ssqq, C_ssqkv, C_in(I_BGATE) + l * 2 * DM, C_cosT, C_sinT, C_RS1, C.lds};
_Pragma("unroll")
            for (int rep = 0; rep < REPN(1); ++rep) run_gemm(C, C_XB, C_Win, NIN, DM, E);
_Pragma("unroll")
            for (int rep = 0; rep < REPN(13); ++rep) ssm_tables(C, l);
            SEAM(pb + 1);
        }
        if (IN(pb + 2)) { PH_FENCE();
_Pragma("unroll")
            for (int rep = 0; rep < REPN(2); ++rep) ssm_states(C);
            if (!fused) SEAM(pb + 2); }
        if (IN(pb + 3)) { PH_FENCE();
#ifndef NO_Q
_Pragma("unroll")
            for (int rep = 0; rep < REPN(3); ++rep) { EpiQ E{C_Q, C_ssqq, C_cosT, C_sinT}; run_gemm(C, C_CQ, C_Wuq, NH * DQK, QL, E); }
#endif
#ifndef NO_KV
_Pragma("unroll")
            for (int rep = 0; rep < REPN(3); ++rep) { EpiKV E{C_KV, C_ssqkv}; run_gemm(C, C_CKV, C_Wukv, 4096, KVL, E); }
#endif
            SEAM(pb + 3);
        }
        if (IN(pb + 4)) { PH_FENCE();
_Pragma("unroll")
            for (int rep = 0; rep < REPN(4); ++rep) ssm_outputs(C, l);
            if (!fused) SEAM(pb + 4); }
        if (IN(pb + 5)) { PH_FENCE();
_Pragma("unroll")
            for (int rep = 0; rep < REPN(5); ++rep) attn_phase(C);
            SEAM(pb + 5); }
        if (IN(pb + 6)) { PH_FENCE(); if (REPN(6) > 1) { EpiPlain E2{C_Q}; run_gemm(C, C_RA, C_Wo, DM, DM, E2); } EpiWo E{C_GA}; run_gemm(C, C_RA, C_Wo, DM, DM, E); SEAM(pb + 6); }
        if (IN(pb + 7)) { PH_FENCE(); if (REPN(7) > 1) { EpiSwiGlu E2{C_Q, C_RS2, C.lds}; run_gemm(C, C_Z, C_Wglu, 4096, SW, E2); } EpiGlu E{C_GA, C_GB, C_in(I_BGLU) + l * 2 * DM}; run_gemm(C, C_Z, C_Wglu, 4096, SW, E); SEAM(pb + 7); }
        #ifdef DBG_K8
        if (IN(pb + 8)) { PH_FENCE(); EpiPlain E{C_GA}; run_gemm(C, C_RA, C_Wout, DM, DM, E); SEAM(pb + 8); }
#else
        if (IN(pb + 8)) { PH_FENCE(); EpiPlain E{C_RA};
_Pragma("unroll")
            for (int rep = 0; rep < REPN(8); ++rep) run_gemm(C, C_GA, C_Wout, DM, DM, E);
            SEAM(pb + 8); }
#endif
        if (IN(pb + 9)) { PH_FENCE();
            const float* wpost = C_in(I_POSTMIX) + l * DM;
            if (REPN(9) > 1) row_phase<1>(C, nullptr, C_XB, DBG_DELTA, wpost, C_XB2, nullptr, C_RS2);
            row_phase<1>(C, nullptr, C_XB, DBG_DELTA, wpost, l == DEPTH - 1 ? C_XB2 : C_XB, nullptr, C_RS2);
            SEAM(pb + 9);
        }
        if (IN(pb + 10)) { PH_FENCE(); EpiSwiGlu E{C_HID, C_RS2, C.lds};
_Pragma("unroll")
            for (int rep = 0; rep < REPN(10); ++rep) run_gemm(C, l == DEPTH - 1 ? C_XB2 : C_XB, C_Wgu, 2 * FF, DM, E);
            SEAM(pb + 10); }
        if (IN(pb + 11)) { PH_FENCE(); EpiPlain E{C_F};
_Pragma("unroll")
            for (int rep = 0; rep < REPN(11); ++rep) run_gemm(C, C_HID, C_Wdn, DM, FF, E);
            SEAM(pb + 11); }
    }
    if (IN(DEPTH * 12)) { PH_FENCE();
        const float* wpost = C_in(I_POSTFFN) + (DEPTH - 1) * DM;
        row_phase<2>(C, nullptr, C_XB2, C_F, wpost, nullptr, C_out, nullptr);
    }
    if (PROBE_STAMP && fused) {
        STAMP_AT(48); { XcdBarrier b2_ = bar; xcd_barrier(b2_); }
        if (C.bid == 0 && C.tid == 0) { const unsigned long long* st = (const unsigned long long*)(args.ws + 262144); unsigned long long q1 = 0, q2 = 0, q3 = 0;
            for (int k = 0; k < 49; ++k) { if (!(((PROBE_STAMP_SEL) >> (k % 12)) & 1)) continue; unsigned long long mx = 0, mn = ~0ull, sm = 0; for (int b = 0; b < C.G; ++b) { const unsigned long long v = __hip_atomic_load(st + b * 64 + k, __ATOMIC_RELAXED, __HIP_MEMORY_SCOPE_AGENT); mx = v > mx ? v : mx; mn = v < mn ? v : mn; sm += v; }
                q1 += mx - mn; q2 += mx - sm / C.G;
                if (PROBE_STAMP == 3) { unsigned long long se = 0; const unsigned long long* st2 = st + 16384; for (int b = 0; b < C.G; ++b) se += __hip_atomic_load(st2 + b * 64 + k, __ATOMIC_RELAXED, __HIP_MEMORY_SCOPE_AGENT); if (se / C.G > mx && mx > 0) q3 += se / C.G - mx; } }
            unsigned long long spin = (PROBE_STAMP == 1 ? q1 : PROBE_STAMP == 3 ? q3 * 4 : q2 * 2); if (spin > 2000000ull) spin = 2000000ull;     const unsigned long long t0 = __builtin_amdgcn_s_memrealtime();
            while (__builtin_amdgcn_s_memrealtime() - t0 < spin) __builtin_amdgcn_s_sleep(8); }
    }
#undef IN
#undef SEAM
#undef gw
#undef NGW
}

#ifndef MK_SINGLE
#define MK_SINGLE 0
#endif
#ifndef MK_PH_END
#define MK_PH_END NPH
#endif
extern "C" void kernel_launch(void* const* d_in, const int* in_sizes, int n_in, void* d_out, int out_size, void* d_ws, size_t ws_size, hipStream_t stream) {
    static int grid = 0;
    if (grid == 0) {
        if (n_in != 27 || in_sizes[0] != T * DM || out_size != T * DM || ws_size < WS_END) { fprintf(stderr, "kernel_launch: unexpected shapes: n_in %d in0 %d out %d ws %zu (need %zu)\n", n_in, n_in > 0 ? in_sizes[0] : -1, out_size, ws_size, (size_t)WS_END); grid = -1; return; }
        int dev = 0, cus = 0, per_cu = 0;
        if (hipGetDevice(&dev) != hipSuccess || hipDeviceGetAttribute(&cus, hipDeviceAttributeMultiprocessorCount, dev) != hipSuccess) { grid = -1; return; }
        if (hipFuncSetAttribute((const void*)mk_fwd, hipFuncAttributeMaxDynamicSharedMemorySize, LDS_BYTES) != hipSuccess) { fprintf(stderr, "kernel_launch: hipFuncSetAttribute failed\n"); grid = -1; return; }
        if (hipOccupancyMaxActiveBlocksPerMultiprocessor(&per_cu, (const void*)mk_fwd, NWAVES * 64, LDS_BYTES) != hipSuccess || per_cu < 1) fprintf(stderr, "kernel_launch: occupancy query says %d\n", per_cu);
        (void)hipGetLastError();
        grid = cus;
    }
    if (grid < 0) return;
    if (hipMemsetAsync((char*)d_ws + WS_CTL, 0, CTL_ZERO_BYTES, stream) != hipSuccess) return;
    Args a{};
    for (int i = 0; i < 27; ++i) a.in[i] = (const float*)d_in[i];
    a.out = (float*)d_out; a.ws = (unsigned char*)d_ws;
#if MK_SINGLE
    a.ph_lo = 0; a.ph_hi = MK_PH_END;
    hipLaunchKernelGGL(mk_fwd, dim3(grid), dim3(NWAVES * 64), LDS_BYTES, stream, a);
#else
    for (int p = 0; p < MK_PH_END; ++p) { a.ph_lo = p; a.ph_hi = p + 1; hipLaunchKernelGGL(mk_fwd, dim3(grid), dim3(NWAVES * 64), LDS_BYTES, stream, a); }
#endif
    const hipError_t le = hipPeekAtLastError();
    if (le != hipSuccess) fprintf(stderr, "kernel_launch: launch failed: %s\n", hipGetErrorName(le));
}
```

```cpp
#include <hip/hip_runtime.h>
#include <cstdio>
#include <cstdint>
#define REPS3 1
#define PROBE_STAMP 0
#define PROBE_STAMP_SEL 0xFFF
#define PROBE_REP_MASK 0
#define MK_ALIGN true
#define MK_SP2 true
#ifndef MK_SINGLE
#define MK_SINGLE 1
#endif
#ifndef MK_PH_END
#define MK_PH_END NPH
#endif
#ifndef PH_MASK
#define PH_MASK 0x1FFF
#endif
#ifndef DBG_DELTA
#define DBG_DELTA C_RA
#endif
#define MK_ST_AUX 0
namespace pg8 {
#define PG8_LAS __attribute__((address_space(3)))
typedef unsigned short bf16_t;
typedef short bf16x8 __attribute__((ext_vector_type(8)));
typedef float f32x4 __attribute__((ext_vector_type(4)));
typedef unsigned u32x4 __attribute__((ext_vector_type(4)));
constexpr int BM = 256, BK = 64, HALF = 128, HTB = HALF * BK * 2  , STAGE_BYTES = 8 * HTB, NXCD = 8, WGM = 8;

__host__ __device__ __forceinline__ int lds_byte(int r, int c) { const int st = (r >> 4) * 2 + (c >> 5), rr = r & 15, cc = c & 31, ob = rr * 64 + cc * 2; return st * 1024 + (ob ^ (((ob >> 9) & 1) << 5)); }
__host__ __device__ __forceinline__ void stage_rc(int b, int& R, int& C) { const int st = b / 1024, sb = b % 1024, swz = sb ^ (((sb >> 9) & 1) << 5); R = (st >> 1) * 16 + swz / 64; C = (st & 1) * 32 + (swz % 64) / 2; }
__host__ __device__ __forceinline__ int perm32(int rho) { const int n = rho >> 4, i = rho & 15; return 8 * (i >> 2) + 4 * n + (i & 3); }

__device__ __forceinline__ int opaque_tid() { int t = threadIdx.x; asm volatile("" : "+v"(t)); return t; }
struct Unit { int pm, pn; };
struct Gemm { const bf16_t* A; const bf16_t* Bt; int M, N, K; };

struct StaticOrder {
    int nM, nN, nwg, G, c;
    __host__ __device__ void init(int M, int N, int G_, int c_) { nM = M / BM; nN = N / BM; nwg = nM * nN; G = G_; c = c_; }
    __host__ __device__ bool next(int i, Unit& u) const {
        const long L = (long)i * G + c; if (L >= nwg) return false;
        int wgid = (int)L; { const int q = nwg / NXCD, r = nwg % NXCD, xcd = wgid % NXCD, off = wgid / NXCD; wgid = (xcd < r ? xcd * (q + 1) : r * (q + 1) + (xcd - r) * q) + off; }
        const int nig = WGM * nN, gid = wgid / nig, fm = gid * WGM, gsz = (nM - fm) < WGM ? (nM - fm) : WGM;
        u.pm = fm + ((wgid % nig) % gsz); u.pn = (wgid % nig) / gsz; return true;
    }
    __device__ __forceinline__ void a_ready(const Unit&) const {}
    __device__ __forceinline__ void done(const Unit&) const {}
};

typedef __bf16 bf16x2_t __attribute__((ext_vector_type(2))); typedef float f32x2_t __attribute__((ext_vector_type(2)));
__device__ __forceinline__ unsigned cvt_pk_bf16(float lo, float hi) { const f32x2_t v = {lo, hi}; const bf16x2_t b = __builtin_convertvector(v, bf16x2_t); return __builtin_bit_cast(unsigned, b); }
template <class Epi, class Sched, bool ALIGN_EPI = false, bool SP2 = false>
__device__ __forceinline__ void gemm_phase(PG8_LAS unsigned char* lds, const Gemm g, const Sched& S, const Epi& E) {
    const int tid = opaque_tid(), wid = __builtin_amdgcn_readfirstlane(tid >> 6), lane = tid & 63, wr = wid >> 2, wc = wid & 3, fr = lane & 15, fq = lane >> 4;
    const int K = g.K, nt = K / BK;
    unsigned voffA[2], voffB[2];
#pragma unroll
    for (int i = 0; i < 2; ++i) { int R, C; stage_rc(tid * 16 + i * 8192, R, C); const int Rb = Epi::PERM ? ((R & ~31) + perm32(R & 31)) : R;
        voffA[i] = (unsigned)(R * K + C) * 2u; voffB[i] = (unsigned)(Rb * K + C) * 2u; }
    const size_t kstep = (size_t)(BK * 2);
    const size_t hstep = (size_t)HALF * K * 2;
    const size_t tstep = 2 * hstep;
    const unsigned ldsw = (unsigned)wid * 1024u;
    const int aoff = lds_byte(wr * 64 + fr, fq * 8), boff = lds_byte(wc * 32 + fr, fq * 8);
#define PG8_SA(b, h) (((b) * 2 + (h)) * HTB)
#define PG8_SB(b, h) ((4 + (b) * 2 + (h)) * HTB)
#define PG8_STAGE(bufoff, gbase, voff) do { _Pragma("unroll") for (int _i = 0; _i < 2; ++_i) \
        __builtin_amdgcn_global_load_lds((const unsigned*)((const char*)(gbase) + (voff)[_i]), (PG8_LAS unsigned*)(lds + (bufoff) + ldsw + _i * 8192), 16, 0, 0); } while (0)
#define PG8_LDA(dst, b, h) do { _Pragma("unroll") for (int m = 0; m < 4; ++m) _Pragma("unroll") for (int k = 0; k < 2; ++k) dst[m][k] = *(const PG8_LAS bf16x8*)(lds + PG8_SA(b, h) + aoff + m * 2048 + k * 1024); } while (0)
#define PG8_LDB(dst, b, h) do { _Pragma("unroll") for (int n = 0; n < 2; ++n) _Pragma("unroll") for (int k = 0; k < 2; ++k) dst[n][k] = *(const PG8_LAS bf16x8*)(lds + PG8_SB(b, h) + boff + n * 2048 + k * 1024); } while (0)
#define PG8_MMA(ai, bj, At, Bt) do { __builtin_amdgcn_s_setprio(1); _Pragma("unroll") for (int m = 0; m < 4; ++m) _Pragma("unroll") for (int n = 0; n < 2; ++n) _Pragma("unroll") for (int k = 0; k < 2; ++k) \
        acc[ai][bj][m][n] = __builtin_amdgcn_mfma_f32_16x16x32_bf16(Bt[n][k], At[m][k], acc[ai][bj][m][n], 0, 0, 0); __builtin_amdgcn_s_setprio(0); } while (0)
#define PG8_WAIT_V(n) asm volatile("s_waitcnt vmcnt(" #n ")" ::: "memory")
#define PG8_WAIT_L(n) asm volatile("s_waitcnt lgkmcnt(" #n ")" ::: "memory")
#define PG8_BAR __builtin_amdgcn_s_barrier()
#define PG8_SCHED __builtin_amdgcn_sched_barrier(0)
    Unit cur, nxt; int ui = 0;
    if (!S.next(0, cur)) return;
    f32x4 acc[2][2][4][2];
#pragma unroll
    for (int a = 0; a < 2; ++a)
#pragma unroll
        for (int b = 0; b < 2; ++b)
#pragma unroll
            for (int m = 0; m < 4; ++m)
#pragma unroll
                for (int n = 0; n < 2; ++n) acc[a][b][m][n] = (f32x4){0.f, 0.f, 0.f, 0.f};
    bf16x8 At[4][2], B0[2][2], B1[2][2];
    const char* cA = (const char*)g.A + (size_t)cur.pm * tstep; const char* cB = (const char*)g.Bt + (size_t)cur.pn * tstep;
    S.a_ready(cur);
    if constexpr (SP2) {
        PG8_STAGE(PG8_SB(0, 0), cB, voffB); PG8_STAGE(PG8_SB(0, 1), cB + hstep, voffB); PG8_STAGE(PG8_SA(0, 0), cA, voffA); PG8_STAGE(PG8_SA(0, 1), cA + hstep, voffA);
        if (wr == 1) PG8_BAR;
        PG8_WAIT_V(2); PG8_BAR;
        PG8_STAGE(PG8_SB(1, 0), cB + kstep, voffB); PG8_STAGE(PG8_SA(1, 0), cA + kstep, voffA); PG8_STAGE(PG8_SB(1, 1), cB + hstep + kstep, voffB);
        PG8_WAIT_V(6); PG8_BAR;
    } else {
        PG8_STAGE(PG8_SB(0, 0), cB, voffB); PG8_STAGE(PG8_SA(0, 0), cA, voffA); PG8_STAGE(PG8_SB(0, 1), cB + hstep, voffB); PG8_STAGE(PG8_SA(0, 1), cA + hstep, voffA);
        if (wr == 1) PG8_BAR;
        PG8_WAIT_V(4); PG8_BAR;
        PG8_STAGE(PG8_SB(1, 0), cB + kstep, voffB); PG8_STAGE(PG8_SA(1, 0), cA + kstep, voffA); PG8_STAGE(PG8_SB(1, 1), cB + hstep + kstep, voffB);
        PG8_WAIT_V(6); PG8_BAR;
    }
    for (;;) {
        const bool has_next = S.next(ui + 1, nxt);
        const char* nA = has_next ? (const char*)g.A + (size_t)nxt.pm * tstep : cA; const char* nB = has_next ? (const char*)g.Bt + (size_t)nxt.pn * tstep : cB;
        for (int t = 0; t < nt; t += 2) {
            const bool last = (t == nt - 2);
            const char* a1 = cA + (size_t)(t + 1) * kstep;
            const char* a2 = last ? nA : cA + (size_t)(t + 2) * kstep; const char* b2 = last ? nB : cB + (size_t)(t + 2) * kstep;
            const char* a3 = a2 + kstep; const char* b3 = b2 + kstep;
            if (last && has_next) S.a_ready(nxt);
            if constexpr (SP2) {
            PG8_LDB(B0, 0, 0); PG8_LDB(B1, 0, 1); PG8_SCHED; PG8_LDA(At, 0, 0); PG8_STAGE(PG8_SA(1, 1), a1 + hstep, voffA);
            PG8_WAIT_V(8); PG8_WAIT_L(0); PG8_BAR; PG8_MMA(0, 0, At, B0); PG8_MMA(0, 1, At, B1); PG8_BAR; PG8_SCHED;
            PG8_LDA(At, 0, 1); PG8_STAGE(PG8_SB(0, 0), b2, voffB); PG8_STAGE(PG8_SB(0, 1), b2 + hstep, voffB); PG8_STAGE(PG8_SA(0, 0), a2, voffA);
            PG8_WAIT_V(8); PG8_WAIT_L(0); PG8_BAR; PG8_MMA(1, 0, At, B0); PG8_MMA(1, 1, At, B1); PG8_BAR; PG8_SCHED;
            PG8_LDB(B0, 1, 0); PG8_LDB(B1, 1, 1); PG8_SCHED; PG8_LDA(At, 1, 0); PG8_STAGE(PG8_SA(0, 1), a2 + hstep, voffA);
            PG8_WAIT_V(8); PG8_WAIT_L(0); PG8_BAR; PG8_MMA(0, 0, At, B0); PG8_MMA(0, 1, At, B1); PG8_BAR; PG8_SCHED;
            PG8_LDA(At, 1, 1); PG8_STAGE(PG8_SB(1, 0), b3, voffB); PG8_STAGE(PG8_SB(1, 1), b3 + hstep, voffB); PG8_STAGE(PG8_SA(1, 0), a3, voffA);
            PG8_WAIT_V(8); PG8_WAIT_L(0); PG8_BAR; PG8_MMA(1, 0, At, B0); PG8_MMA(1, 1, At, B1); PG8_BAR; PG8_SCHED;
            } else {
            PG8_LDB(B0, 0, 0); PG8_SCHED; PG8_LDA(At, 0, 0); PG8_STAGE(PG8_SA(1, 1), a1 + hstep, voffA);
            PG8_WAIT_L(8); PG8_BAR; PG8_WAIT_L(0); PG8_MMA(0, 0, At, B0); PG8_BAR; PG8_SCHED;
            PG8_LDB(B1, 0, 1); PG8_STAGE(PG8_SB(0, 0), b2, voffB);
            PG8_BAR; PG8_WAIT_L(0); PG8_MMA(0, 1, At, B1); PG8_BAR;
            PG8_LDA(At, 0, 1); PG8_STAGE(PG8_SA(0, 0), a2, voffA);
            PG8_BAR; PG8_WAIT_L(0); PG8_MMA(1, 0, At, B0); PG8_BAR; PG8_SCHED;
            PG8_STAGE(PG8_SB(0, 1), b2 + hstep, voffB);
            PG8_WAIT_V(6); PG8_BAR; PG8_MMA(1, 1, At, B1); PG8_BAR;
            PG8_LDB(B0, 1, 0); PG8_SCHED; PG8_LDA(At, 1, 0); PG8_STAGE(PG8_SA(0, 1), a2 + hstep, voffA);
            PG8_WAIT_L(8); PG8_BAR; PG8_WAIT_L(0); PG8_MMA(0, 0, At, B0); PG8_BAR; PG8_SCHED;
            PG8_LDB(B1, 1, 1); PG8_STAGE(PG8_SB(1, 0), b3, voffB);
            PG8_BAR; PG8_WAIT_L(0); PG8_MMA(0, 1, At, B1); PG8_BAR;
            PG8_LDA(At, 1, 1); PG8_STAGE(PG8_SA(1, 0), a3, voffA);
            PG8_BAR; PG8_WAIT_L(0); PG8_MMA(1, 0, At, B0); PG8_BAR; PG8_SCHED;
            PG8_STAGE(PG8_SB(1, 1), b3 + hstep, voffB);
            PG8_WAIT_V(6); PG8_BAR; PG8_MMA(1, 1, At, B1); PG8_BAR;
            }
        }
        if constexpr (ALIGN_EPI) { if (wr == 0) PG8_BAR; }
        if constexpr (!Epi::AFTER_DRAIN) { E(acc, cur, wr, wc, fr, fq); S.done(cur); }
        if (!has_next) break;
#pragma unroll
        for (int a = 0; a < 2; ++a)
#pragma unroll
            for (int b = 0; b < 2; ++b)
#pragma unroll
                for (int m = 0; m < 4; ++m)
#pragma unroll
                    for (int n = 0; n < 2; ++n) acc[a][b][m][n] = (f32x4){0.f, 0.f, 0.f, 0.f};
        cur = nxt; cA = nA; cB = nB; ++ui;
        if constexpr (ALIGN_EPI) { if (wr == 1) PG8_BAR; }
    }
    PG8_WAIT_V(0);
    if constexpr (!ALIGN_EPI) { if (wr == 0) PG8_BAR; }
    PG8_BAR;
    if constexpr (Epi::AFTER_DRAIN) { E.fused(acc, cur, wr, wc, fr, fq, lds, wid, lane); S.done(cur); }
#undef PG8_SA
#undef PG8_SB
#undef PG8_STAGE
#undef PG8_LDA
#undef PG8_LDB
#undef PG8_MMA
#undef PG8_WAIT_V
#undef PG8_WAIT_L
#undef PG8_BAR
#undef PG8_SCHED
}
}

constexpr int BATCH = 8, SEQ = 4096, DM = 2048, DEPTH = 4, T = BATCH * SEQ;
constexpr int NH = 16, DQK = 192, QL = 512, KVL = 256;
constexpr int SW = 1024, SG = 64, SN = 64, SP = 16, FF = 5632;
constexpr int INW = 5952, OFF_SSM = 832, OFF_GATE = 1856;
constexpr int NIN = 6144;
constexpr float EPS = 1e-6f;
constexpr float QSCALE = 0.07216878364870322f * 1.4426950408889634f;
constexpr int NWAVES = 8;
constexpr int NPH = DEPTH * 12 + 1;

constexpr size_t MiB = 1u << 20;
constexpr size_t WS_CTL = 0, CTL_ZERO_BYTES = 1 * MiB;
constexpr size_t WS_COS = 1 * MiB, WS_SIN = 5 * MiB;
constexpr size_t WS_SSQQ = 9 * MiB, WS_SSQKV = 10 * MiB;
constexpr size_t WS_RS1 = 10 * MiB + 512 * 1024, WS_RS2 = 10 * MiB + 768 * 1024;
constexpr size_t WS_LP = 11 * MiB;
constexpr size_t WS_FB = WS_LP + 5 * MiB / 2;
constexpr size_t WS_KD = 14 * MiB;
constexpr size_t WS_MAT = 17 * MiB;
constexpr size_t WS_CCT = 33 * MiB;
constexpr size_t WS_XST = 49 * MiB;
constexpr size_t WS_W = 57 * MiB;
constexpr size_t WO_WIN = 0, WO_WUQ = 24 * MiB, WO_WUKV = 27 * MiB, WO_WO = 29 * MiB, WO_WGLU = 37 * MiB, WO_WOUT = 45 * MiB, WO_WGU = 53 * MiB, WO_WDN = 97 * MiB;
constexpr size_t WS_RA = 176 * MiB;
constexpr size_t WS_CQ = 304 * MiB, WS_CKV = 336 * MiB, WS_KPE = 352 * MiB, WS_U = 356 * MiB, WS_GA = 420 * MiB, WS_GB = 548 * MiB;
constexpr size_t WS_HID = 304 * MiB;
constexpr size_t WS_Q = 676 * MiB;
constexpr size_t WS_KV = 868 * MiB;
constexpr size_t WS_Z = 1124 * MiB;
constexpr size_t WS_END = 1188 * MiB;
static_assert(WS_HID + (size_t)T * FF * 2 <= WS_Q, "HID overlay");

constexpr int CW_TMO = 0, CW_CODE = 1, CW_BAR = 4096;

constexpr int RING_BYTES = 131072, KD_LDS_BYTES = 4 * 65 * 256 * 2, LDS_BYTES = 163840, MISC_OFF = LDS_BYTES - 512;

#define GAS __attribute__((address_space(1)))
#define LAS __attribute__((address_space(3)))
#define CAS __attribute__((address_space(4)))
typedef unsigned short bf16;
using pg8::bf16x8; using pg8::f32x4; using pg8::u32x4; using pg8::cvt_pk_bf16;
typedef float f32x2 __attribute__((ext_vector_type(2)));
typedef float f32x16 __attribute__((ext_vector_type(16)));
typedef unsigned u32x2 __attribute__((ext_vector_type(2)));
typedef short s16x4 __attribute__((ext_vector_type(4)));
typedef GAS unsigned gu32;
#define RLX_AGENT __ATOMIC_RELAXED, __HIP_MEMORY_SCOPE_AGENT
#define LDS_WAIT() asm volatile("s_waitcnt lgkmcnt(0)" ::: "memory")
#define VM_WAIT() asm volatile("s_waitcnt vmcnt(0)" ::: "memory")
__device__ __forceinline__ unsigned f2bf(float f) { unsigned u = __builtin_bit_cast(unsigned, f); return (u + 0x7fffu + ((u >> 16) & 1u)) >> 16; }
__device__ __forceinline__ unsigned pk2(float lo, float hi) { return f2bf(lo) | (f2bf(hi) << 16); }
__device__ __forceinline__ float bflo(unsigned w) { return __uint_as_float(w << 16); }
__device__ __forceinline__ float bfhi(unsigned w) { return __uint_as_float(w & 0xffff0000u); }
__device__ __forceinline__ float sigm(float x) { return __builtin_amdgcn_rcpf(1.0f + __builtin_amdgcn_exp2f(-1.4426950408889634f * x)); }
__device__ __forceinline__ void st8(bf16* p, f32x4 v0, f32x4 v1) { u32x4 w; w.x = cvt_pk_bf16(v0[0], v0[1]); w.y = cvt_pk_bf16(v0[2], v0[3]); w.z = cvt_pk_bf16(v1[0], v1[1]); w.w = cvt_pk_bf16(v1[2], v1[3]); *(u32x4*)p = w; }
__device__ __forceinline__ void ld8(const bf16* p, f32x4& v0, f32x4& v1) { const u32x4 w = *(const u32x4*)p; v0[0] = bflo(w.x); v0[1] = bfhi(w.x); v0[2] = bflo(w.y); v0[3] = bfhi(w.y); v1[0] = bflo(w.z); v1[1] = bfhi(w.z); v1[2] = bflo(w.w); v1[3] = bfhi(w.w); }
__device__ __forceinline__ float wave_sum(float v) {
#pragma unroll
    for (int o = 1; o < 64; o <<= 1) v += __shfl_xor(v, o);
    return v;
}

#define XB_TMO      128
#define XB_XCNT(j)  (256  + 64 * (j))
#define XB_XSUB(j)  (1280 + 64 * (j))
#define XB_XGEN(j)  (2304 + 64 * (j))
#define XB_TOP      3328
#define XB_TOPGEN   3392
#define XCD_BAR_WORDS 3456
#define XB_SPIN_CAP (1u << 18)

__device__ __forceinline__ unsigned xb_ld(unsigned* p)              { return __hip_atomic_load(p, __ATOMIC_RELAXED, __HIP_MEMORY_SCOPE_AGENT); }
__device__ __forceinline__ unsigned xb_add(unsigned* p, unsigned v) { return __hip_atomic_fetch_add(p, v, __ATOMIC_RELAXED, __HIP_MEMORY_SCOPE_AGENT); }
__device__ __forceinline__ unsigned xb_xcc_id() { return (unsigned)__builtin_amdgcn_s_getreg((3 << 11) | 20) & 0xFu; }
#define XB_SPIN(cond, bar) do { unsigned _sp = 0; while (cond) { __builtin_amdgcn_s_sleep(1); \
    if ((++_sp & 255u) == 0u) { if (xb_ld(&(bar)[XB_TMO])) break; if (_sp > XB_SPIN_CAP) { atomicAdd(&(bar)[XB_TMO], 1u); break; } } } } while (0)

struct XcdBarrier {
    unsigned* bar; unsigned x;
    volatile LAS unsigned* st;
};

__device__ __forceinline__ XcdBarrier xcd_barrier_post(unsigned* bar, volatile LAS unsigned* st) {
    XcdBarrier b; b.bar = bar; b.x = xb_xcc_id(); b.st = st;
    if (threadIdx.x == 0) (void)xb_add(&bar[XB_XCNT(b.x)], 1u);
    return b;
}
__device__ __forceinline__ void xcd_barrier_complete(unsigned* bar, unsigned x, unsigned& nloc, unsigned& nx) {
    const unsigned G = gridDim.x * gridDim.y * gridDim.z;
    unsigned sum, cnt, mine, sp = 0u;
    for (;;) {
        sum = 0u; cnt = 0u; mine = 0u;
#pragma unroll
        for (unsigned j = 0; j < 16; ++j) { const unsigned c = xb_ld(&bar[XB_XCNT(j)]); sum += c; cnt += (c > 0u) ? 1u : 0u; mine = (j == x) ? c : mine; }
        if (sum == G) break;
        __builtin_amdgcn_s_sleep(1);
        if ((++sp & 255u) == 0u) { if (xb_ld(&bar[XB_TMO])) break; if (sp > XB_SPIN_CAP) { atomicAdd(&bar[XB_TMO], 1u); break; } }
    }
    nloc = mine > 0u ? mine : 1u; nx = cnt > 0u ? cnt : 1u;
}

__device__ __forceinline__ void xcd_barrier(const XcdBarrier& b) {
#ifdef XB_TWICE
#pragma nounroll
    for (int rr_ = 0; rr_ < 2; ++rr_) {
#endif
    asm volatile("s_waitcnt vmcnt(0)" ::: "memory");
    __syncthreads();
    if (threadIdx.x == 0) {
        unsigned* bar = b.bar;
        __builtin_amdgcn_s_waitcnt(0);
        unsigned nloc = b.st[0], nx = b.st[1];
        if (nloc == 0u) { xcd_barrier_complete(bar, b.x, nloc, nx); b.st[0] = nloc; b.st[1] = nx; }
        const unsigned old = xb_add(&bar[XB_XSUB(b.x)], 1u);
        const unsigned gen = old / nloc;
        if (old + 1u == (gen + 1u) * nloc) {
#ifndef XB_NO_WB
            __builtin_amdgcn_fence(__ATOMIC_RELEASE, "agent");
#endif
            asm volatile("s_waitcnt vmcnt(0)" ::: "memory");
#ifdef XB_DOUBLE_WB
            __builtin_amdgcn_fence(__ATOMIC_RELEASE, "agent"); asm volatile("s_waitcnt vmcnt(0)" ::: "memory");
#endif
            const unsigned og = xb_add(&bar[XB_TOP], 1u);
            const unsigned tg = og / nx;
            if (og + 1u == (tg + 1u) * nx) xb_add(&bar[XB_TOPGEN], 1u);
            else XB_SPIN(xb_ld(&bar[XB_TOPGEN]) == tg, bar);
            __builtin_amdgcn_fence(__ATOMIC_ACQUIRE, "agent");
            xb_add(&bar[XB_XGEN(b.x)], 1u);
            asm volatile("s_waitcnt vmcnt(0)" ::: "memory");
        } else {
            XB_SPIN(xb_ld(&bar[XB_XGEN(b.x)]) == gen, bar);
#ifndef XB_NO_LOCAL_INV
            __builtin_amdgcn_fence(__ATOMIC_ACQUIRE, "agent");
#endif
            asm volatile("s_waitcnt vmcnt(0)" ::: "memory");
        }
    }
    __syncthreads();
#ifdef XB_TWICE
    }
#endif
}

struct Args { const float* in[27]; float* out; unsigned char* ws; int ph_lo, ph_hi; };
struct Ctx {
    LAS unsigned char* lds;
    int tid, lane, wave, G, bid;
    const CAS char* ka;
};
static_assert(sizeof(Args) == 240, "Args layout");
#define C_in(i) (*(const float* const CAS*)(C.ka + 8 * (i)))
#define C_out (*(float* const CAS*)(C.ka + 216))
#define C_ws (*(unsigned char* const CAS*)(C.ka + 224))
#define WSP(TY, off) ((TY*)(C_ws + (off)))
#define C_cosT WSP(float, WS_COS)
#define C_sinT WSP(float, WS_SIN)
#define C_ssqq WSP(float, WS_SSQQ)
#define C_ssqkv WSP(float, WS_SSQKV)
#define C_LP WSP(f32x2, WS_LP)
#define C_FB WSP(f32x2, WS_FB)
#define C_KD WSP(bf16, WS_KD)
#define C_MAT WSP(bf16, WS_MAT)
#define C_CCT WSP(bf16, WS_CCT)
#define C_XST WSP(bf16, WS_XST)
#define C_Win WSP(bf16, WS_W + WO_WIN)
#define C_Wuq WSP(bf16, WS_W + WO_WUQ)
#define C_Wukv WSP(bf16, WS_W + WO_WUKV)
#define C_Wo WSP(bf16, WS_W + WO_WO)
#define C_Wglu WSP(bf16, WS_W + WO_WGLU)
#define C_Wout WSP(bf16, WS_W + WO_WOUT)
#define C_Wgu WSP(bf16, WS_W + WO_WGU)
#define C_Wdn WSP(bf16, WS_W + WO_WDN)
#define C_RA WSP(bf16, WS_RA)
#define C_CQ WSP(bf16, WS_CQ)
#define C_CKV WSP(bf16, WS_CKV)
#define C_KPE WSP(bf16, WS_KPE)
#define C_U WSP(bf16, WS_U)
#define C_GA WSP(bf16, WS_GA)
#define C_GB WSP(bf16, WS_GB)
#define C_HID WSP(bf16, WS_HID)
#define C_Q WSP(bf16, WS_Q)
#define C_KV WSP(bf16, WS_KV)
#define C_Z WSP(bf16, WS_Z)
#define C_XB2 WSP(bf16, WS_Q)
#define C_XB ((bf16*)C_out)
#define C_RS1 WSP(float, WS_RS1)
#define C_RS2 WSP(float, WS_RS2)
#define C_F WSP(bf16, WS_KV)
enum { I_X = 0, I_POS, I_PREMIX, I_WIN, I_BGATE, I_QNORM, I_KVNORM, I_WUQ, I_WUKV, I_WO, I_ARE, I_AIM, I_LOGDT, I_BRE, I_BIM, I_CRE, I_CIM, I_SSMD, I_WGLU, I_BGLU, I_WOUT, I_POSTMIX, I_PREFFN, I_WFG, I_WFU, I_WFD, I_POSTFFN };

using pg8::Unit;
#define EPI_HDR static constexpr bool PERM = true, AFTER_DRAIN = false;
#define EPI_ARGS const f32x4 (&acc)[2][2][4][2], const Unit& u, int wr, int wc, int fr, int fq
#define FOR_AI_M _Pragma("unroll") for (int ai = 0; ai < 2; ++ai) _Pragma("unroll") for (int m = 0; m < 4; ++m)

#ifndef MK_ST_AUX
#define MK_ST_AUX 16
#endif
typedef __amdgpu_buffer_rsrc_t rsrc_t;
__device__ __forceinline__ rsrc_t mk_rsrc(const void* p, unsigned bytes) { return __builtin_amdgcn_make_buffer_rsrc((void*)p, (short)0, (int)bytes, 0x00020000); }
__device__ __forceinline__ void bst8(rsrc_t r, unsigned voff, unsigned soff, f32x4 v0, f32x4 v1) { u32x4 w; w.x = cvt_pk_bf16(v0[0], v0[1]); w.y = cvt_pk_bf16(v0[2], v0[3]); w.z = cvt_pk_bf16(v1[0], v1[1]); w.w = cvt_pk_bf16(v1[2], v1[3]); __builtin_amdgcn_raw_buffer_store_b128(w, r, voff + soff, 0, MK_ST_AUX); }
__device__ __forceinline__ void bld8(rsrc_t r, unsigned voff, unsigned soff, f32x4& v0, f32x4& v1) { const u32x4 w = __builtin_amdgcn_raw_buffer_load_b128(r, voff, soff, 0); v0[0] = bflo(w.x); v0[1] = bfhi(w.x); v0[2] = bflo(w.y); v0[3] = bfhi(w.y); v1[0] = bflo(w.z); v1[1] = bfhi(w.z); v1[2] = bflo(w.w); v1[3] = bfhi(w.w); }
__device__ __forceinline__ f32x4 bldf4(rsrc_t r, unsigned voff, unsigned soff) { return __builtin_bit_cast(f32x4, __builtin_amdgcn_raw_buffer_load_b128(r, voff, soff, 0)); }
#define ROWG (ai * 128 + m * 16)
#define TILE_BYTES(PB) (255u * (PB) + (PB))
#define RS_LOAD(P) float rsv[2][4]; { const rsrc_t rr_ = mk_rsrc((P) + r0, 1024); FOR_AI_M rsv[ai][m] = __uint_as_float(__builtin_amdgcn_raw_buffer_load_b32(rr_, (unsigned)lr * 4u, ROWG * 4, 0)); }

struct EpiInProj { EPI_HDR
    bf16 *CQ, *CKV, *KPE, *U, *GA, *GB; float *ssqq, *ssqkv; const float *bgate, *cosT, *sinT, *rsr;
    __device__ __forceinline__ void operator()(EPI_ARGS) const {
        const int pn = u.pn, lr = wr * 64 + fr, cl = wc * 32 + 8 * fq; const size_t r0 = (size_t)u.pm * 256;
        RS_LOAD(rsr);
        if (pn < 2) {
            const rsrc_t rb = mk_rsrc(CQ + r0 * QL + pn * 256, TILE_BYTES(QL * 2)), rq = mk_rsrc(ssqq + r0 * 8, 256 * 32);
            const unsigned vo = (unsigned)(lr * QL + cl) * 2u, vs = (unsigned)(lr * 8 + pn * 4 + wc) * 4u;
            FOR_AI_M { float s = 0.f;
#pragma unroll
                for (int bj = 0; bj < 2; ++bj) { const f32x4 v0 = acc[ai][bj][m][0] * rsv[ai][m], v1 = acc[ai][bj][m][1] * rsv[ai][m];
                    s += (v0[0] * v0[0] + v0[1] * v0[1]) + (v0[2] * v0[2] + v0[3] * v0[3]) + (v1[0] * v1[0] + v1[1] * v1[1]) + (v1[2] * v1[2] + v1[3] * v1[3]);
                    bst8(rb, vo, ROWG * QL * 2 + bj * 256, v0, v1); }
                s += __shfl_xor(s, 16); s += __shfl_xor(s, 32);
                if (fq == 0) __builtin_amdgcn_raw_buffer_store_b32(__float_as_uint(s), rq, vs + ROWG * 32, 0, 0); }
        } else if (pn == 2) {
            const rsrc_t rb = mk_rsrc(CKV + r0 * KVL, TILE_BYTES(KVL * 2)), rq = mk_rsrc(ssqkv + r0 * 4, 256 * 16);
            const unsigned vo = (unsigned)(lr * KVL + cl) * 2u, vs = (unsigned)(lr * 4 + wc) * 4u;
            FOR_AI_M { float s = 0.f;
#pragma unroll
                for (int bj = 0; bj < 2; ++bj) { const f32x4 v0 = acc[ai][bj][m][0] * rsv[ai][m], v1 = acc[ai][bj][m][1] * rsv[ai][m];
                    s += (v0[0] * v0[0] + v0[1] * v0[1]) + (v0[2] * v0[2] + v0[3] * v0[3]) + (v1[0] * v1[0] + v1[1] * v1[1]) + (v1[2] * v1[2] + v1[3] * v1[3]);
                    bst8(rb, vo, ROWG * KVL * 2 + bj * 256, v0, v1); }
                s += __shfl_xor(s, 16); s += __shfl_xor(s, 32);
                if (fq == 0) __builtin_amdgcn_raw_buffer_store_b32(__float_as_uint(s), rq, vs + ROWG * 16, 0, 0); }
        } else if (pn < 7) {
            const rsrc_t rb = mk_rsrc(U + r0 * SW + (pn - 3) * 256, TILE_BYTES(SW * 2)); const unsigned vo = (unsigned)(lr * SW + cl) * 2u;
            FOR_AI_M {
#pragma unroll
                for (int bj = 0; bj < 2; ++bj) bst8(rb, vo, ROWG * SW * 2 + bj * 256, acc[ai][bj][m][0] * rsv[ai][m], acc[ai][bj][m][1] * rsv[ai][m]); }
        } else if (pn < 23) {
            const int colt = (pn - (pn < 15 ? 7 : 15)) * 256;
            const rsrc_t rb = mk_rsrc((pn < 15 ? GA : GB) + r0 * DM + colt, TILE_BYTES(DM * 2)); const unsigned vo = (unsigned)(lr * DM + cl) * 2u;
            const float* bb = bgate + (pn < 15 ? 0 : DM) + colt + cl;
            f32x4 bv[2][2];
#pragma unroll
            for (int bj = 0; bj < 2; ++bj) { bv[bj][0] = *(const f32x4*)(bb + bj * 128); bv[bj][1] = *(const f32x4*)(bb + bj * 128 + 4); }
            FOR_AI_M {
#pragma unroll
                for (int bj = 0; bj < 2; ++bj) { f32x4 v0 = acc[ai][bj][m][0] * rsv[ai][m] + bv[bj][0], v1 = acc[ai][bj][m][1] * rsv[ai][m] + bv[bj][1];
#pragma unroll
                    for (int e = 0; e < 4; ++e) { v0[e] = sigm(v0[e]); v1[e] = sigm(v1[e]); }
#ifdef DBG_PLAINGATE
                    v0 = acc[ai][bj][m][0]; v1 = acc[ai][bj][m][1];
#endif
#ifdef DBG_BIASONLY
#pragma unroll
                    for (int e = 0; e < 4; ++e) { float t0 = acc[ai][bj][m][0][e] + bv[bj][0][e], t1 = acc[ai][bj][m][1][e] + bv[bj][1][e]; asm volatile("" : "+v"(t0), "+v"(t1)); v0[e] = t0; v1[e] = t1; }
#endif
                    bst8(rb, vo, ROWG * DM * 2 + bj * 256, v0, v1); } }
        } else if (wc == 0) {
            const rsrc_t rb = mk_rsrc(KPE + r0 * 64, 256 * 128), rc = mk_rsrc(cosT + r0 * 32, 256 * 128), rs_ = mk_rsrc(sinT + r0 * 32, 256 * 128);
            const unsigned vo = (unsigned)(lr * 64 + 8 * fq) * 2u, vt = (unsigned)(lr * 32 + 8 * fq) * 4u;
            FOR_AI_M {
                const f32x4 c0 = bldf4(rc, vt, ROWG * 128), c1 = bldf4(rc, vt, ROWG * 128 + 16), s0 = bldf4(rs_, vt, ROWG * 128), s1 = bldf4(rs_, vt, ROWG * 128 + 16);
                const f32x4 x10 = acc[ai][0][m][0] * rsv[ai][m], x11 = acc[ai][0][m][1] * rsv[ai][m], x20 = acc[ai][1][m][0] * rsv[ai][m], x21 = acc[ai][1][m][1] * rsv[ai][m];
                bst8(rb, vo, ROWG * 128, x10 * c0 - x20 * s0, x11 * c1 - x21 * s1);
                bst8(rb, vo, ROWG * 128 + 64, x10 * s0 + x20 * c0, x11 * s1 + x21 * c1);
                asm volatile("" ::: "memory"); }
        }
    }
};
struct EpiQ { EPI_HDR
    bf16* Q; const float *ssqq, *cosT, *sinT;
    __device__ __forceinline__ void operator()(EPI_ARGS) const {
        constexpr int PQ = NH * DQK * 2;
        const int pn = u.pn, lr = wr * 64 + fr, cl = wc * 32 + 8 * fq; const size_t r0 = (size_t)u.pm * 256;
        const rsrc_t rq = mk_rsrc(ssqq + r0 * 8, 256 * 32), rb = mk_rsrc(Q + r0 * (NH * DQK), TILE_BYTES(PQ));
        const unsigned vs = (unsigned)lr * 32u;
        if (pn < 8) {
            const unsigned vo = (unsigned)lr * PQ + (unsigned)(2 * pn * DQK + cl) * 2u;
            FOR_AI_M { const f32x4 sa = bldf4(rq, vs, ROWG * 32), sb = bldf4(rq, vs, ROWG * 32 + 16);
                const float rs = rsqrtf((((sa[0] + sa[1]) + (sa[2] + sa[3])) + ((sb[0] + sb[1]) + (sb[2] + sb[3]))) * (1.0f / QL) + EPS) * QSCALE;
#pragma unroll
                for (int bj = 0; bj < 2; ++bj) bst8(rb, vo, ROWG * PQ + bj * DQK * 2, acc[ai][bj][m][0] * rs, acc[ai][bj][m][1] * rs);
                asm volatile("" ::: "memory"); }
        } else {
            const rsrc_t rc = mk_rsrc(cosT + r0 * 32, 256 * 128), rs_ = mk_rsrc(sinT + r0 * 32, 256 * 128);
            const unsigned vo = (unsigned)lr * PQ + (unsigned)((4 * (pn - 8) + wc) * DQK + 128 + 8 * fq) * 2u, vt = (unsigned)(lr * 32 + 8 * fq) * 4u;
            FOR_AI_M { const f32x4 sa = bldf4(rq, vs, ROWG * 32), sb = bldf4(rq, vs, ROWG * 32 + 16);
                const float rs = rsqrtf((((sa[0] + sa[1]) + (sa[2] + sa[3])) + ((sb[0] + sb[1]) + (sb[2] + sb[3]))) * (1.0f / QL) + EPS) * QSCALE;
                const f32x4 c0 = bldf4(rc, vt, ROWG * 128) * rs, c1 = bldf4(rc, vt, ROWG * 128 + 16) * rs, s0 = bldf4(rs_, vt, ROWG * 128) * rs, s1 = bldf4(rs_, vt, ROWG * 128 + 16) * rs;
                const f32x4 x10 = acc[ai][0][m][0], x11 = acc[ai][0][m][1], x20 = acc[ai][1][m][0], x21 = acc[ai][1][m][1];
                bst8(rb, vo, ROWG * PQ, x10 * c0 - x20 * s0, x11 * c1 - x21 * s1);
                bst8(rb, vo, ROWG * PQ + 64, x10 * s0 + x20 * c0, x11 * s1 + x21 * c1);
                asm volatile("" ::: "memory"); }
        }
    }
};
struct EpiKV { EPI_HDR
    bf16* KV; const float* ssqkv;
    __device__ __forceinline__ void operator()(EPI_ARGS) const {
        const int lr = wr * 64 + fr, cl = wc * 32 + 8 * fq; const size_t r0 = (size_t)u.pm * 256;
        const rsrc_t rq = mk_rsrc(ssqkv + r0 * 4, 256 * 16), rb = mk_rsrc(KV + r0 * 4096 + u.pn * 256, TILE_BYTES(8192));
        const unsigned vs = (unsigned)lr * 16u, vo = (unsigned)(lr * 4096 + cl) * 2u;
        FOR_AI_M { const f32x4 sa = bldf4(rq, vs, ROWG * 16);
            const float rs = rsqrtf(((sa[0] + sa[1]) + (sa[2] + sa[3])) * (1.0f / KVL) + EPS);
#pragma unroll
            for (int bj = 0; bj < 2; ++bj) bst8(rb, vo, ROWG * 8192 + bj * 256, acc[ai][bj][m][0] * rs, acc[ai][bj][m][1] * rs);
            asm volatile("" ::: "memory"); }
    }
};
struct EpiWo { EPI_HDR
    bf16* GA;
    __device__ __forceinline__ void operator()(EPI_ARGS) const {
        const int lr = wr * 64 + fr, cl = wc * 32 + 8 * fq; const size_t r0 = (size_t)u.pm * 256;
        const rsrc_t rb = mk_rsrc(GA + r0 * DM + u.pn * 256, TILE_BYTES(DM * 2)); const unsigned vo = (unsigned)(lr * DM + cl) * 2u;
        FOR_AI_M {
#pragma unroll
            for (int bj = 0; bj < 2; ++bj) { f32x4 g0, g1; bld8(rb, vo, ROWG * DM * 2 + bj * 256, g0, g1); bst8(rb, vo, ROWG * DM * 2 + bj * 256, g0 * acc[ai][bj][m][0], g1 * acc[ai][bj][m][1]); }
            asm volatile("" ::: "memory"); }
    }
};
struct EpiGlu { EPI_HDR
    bf16 *GA, *GB; const float* bglu;
    __device__ __forceinline__ void operator()(EPI_ARGS) const {
        const int lr = wr * 64 + fr, j0 = u.pn * 128 + wc * 32 + 8 * fq; const size_t r0 = (size_t)u.pm * 256;
        const rsrc_t ra = mk_rsrc(GA + r0 * DM, TILE_BYTES(DM * 2)), rb = mk_rsrc(GB + r0 * DM, TILE_BYTES(DM * 2)); const unsigned vo = (unsigned)(lr * DM + j0) * 2u;
        const f32x4 bv0 = *(const f32x4*)(bglu + j0), bv1 = *(const f32x4*)(bglu + j0 + 4), bg0 = *(const f32x4*)(bglu + DM + j0), bg1 = *(const f32x4*)(bglu + DM + j0 + 4);
        FOR_AI_M {
            f32x4 v0 = acc[ai][0][m][0] + bv0, v1 = acc[ai][0][m][1] + bv1, g0 = acc[ai][1][m][0] + bg0, g1 = acc[ai][1][m][1] + bg1;
#pragma unroll
            for (int e = 0; e < 4; ++e) { v0[e] *= sigm(g0[e]); v1[e] *= sigm(g1[e]); }
            f32x4 m0, m1, q0, q1; bld8(ra, vo, ROWG * DM * 2, m0, m1); bld8(rb, vo, ROWG * DM * 2, q0, q1);
            bst8(ra, vo, ROWG * DM * 2, m0 + q0 * v0, m1 + q1 * v1);
            asm volatile("" ::: "memory"); }
    }
};
struct EpiPlain { EPI_HDR
    bf16* O;
    __device__ __forceinline__ void operator()(EPI_ARGS) const {
        const int lr = wr * 64 + fr, cl = wc * 32 + 8 * fq; const size_t r0 = (size_t)u.pm * 256;
        const rsrc_t rb = mk_rsrc(O + r0 * DM + u.pn * 256, TILE_BYTES(DM * 2)); const unsigned vo = (unsigned)(lr * DM + cl) * 2u;
        FOR_AI_M {
#pragma unroll
            for (int bj = 0; bj < 2; ++bj) bst8(rb, vo, ROWG * DM * 2 + bj * 256, acc[ai][bj][m][0], acc[ai][bj][m][1]); }
    }
};
struct EpiSwiGlu { EPI_HDR
    bf16* HID; const float* rsr;
    __device__ __forceinline__ void operator()(EPI_ARGS) const {
        const int lr = wr * 64 + fr, j0 = u.pn * 128 + wc * 32 + 8 * fq; const size_t r0 = (size_t)u.pm * 256;
        const rsrc_t rb = mk_rsrc(HID + r0 * FF, TILE_BYTES(FF * 2)); const unsigned vo = (unsigned)(lr * FF + j0) * 2u;
        RS_LOAD(rsr);
        FOR_AI_M {
            f32x4 g0 = acc[ai][0][m][0] * rsv[ai][m], g1 = acc[ai][0][m][1] * rsv[ai][m];
#pragma unroll
            for (int e = 0; e < 4; ++e) { g0[e] *= sigm(g0[e]); g1[e] *= sigm(g1[e]); }
            bst8(rb, vo, ROWG * FF * 2, g0 * (acc[ai][1][m][0] * rsv[ai][m]), g1 * (acc[ai][1][m][1] * rsv[ai][m])); }
    }
};

template <class Epi> __device__ __forceinline__ void run_gemm(Ctx& C, const bf16* A, const bf16* Bt, int N, int K, const Epi& E) {
    int Kv = K, Nv = N; asm volatile("" : "+s"(Kv), "+s"(Nv));
    pg8::Gemm g{A, Bt, T, Nv, Kv}; pg8::StaticOrder S; S.init(T, Nv, C.G, C.bid);
    pg8::gemm_phase<Epi, pg8::StaticOrder, MK_ALIGN, MK_SP2>(C.lds, g, S, E);
}

__device__ __forceinline__ void row_pass(const float* xin, const bf16* delta, const float* wpost, float* xout, const float* wpre, bf16* hout, int lane) {
    f32x4 x[8];
#pragma unroll
    for (int j = 0; j < 8; ++j) x[j] = ((const f32x4*)xin)[64 * j + lane];
    if (delta) {
        f32x4 d[8]; float s = 0.f;
#pragma unroll
        for (int j = 0; j < 8; ++j) { const u32x2 w = ((const u32x2*)delta)[64 * j + lane]; d[j] = (f32x4){bflo(w.x), bfhi(w.x), bflo(w.y), bfhi(w.y)};
            s += (d[j][0] * d[j][0] + d[j][1] * d[j][1]) + (d[j][2] * d[j][2] + d[j][3] * d[j][3]); }
        const float rs = rsqrtf(wave_sum(s) * (1.0f / DM) + EPS);
#pragma unroll
        for (int j = 0; j < 8; ++j) { const f32x4 w = ((const f32x4*)wpost)[64 * j + lane]; x[j] = x[j] + d[j] * rs * w; }
        if (xout) {
#pragma unroll
            for (int j = 0; j < 8; ++j) ((f32x4*)xout)[64 * j + lane] = x[j]; }
    }
    if (hout) {
        float s = 0.f;
#pragma unroll
        for (int j = 0; j < 8; ++j) s += (x[j][0] * x[j][0] + x[j][1] * x[j][1]) + (x[j][2] * x[j][2] + x[j][3] * x[j][3]);
        const float rs = rsqrtf(wave_sum(s) * (1.0f / DM) + EPS);
#pragma unroll
        for (int j = 0; j < 8; ++j) { const f32x4 w = ((const f32x4*)wpre)[64 * j + lane]; const f32x4 h = x[j] * rs * w;
            u32x2 o; o.x = cvt_pk_bf16(h[0], h[1]); o.y = cvt_pk_bf16(h[2], h[3]); ((u32x2*)hout)[64 * j + lane] = o; }
    }
}

template <int MODE>
__device__ __forceinline__ void row_phase(Ctx& C, const float* xf, const bf16* xb, const bf16* delta, const float* wpost, bf16* xo, float* of, float* rso) {
    const int lane = C.lane, rpb = T / C.G, row0 = C.bid * rpb;
    LAS unsigned* ctr = (LAS unsigned*)(C.lds + MISC_OFF + 64);
    if (C.tid == 0) *ctr = 0u;
    LDS_WAIT(); __syncthreads();
#define ROW_GRAB(dst) do { unsigned v_ = 0; if (lane == 0) v_ = __hip_atomic_fetch_add(ctr, 1u, __ATOMIC_RELAXED, __HIP_MEMORY_SCOPE_WORKGROUP); dst = (int)__builtin_amdgcn_readfirstlane(v_); } while (0)
#define ROW_LOAD(R, mrow) do { const size_t m_ = (size_t)(mrow); _Pragma("unroll") for (int j = 0; j < 4; ++j) { \
        if (MODE == 0) { R[2 * j] = __builtin_nontemporal_load(((const u32x4*)(xf + m_ * DM)) + (64 * j + lane) * 2); R[2 * j + 1] = __builtin_nontemporal_load(((const u32x4*)(xf + m_ * DM)) + (64 * j + lane) * 2 + 1); } \
        else { R[j] = __builtin_nontemporal_load(((const u32x4*)(xb + m_ * DM)) + 64 * j + lane); R[4 + j] = __builtin_nontemporal_load(((const u32x4*)(delta + m_ * DM)) + 64 * j + lane); } } } while (0)
    f32x4 wp[8];
#pragma unroll
    for (int j = 0; j < 4; ++j) { wp[2 * j] = MODE ? ((const f32x4*)wpost)[(64 * j + lane) * 2] : (f32x4){0.f, 0.f, 0.f, 0.f}; wp[2 * j + 1] = MODE ? ((const f32x4*)wpost)[(64 * j + lane) * 2 + 1] : (f32x4){0.f, 0.f, 0.f, 0.f}; }
    u32x4 raw[8]; int cur, nxt; ROW_GRAB(cur);
    if (cur < rpb) ROW_LOAD(raw, row0 + cur);
    while (cur < rpb) {
        ROW_GRAB(nxt);
        u32x4 rn[8];
        if (nxt < rpb) ROW_LOAD(rn, row0 + nxt);
        else {
#pragma unroll
            for (int j = 0; j < 8; ++j) rn[j] = (u32x4){0u, 0u, 0u, 0u}; }
        const size_t m = (size_t)(row0 + cur);
        f32x4 x[8];
        if (MODE == 0) {
#pragma unroll
            for (int j = 0; j < 8; ++j) x[j] = __builtin_bit_cast(f32x4, raw[j]);
        } else {
            f32x4 d[8]; float s = 0.f;
#pragma unroll
            for (int j = 0; j < 4; ++j) { const u32x4 xw = raw[j], dw = raw[4 + j];
                x[2 * j] = (f32x4){bflo(xw.x), bfhi(xw.x), bflo(xw.y), bfhi(xw.y)}; x[2 * j + 1] = (f32x4){bflo(xw.z), bfhi(xw.z), bflo(xw.w), bfhi(xw.w)};
                d[2 * j] = (f32x4){bflo(dw.x), bfhi(dw.x), bflo(dw.y), bfhi(dw.y)}; d[2 * j + 1] = (f32x4){bflo(dw.z), bfhi(dw.z), bflo(dw.w), bfhi(dw.w)}; }
#pragma unroll
            for (int j = 0; j < 8; ++j) s += (d[j][0] * d[j][0] + d[j][1] * d[j][1]) + (d[j][2] * d[j][2] + d[j][3] * d[j][3]);
            const float rs = rsqrtf(wave_sum(s) * (1.0f / DM) + EPS);
#pragma unroll
            for (int j = 0; j < 8; ++j) x[j] = x[j] + d[j] * rs * wp[j];
        }
        if (MODE == 2) {
#pragma unroll
            for (int j = 0; j < 4; ++j) { __builtin_nontemporal_store(x[2 * j], ((f32x4*)(of + m * DM)) + (64 * j + lane) * 2); __builtin_nontemporal_store(x[2 * j + 1], ((f32x4*)(of + m * DM)) + (64 * j + lane) * 2 + 1); }
        } else {
            float s = 0.f;
#pragma unroll
            for (int j = 0; j < 4; ++j) { u32x4 o; o.x = cvt_pk_bf16(x[2 * j][0], x[2 * j][1]); o.y = cvt_pk_bf16(x[2 * j][2], x[2 * j][3]); o.z = cvt_pk_bf16(x[2 * j + 1][0], x[2 * j + 1][1]); o.w = cvt_pk_bf16(x[2 * j + 1][2], x[2 * j + 1][3]);
                ((u32x4*)(xo + m * DM))[64 * j + lane] = o;
                const float a0 = bflo(o.x), a1 = bfhi(o.x), a2 = bflo(o.y), a3 = bfhi(o.y), a4 = bflo(o.z), a5 = bfhi(o.z), a6 = bflo(o.w), a7 = bfhi(o.w);
                s += ((a0 * a0 + a1 * a1) + (a2 * a2 + a3 * a3)) + ((a4 * a4 + a5 * a5) + (a6 * a6 + a7 * a7)); }
            const float rs = rsqrtf(wave_sum(s) * (1.0f / DM) + EPS);
            if (lane == 0) rso[m] = rs;
        }
#pragma unroll
        for (int j = 0; j < 8; ++j) raw[j] = rn[j];
        cur = nxt;
    }
#undef ROW_LOAD
#undef ROW_GRAB
}

__device__ __forceinline__ void tr_item(const float* src, int lds_, bf16* dst, int ldd, const float* ksc, LAS float* scr, int lane) {
    float tv[32];
#pragma unroll
    for (int i = 0; i < 32; ++i) { const int kk = 2 * i + (lane >> 5); tv[i] = src ? __builtin_nontemporal_load(src + (size_t)kk * lds_ + (lane & 31)) : 0.f; }
#pragma unroll
    for (int i = 0; i < 32; ++i) { const int kk = 2 * i + (lane >> 5); float v = tv[i]; if (ksc) v *= ksc[kk]; scr[kk * 33 + (lane & 31)] = v; }
    LDS_WAIT(); asm volatile("" ::: "memory");
    const int c = lane & 7;
#pragma unroll
    for (int j = 0; j < 4; ++j) { const int n = (lane >> 3) + 8 * j; const LAS float* s = scr + (8 * c) * 33 + n;
        u32x4 o; o.x = pk2(s[0 * 33], s[1 * 33]); o.y = pk2(s[2 * 33], s[3 * 33]); o.z = pk2(s[4 * 33], s[5 * 33]); o.w = pk2(s[6 * 33], s[7 * 33]);
        *(u32x4*)(dst + (size_t)n * ldd + 8 * c) = o; }
    LDS_WAIT(); asm volatile("" ::: "memory");
}
constexpr int IT_WIN = 32 * 192, IT_WUQ = 8 * 96, IT_WUKV = 4 * 128, IT_WO = 32 * 64, IT_WGLU = 16 * 128, IT_WOUT = 32 * 64, IT_WGU = 32 * 352, IT_WDN = 88 * 64;
constexpr int IT_ALL = IT_WIN + IT_WUQ + IT_WUKV + IT_WO + IT_WGLU + IT_WOUT + IT_WGU + IT_WDN;
__device__ __forceinline__ void convert_weights(Ctx& C, int l) {
    LAS float* scr = (LAS float*)(C.lds + C.wave * 16384);
    const int gw = C.bid * NWAVES + C.wave, NGW = C.G * NWAVES, lane = C.lane;
    for (int it = gw; it < IT_ALL; it += NGW) {
        int r = it; const float* src; int lds_; bf16* dst; int ldd; const float* ksc = nullptr;
        if (r < IT_WIN) { const int kb = r / 192, nb = r % 192, n0 = nb * 32, k0 = kb * 64; int sc = -1;
            if (n0 < 768) sc = n0; else if (n0 < 5888) sc = n0 + 64; else if (n0 == 5888) sc = 768; else if (n0 == 5888 + 128) sc = 800;
            const float* W = C_in(I_WIN) + (size_t)l * DM * INW;
            src = sc >= 0 ? W + (size_t)k0 * INW + sc : nullptr; lds_ = INW; dst = C_Win + (size_t)n0 * DM + k0; ldd = DM; ksc = C_in(I_PREMIX) + l * DM + k0; }
        else if ((r -= IT_WIN) < IT_WUQ) { const int kb = r / 96, nb = r % 96, n0 = nb * 32, k0 = kb * 64; int sc;
            if (n0 < 2048) sc = (n0 >> 7) * DQK + (n0 & 127); else { const int rr = n0 - 2048, t = rr >> 8, c = rr & 255, bj = c >> 7, hh = (c & 127) >> 5; sc = (4 * t + hh) * DQK + 128 + bj * 32; }
            const float* W = C_in(I_WUQ) + (size_t)l * QL * (NH * DQK);
            src = W + (size_t)k0 * (NH * DQK) + sc; lds_ = NH * DQK; dst = C_Wuq + (size_t)n0 * QL + k0; ldd = QL; ksc = C_in(I_QNORM) + l * QL + k0; }
        else if ((r -= IT_WUQ) < IT_WUKV) { const int kb = r / 128, nb = r % 128, n0 = nb * 32, k0 = kb * 64;
            const float* W = C_in(I_WUKV) + (size_t)l * KVL * 4096;
            src = W + (size_t)k0 * 4096 + n0; lds_ = 4096; dst = C_Wukv + (size_t)n0 * KVL + k0; ldd = KVL; ksc = C_in(I_KVNORM) + l * KVL + k0; }
        else if ((r -= IT_WUKV) < IT_WO) { const int kb = r / 64, nb = r % 64, n0 = nb * 32, k0 = kb * 64;
            const float* W = C_in(I_WO) + (size_t)l * DM * DM;
            src = W + (size_t)k0 * DM + n0; lds_ = DM; dst = C_Wo + (size_t)n0 * DM + k0; ldd = DM; }
        else if ((r -= IT_WO) < IT_WGLU) { const int kb = r / 128, nb = r % 128, n0 = nb * 32, k0 = kb * 64; const int t = n0 >> 8, bj = (n0 >> 7) & 1, i0 = n0 & 127;
            const float* W = C_in(I_WGLU) + (size_t)l * SW * 4096;
            src = W + (size_t)k0 * 4096 + bj * DM + t * 128 + i0; lds_ = 4096; dst = C_Wglu + (size_t)n0 * SW + k0; ldd = SW; }
        else if ((r -= IT_WGLU) < IT_WOUT) { const int kb = r / 64, nb = r % 64, n0 = nb * 32, k0 = kb * 64;
            const float* W = C_in(I_WOUT) + (size_t)l * DM * DM;
            src = W + (size_t)k0 * DM + n0; lds_ = DM; dst = C_Wout + (size_t)n0 * DM + k0; ldd = DM; }
        else if ((r -= IT_WOUT) < IT_WGU) { const int kb = r / 352, nb = r % 352, n0 = nb * 32, k0 = kb * 64; const int t = n0 >> 8, bj = (n0 >> 7) & 1, i0 = n0 & 127;
            const float* W = (bj ? C_in(I_WFU) : C_in(I_WFG)) + (size_t)l * DM * FF;
            src = W + (size_t)k0 * FF + t * 128 + i0; lds_ = FF; dst = C_Wgu + (size_t)n0 * DM + k0; ldd = DM; ksc = C_in(I_PREFFN) + l * DM + k0; }
        else { r -= IT_WGU; const int kb = r / 64, nb = r % 64, n0 = nb * 32, k0 = kb * 64;
            const float* W = C_in(I_WFD) + (size_t)l * FF * DM;
            src = W + (size_t)k0 * DM + n0; lds_ = DM; dst = C_Wdn + (size_t)n0 * FF + k0; ldd = FF; }
        tr_item(src, lds_, dst, ldd, ksc, scr, lane);
    }
}

__device__ __forceinline__ void rope_tables(Ctx& C) {
    const int* pos = (const int*)C_in(I_POS); float* cT = C_cosT; float* sT = C_sinT;
    for (int i = C.bid * 512 + C.tid; i < T * 32; i += C.G * 512) { const int row = i >> 5, k = i & 31;
        const float inv = __builtin_amdgcn_exp2f(-(float)k * (13.287712379549449f / 32.0f));
        const float ang = (float)pos[row] * inv;
        cT[i] = cosf(ang); sT[i] = sinf(ang); }
}
__device__ __forceinline__ void ssm_lp(Ctx& C, int l) {
    const float* are = C_in(I_ARE) + l * SG * SN; const float* aim = C_in(I_AIM) + l * SG * SN; const float* ldt = C_in(I_LOGDT) + l * SG; f32x2* LPp = C_LP; f32x2* FBp = C_FB;
    for (int i = C.bid * 512 + C.tid; i < SG * 65 * SN; i += C.G * 512) { const int n = i & 63, d = (i >> 6) % 65, g = i / (65 * 64);
        const float dt = expf(ldt[g]), ar = are[g * SN + n], ai = aim[g * SN + n];
        const float e = expf((float)d * (ar * dt)), ang = (float)d * (ai * dt); const float s = sinf(ang), c = cosf(ang);
        LPp[i] = (f32x2){e * c, e * s};
        if (d == 1) { const float lr = e * c, li = e * s, nr = lr - 1.0f, den = ar * ar + ai * ai;
            FBp[g * SN + n] = (f32x2){(nr * ar + li * ai) / den, (li * ar - nr * ai) / den}; } }
}
__device__ __forceinline__ void ssm_tables(Ctx& C, int l) {
    const float* bre = C_in(I_BRE) + (size_t)l * SG * SN * SP; const float* bim = C_in(I_BIM) + (size_t)l * SG * SN * SP;
    const float* cre = C_in(I_CRE) + (size_t)l * SG * SP * SN; const float* cim = C_in(I_CIM) + (size_t)l * SG * SP * SN; const float* dsk_ = C_in(I_SSMD) + l * SW;
    const int gt = C.bid * 512 + C.tid, NT_ = C.G * 512;
    { LAS float* LC = (LAS float*)C.lds; LAS float* LB = LC + 2048; LAS float* LL = LB + 2048; bf16* KDp = C_KD; const f32x2* LPp = C_LP; const f32x2* FBp = C_FB;
      for (int unit = C.bid; unit < SG * 4; unit += C.G) { const int g = unit >> 2, d0 = (unit & 3) * 17, nd = (65 - d0) < 17 ? (65 - d0) : 17;
        for (int i = C.tid; i < 1024; i += NWAVES * 64) { const int n = i >> 4, p = i & 15; const f32x2 f = FBp[g * SN + n]; const float br = bre[(g * SN + n) * SP + p], bi = bim[(g * SN + n) * SP + p];
            LC[2 * i] = cre[(g * SP + p) * SN + n]; LC[2 * i + 1] = cim[(g * SP + p) * SN + n]; LB[2 * i] = f.x * br - f.y * bi; LB[2 * i + 1] = f.x * bi + f.y * br; }
        for (int i = C.tid; i < nd * 64; i += NWAVES * 64) { const int dd = d0 + (i >> 6), n = i & 63; f32x2 L = {0.f, 0.f}; if (dd > 0) L = LPp[(size_t)(g * 65 + dd - 1) * 64 + n]; LL[2 * i] = L.x; LL[2 * i + 1] = L.y; }
        LDS_WAIT(); __syncthreads();
        const int p = (C.tid >> 4) & 15, pp = C.tid & 15, half = C.tid >> 8; float acc[9];
#pragma unroll
        for (int k = 0; k < 9; ++k) acc[k] = 0.f;
        for (int n = 0; n < SN; ++n) { const float cr = LC[(n * 16 + p) * 2], ci = LC[(n * 16 + p) * 2 + 1], br = LB[(n * 16 + pp) * 2], bi = LB[(n * 16 + pp) * 2 + 1];
            const float wr_ = cr * br - ci * bi, wi_ = cr * bi + ci * br;
#pragma unroll
            for (int k = 0; k < 9; ++k) { const int dl = half * 9 + k; if (dl < nd) acc[k] += wr_ * LL[(dl * 64 + n) * 2] - wi_ * LL[(dl * 64 + n) * 2 + 1]; } }
#pragma unroll
        for (int k = 0; k < 9; ++k) { const int dl = half * 9 + k; if (dl < nd) { float v = acc[k]; if (d0 + dl == 1 && p == pp) v += dsk_[g * 16 + p];
                KDp[(size_t)g * (65 * 256) + (d0 + dl) * 256 + p * 16 + pp] = (bf16)f2bf(v); } }
        LDS_WAIT(); __syncthreads(); } }
    for (int i = gt; i < SG * 64 * 128; i += NT_) { const int ncol = i & 127, j = (i >> 7) & 63, g = i >> 13, n = ncol & 63, part = ncol >> 6;
        const f32x2 L = C_LP[(size_t)(g * 65 + 63 - j) * 64 + n], f = C_FB[g * SN + n]; float o[16];
#pragma unroll
        for (int pp = 0; pp < 16; ++pp) { const float br = bre[(g * SN + n) * SP + pp], bi = bim[(g * SN + n) * SP + pp];
            const float Br = f.x * br - f.y * bi, Bi = f.x * bi + f.y * br; o[pp] = part ? (L.x * Bi + L.y * Br) : (L.x * Br - L.y * Bi); }
        u32x4 w0, w1; w0.x = pk2(o[0], o[1]); w0.y = pk2(o[2], o[3]); w0.z = pk2(o[4], o[5]); w0.w = pk2(o[6], o[7]); w1.x = pk2(o[8], o[9]); w1.y = pk2(o[10], o[11]); w1.z = pk2(o[12], o[13]); w1.w = pk2(o[14], o[15]);
        u32x4* dst = (u32x4*)(C_MAT + (size_t)i * 16); dst[0] = w0; dst[1] = w1; }
    for (int i = gt; i < SG * 8 * 1024; i += NT_) { const int p = i & 15, j = (i >> 4) & 63, kk = (i >> 10) & 7, g = i >> 13; float o[16];
#pragma unroll
        for (int k = 0; k < 16; ++k) { const int kq = kk * 16 + k, n = kq & 63, part = kq >> 6; const f32x2 L = C_LP[(size_t)(g * 65 + j + 1) * 64 + n];
            const float cr = cre[(g * SP + p) * SN + n], ci = cim[(g * SP + p) * SN + n]; o[k] = part ? -(cr * L.y + ci * L.x) : (cr * L.x - ci * L.y); }
        u32x4 w0, w1; w0.x = pk2(o[0], o[1]); w0.y = pk2(o[2], o[3]); w0.z = pk2(o[4], o[5]); w0.w = pk2(o[6], o[7]); w1.x = pk2(o[8], o[9]); w1.y = pk2(o[10], o[11]); w1.z = pk2(o[12], o[13]); w1.w = pk2(o[14], o[15]);
        u32x4* dst = (u32x4*)(C_CCT + (size_t)i * 16); dst[0] = w0; dst[1] = w1; }
}

__device__ __forceinline__ int crow(int r, int hi) { return (r & 3) + 8 * (r >> 2) + 4 * hi; }
__device__ __forceinline__ f32x16 mfma32(bf16x8 a, bf16x8 b, f32x16 c) { return __builtin_amdgcn_mfma_f32_32x32x16_bf16(a, b, c, 0, 0, 0); }
__device__ __forceinline__ void ssm_states(Ctx& C) {
    const int lane = C.lane, r32 = lane & 31, hi = lane >> 5, mt = C.wave >> 2, nblk = C.wave & 3;
    LAS float* SL = (LAS float*)C.lds;
    for (int unit = C.bid; unit < SG * BATCH; unit += C.G) { const int g = unit >> 3, b = unit & 7;
        f32x16 acc = {};
        const bf16* ap = C_U + ((size_t)(b * SEQ + (32 * mt + r32) * 64)) * SW + g * 16 + hi * 8;
        const bf16* bp = C_MAT + ((size_t)(g * 64) * 128 + nblk * 32 + r32) * 16 + hi * 8;
#pragma unroll 8
        for (int j = 0; j < 64; ++j) { const bf16x8 a = *(const bf16x8*)(ap + (size_t)j * SW), bb = *(const bf16x8*)(bp + (size_t)j * 128 * 16); acc = mfma32(a, bb, acc); }
#pragma unroll
        for (int r = 0; r < 16; ++r) SL[(32 * mt + crow(r, hi)) * 128 + 32 * nblk + r32] = acc[r];
        LDS_WAIT(); __syncthreads();
        if (C.tid < 64) { const int n = C.tid; const f32x2 lam = C_LP[(size_t)(g * 65 + 64) * 64 + n]; float xr = 0.f, xi = 0.f;
            bf16* xp = C_XST + ((size_t)(b * 64) * 64 + g) * 128 + n;
            for (int c = 0; c < 64; ++c) { xp[(size_t)c * 64 * 128] = (bf16)f2bf(xr); xp[(size_t)c * 64 * 128 + 64] = (bf16)f2bf(xi);
                const float sr = SL[c * 128 + n], si = SL[c * 128 + 64 + n]; const float nr = lam.x * xr - lam.y * xi + sr, ni = lam.x * xi + lam.y * xr + si; xr = nr; xi = ni; } }
        LDS_WAIT(); __syncthreads();
    }
}
#ifndef REPS3
#define REPS3 1
#endif
__device__ __forceinline__ float gelu_tanh(float y) { return y * sigm(1.5957691216057308f * (y + 0.044715f * y * y * y)); }
__device__ __forceinline__ void ssm_outputs(Ctx& C, int l) {
    const int lane = C.lane, r32 = lane & 31, hi = lane >> 5, half = C.wave & 1;
    for (int unit = C.bid; unit < 16 * 16; unit += C.G) { const int gb = unit >> 4, mt = unit & 15, g = 4 * gb + (C.wave >> 1), b = mt >> 1, c0 = 32 * (mt & 1);
        const bf16* up = C_U + ((size_t)(b * SEQ + (c0 + r32) * 64)) * SW + g * 16 + hi * 8;
        const bf16* xp = C_XST + ((size_t)((b * 64 + c0 + r32) * 64 + g)) * 128 + hi * 8;
        { const u32x4* src = (const u32x4*)(C_KD + (size_t)(4 * gb) * (65 * 256)); LAS u32x4* dstl = (LAS u32x4*)C.lds;
          for (int i = C.tid; i < KD_LDS_BYTES / 16; i += NWAVES * 64) dstl[i] = src[i];
          LDS_WAIT(); __syncthreads(); }
        const LAS bf16* kd = (const LAS bf16*)C.lds + (size_t)(C.wave >> 1) * (65 * 256) + r32 * 16 + hi * 8;
        const bf16* cc = C_CCT + ((size_t)(g * 8) * 1024 + r32) * 16 + hi * 8;
        for (int s2 = 0; s2 < 2; ++s2) { const int sp = half ? (2 - s2) : (s2 ? 0 : 3);
            f32x16 acc[8];
_Pragma("unroll")
            for (int rep_ = 0; rep_ < REPS3; ++rep_) {
#pragma unroll
            for (int nb = 0; nb < 8; ++nb) acc[nb] = (f32x16){};
#pragma unroll 2
            for (int kk = 0; kk < 8; ++kk) { const bf16x8 a = *(const bf16x8*)(xp + kk * 16);
#pragma unroll
                for (int nb = 0; nb < 8; ++nb) { const bf16x8 bb = *(const bf16x8*)(cc + ((size_t)kk * 1024 + (16 * sp + 2 * nb) * 16) * 16); acc[nb] = mfma32(a, bb, acc[nb]); } }
            const int iend = 16 * sp + 15;
            for (int i0 = 0; i0 <= iend; i0 += 8) {
                bf16x8 a8[8];
#pragma unroll
                for (int u = 0; u < 8; ++u) a8[u] = *(const bf16x8*)(up + (size_t)(i0 + u) * SW);
#pragma unroll
                for (int u = 0; u < 8; ++u) {
#pragma unroll
                    for (int nb = 0; nb < 8; ++nb) { const int d = 16 * sp + 2 * nb - (i0 + u);
                        if (d >= -1) { const bf16x8 bb = *(const LAS bf16x8*)(kd + (d + 1) * 256); acc[nb] = mfma32(a8[u], bb, acc[nb]); } } } }
            }
            {
                const int p = r32 & 15, toff = r32 >> 4;
                const rsrc_t rz = mk_rsrc(C_Z + ((size_t)(b * SEQ + c0 * 64 + 16 * sp)) * SW + g * 16, (unsigned)((31 * 64 + 16) * SW * 2));
                const unsigned vz = (unsigned)((4 * hi * 64 + toff) * SW + p) * 2u;
#pragma unroll
                for (int nb = 0; nb < 8; ++nb)
#pragma unroll
                    for (int r = 0; r < 16; ++r) __builtin_amdgcn_raw_buffer_store_b16((unsigned short)f2bf(gelu_tanh(acc[nb][r])), rz, vz, (((r & 3) + 8 * (r >> 2)) * 64 + 2 * nb) * SW * 2, 0);
            }
        }
        __syncthreads();
    }
}

namespace att {
constexpr int LDQ = NH * DQK, LDKV = 4096, LDO = DM;
constexpr int SHM_V = 16384, SHM_K = 16384, SHM_KP = 8192;
constexpr int OFF_V = 0, OFF_K = 2 * SHM_V, OFF_KP = OFF_K + 2 * SHM_K, OFF_WS = OFF_KP + 2 * SHM_KP, ATT_LDS = OFF_WS + NWAVES * 64 * 4;
constexpr float THRL = 11.5f;
#define KSWZ(row, colB) ((row) * 256 + ((colB) ^ (((row) & 7) << 4)))
#define KPSWZ(row, colB) ((row) * 128 + ((colB) ^ (((row) & 7) << 4)))
#define SBAR() __builtin_amdgcn_sched_barrier(0)
__device__ __forceinline__ void partialSM(f32x16& p0, f32x16& p1, float& m_reg, float& mn, float& alpha, bool dead) {
    if (dead) {
#pragma unroll
        for (int r = 0; r < 16; ++r) { p0[r] = -1e30f; p1[r] = -1e30f; } }
    float pmax = p0[0];
#pragma unroll
    for (int r = 1; r < 16; ++r) pmax = fmaxf(pmax, p0[r]);
#pragma unroll
    for (int r = 0; r < 16; ++r) pmax = fmaxf(pmax, p1[r]);
    { auto rr = __builtin_amdgcn_permlane32_swap(__float_as_uint(pmax), __float_as_uint(pmax), false, false); pmax = fmaxf(__uint_as_float(rr[0]), __uint_as_float(rr[1])); }
    if (__builtin_expect(__all(pmax - m_reg <= THRL), 1)) { mn = m_reg; alpha = 1.f; }
    else { mn = fmaxf(m_reg, pmax); alpha = __builtin_amdgcn_exp2f(m_reg - mn); m_reg = mn; }
#pragma unroll
    for (int r = 0; r < 16; ++r) p0[r] = p0[r] - mn;
#pragma unroll
    for (int r = 0; r < 16; ++r) p1[r] = p1[r] - mn;
#pragma unroll
    for (int r = 0; r < 16; ++r) p0[r] = __builtin_amdgcn_exp2f(p0[r]);
}
__device__ __forceinline__ void finishSM(f32x16& p0, f32x16& p1, float alpha, float& l_reg, bf16x8& pa0, bf16x8& pa1, bf16x8& pa2, bf16x8& pa3) {
#pragma unroll
    for (int r = 0; r < 16; ++r) p1[r] = __builtin_amdgcn_exp2f(p1[r]);
    float ps = 0;
#pragma unroll
    for (int r = 0; r < 16; ++r) ps += p0[r];
#pragma unroll
    for (int r = 0; r < 16; ++r) ps += p1[r];
    { auto rr = __builtin_amdgcn_permlane32_swap(__float_as_uint(ps), __float_as_uint(ps), false, false); ps = __uint_as_float(rr[0]) + __uint_as_float(rr[1]); }
    l_reg = l_reg * alpha + ps;
#define PK4(P, BASE, OUT) do { unsigned a0 = cvt_pk_bf16(P[BASE + 0], P[BASE + 1]), a1 = cvt_pk_bf16(P[BASE + 2], P[BASE + 3]);   \
    unsigned b0 = cvt_pk_bf16(P[BASE + 4], P[BASE + 5]), b1 = cvt_pk_bf16(P[BASE + 6], P[BASE + 7]);                              \
    auto r0 = __builtin_amdgcn_permlane32_swap(a0, b0, false, false); auto r1 = __builtin_amdgcn_permlane32_swap(a1, b1, false, false); \
    u32x4 w = {r0[0], r1[0], r0[1], r1[1]}; OUT = *reinterpret_cast<bf16x8*>(&w); } while (0)
    PK4(p0, 0, pa0); PK4(p0, 8, pa1); PK4(p1, 0, pa2); PK4(p1, 8, pa3);
#undef PK4
}
__device__ __forceinline__ void qkt(f32x16& p0, f32x16& p1, const LAS char* Ks, const LAS char* KPs, const bf16x8* qr, int r32, int hi) {
    p0 = f32x16{}; p1 = f32x16{};
#pragma unroll
    for (int d0 = 0; d0 < 8; ++d0) { const int cb = (d0 * 16 + hi * 8) * 2;
        const bf16x8 b0 = *(const LAS bf16x8*)(Ks + KSWZ(r32, cb)), b1 = *(const LAS bf16x8*)(Ks + KSWZ(32 + r32, cb));
        p0 = mfma32(b0, qr[d0], p0); p1 = mfma32(b1, qr[d0], p1); }
#pragma unroll
    for (int d0 = 0; d0 < 4; ++d0) { const int cb = (d0 * 16 + hi * 8) * 2;
        const bf16x8 b0 = *(const LAS bf16x8*)(KPs + KPSWZ(r32, cb)), b1 = *(const LAS bf16x8*)(KPs + KPSWZ(32 + r32, cb));
        p0 = mfma32(b0, qr[8 + d0], p0); p1 = mfma32(b1, qr[8 + d0], p1); }
}
__device__ __forceinline__ int v_st(int k, int c) { const int kk = (k & ~0xC) | ((k & 4) << 1) | ((k & 8) >> 1); return ((kk >> 3) * 4 + (c >> 5)) * 512 + ((kk & 7) * 32 + (c & 31)) * 2; }
__device__ __forceinline__ int v_rd_base(int lane) { return ((lane & 3) << 3) | (((lane >> 2) & 3) << 6) | (((lane >> 4) & 1) << 5) | (((lane >> 5) & 1) << 8); }
constexpr int v_rd_off(int d0, int ks, int half) { return d0 * 512 + ks * 4096 + half * 2048; }
template <int OFF> __device__ __forceinline__ s16x4 tr_read(int vb) { s16x4 r; asm volatile("ds_read_b64_tr_b16 %0, %1 offset:%2" : "=&v"(r) : "v"(vb), "i"(OFF) : "memory"); return r; }
template <int D0> __device__ __forceinline__ void pv_one(f32x16& od, int vb, bf16x8 pa0, bf16x8 pa1, bf16x8 pa2, bf16x8 pa3) {
    const s16x4 l0 = tr_read<v_rd_off(D0, 0, 0)>(vb), h0 = tr_read<v_rd_off(D0, 0, 1)>(vb), l1 = tr_read<v_rd_off(D0, 1, 0)>(vb), h1 = tr_read<v_rd_off(D0, 1, 1)>(vb);
    const s16x4 l2 = tr_read<v_rd_off(D0, 2, 0)>(vb), h2 = tr_read<v_rd_off(D0, 2, 1)>(vb), l3 = tr_read<v_rd_off(D0, 3, 0)>(vb), h3 = tr_read<v_rd_off(D0, 3, 1)>(vb);
    asm volatile("s_waitcnt lgkmcnt(0)" ::: "memory"); SBAR();
#define PK(L, H) (bf16x8){L[0], L[1], L[2], L[3], H[0], H[1], H[2], H[3]}
    od = mfma32(pa0, PK(l0, h0), od); od = mfma32(pa1, PK(l1, h1), od); od = mfma32(pa2, PK(l2, h2), od); od = mfma32(pa3, PK(l3, h3), od);
#undef PK
}
__device__ __forceinline__ void pv_d0(f32x16* o, int vb, bf16x8 pa0, bf16x8 pa1, bf16x8 pa2, bf16x8 pa3) {
    pv_one<0>(o[0], vb, pa0, pa1, pa2, pa3); pv_one<1>(o[1], vb, pa0, pa1, pa2, pa3); pv_one<2>(o[2], vb, pa0, pa1, pa2, pa3); pv_one<3>(o[3], vb, pa0, pa1, pa2, pa3);
}
__device__ __forceinline__ void attn_unit(const bf16* __restrict__ Q, const bf16* __restrict__ KV, const bf16* __restrict__ KPE, bf16* __restrict__ O, int b, int h, int qb, LAS char* lds) {
    const int tid = pg8::opaque_tid(), wid = __builtin_amdgcn_readfirstlane(tid >> 6), lane = tid & 63, r32 = lane & 31, hi = lane >> 5;
    LAS char* V_lds = lds + OFF_V; LAS char* K_lds = lds + OFF_K; LAS char* KP_lds = lds + OFF_KP;
    LAS float* ws = (LAS float*)(lds + OFF_WS) + wid * 64; LAS float* li_l = ws; LAS float* al_l = ws + 32;
    const bf16* Kh = KV + (size_t)(b * SEQ) * LDKV + h * 256; const bf16* Vh = Kh + 128; const bf16* Pb = KPE + (size_t)(b * SEQ) * 64;
    const int NT = 4 * qb + 4, NTw = 4 * qb + (wid >> 1) + 1;
    float m_reg = -1e30f, l_reg = 0; f32x16 o[4] = {}; bf16x8 qr[12];
    const bf16* Qw = Q + (size_t)(b * SEQ + qb * 256 + wid * 32 + r32) * LDQ + h * DQK + hi * 8;
#pragma unroll
    for (int d0 = 0; d0 < 12; ++d0) qr[d0] = *(const bf16x8*)(Qw + d0 * 16);
    const int sr = tid >> 4, sc = (tid & 15) * 8, vst0 = v_st(sr, sc), vst1 = v_st(32 + sr, sc), pr = tid >> 3, pc = (tid & 7) * 8;
    const int vb0 = (int)(unsigned)(uintptr_t)V_lds + v_rd_base(lane);
    bf16x8 vs0, vs1, ks0, ks1, kp0;
#define SLOAD(k0) do { vs0 = *(const bf16x8*)(Vh + (size_t)((k0) + sr) * LDKV + sc); vs1 = *(const bf16x8*)(Vh + (size_t)((k0) + 32 + sr) * LDKV + sc); \
    ks0 = *(const bf16x8*)(Kh + (size_t)((k0) + sr) * LDKV + sc); ks1 = *(const bf16x8*)(Kh + (size_t)((k0) + 32 + sr) * LDKV + sc); kp0 = *(const bf16x8*)(Pb + (size_t)((k0) + pr) * 64 + pc); } while (0)
#define SWRITE(bb) do { *(LAS bf16x8*)(V_lds + (bb) * SHM_V + vst0) = vs0; *(LAS bf16x8*)(V_lds + (bb) * SHM_V + vst1) = vs1; \
    *(LAS bf16x8*)(K_lds + (bb) * SHM_K + KSWZ(sr, sc * 2)) = ks0; *(LAS bf16x8*)(K_lds + (bb) * SHM_K + KSWZ(32 + sr, sc * 2)) = ks1; \
    *(LAS bf16x8*)(KP_lds + (bb) * SHM_KP + KPSWZ(pr, pc * 2)) = kp0; } while (0)
#define RESC(a) do { if (__any((a) < 1.f)) { if (hi == 0) al_l[r32] = (a); asm volatile("s_waitcnt lgkmcnt(0)" ::: "memory"); \
    _Pragma("unroll") for (int d = 0; d < 4; ++d) _Pragma("unroll") for (int r = 0; r < 16; ++r) o[d][r] *= al_l[crow(r, hi)]; } } while (0)
    f32x16 p0, p1; float mn, al; bf16x8 pa0, pa1, pa2, pa3;
    SLOAD(0); asm volatile("s_waitcnt vmcnt(0)" ::: "memory"); SWRITE(0); __syncthreads();
    for (int j = 0; j < NT; ++j) {
        const int bsel = j & 1;
        if (j + 1 < NT) SLOAD((j + 1) * 64);
        SBAR();
        if (j < NTw) {
            qkt(p0, p1, K_lds + bsel * SHM_K, KP_lds + bsel * SHM_KP, qr, r32, hi);
            partialSM(p0, p1, m_reg, mn, al, false);
            RESC(al);
            finishSM(p0, p1, al, l_reg, pa0, pa1, pa2, pa3); SBAR();
            pv_d0(o, vb0 + bsel * SHM_V, pa0, pa1, pa2, pa3);
        }
        SBAR();
        if (j + 1 < NT) { asm volatile("s_waitcnt vmcnt(0)" ::: "memory"); SWRITE(bsel ^ 1); }
        __syncthreads();
    }
    if (hi == 0) li_l[r32] = l_reg; asm volatile("s_waitcnt lgkmcnt(0)" ::: "memory");
    float rli[16];
#pragma unroll
    for (int r = 0; r < 16; ++r) rli[r] = __builtin_amdgcn_rcpf(li_l[crow(r, hi)]);
    bf16* Ow = O + (size_t)(b * SEQ + qb * 256 + wid * 32) * LDO + h * 128;
#pragma unroll
    for (int r = 0; r < 16; ++r) { const int orow = crow(r, hi);
#pragma unroll
        for (int d0 = 0; d0 < 4; ++d0) Ow[(size_t)orow * LDO + d0 * 32 + r32] = (bf16)f2bf(o[d0][r] * rli[r]); }
    __syncthreads();
#undef SLOAD
#undef SWRITE
#undef RESC
}
}
__device__ __forceinline__ void attn_phase(Ctx& C) {
    const int x = C.bid & 7, idx = C.bid >> 3, per = C.G >> 3;
    for (int p = idx; p < 128; p += per) { const int bh = 16 * x + (p >> 3), pr = p & 7, b = bh >> 4, h = bh & 15;
        att::attn_unit(C_Q, C_KV, C_KPE, C_RA, b, h, 15 - pr, (LAS char*)C.lds);
        att::attn_unit(C_Q, C_KV, C_KPE, C_RA, b, h, pr, (LAS char*)C.lds); }
}

#ifndef DBG_DELTA
#define DBG_DELTA C_RA
#endif

#if PROBE_STAMP >= 6 && PROBE_STAMP < 10
#define XBS(j) (sp[(j) * 16384] = __builtin_amdgcn_s_memrealtime())
__device__ __forceinline__ void xcd_barrier_probe(const XcdBarrier& b, unsigned long long* sp) {
    asm volatile("s_waitcnt vmcnt(0)" ::: "memory");
    __syncthreads();
    if (threadIdx.x == 0) {
        unsigned* bar = b.bar;
        __builtin_amdgcn_s_waitcnt(0);
        unsigned nloc = b.st[0], nx = b.st[1];
        if (nloc == 0u) { xcd_barrier_complete(bar, b.x, nloc, nx); b.st[0] = nloc; b.st[1] = nx; }
        const unsigned old = xb_add(&bar[XB_XSUB(b.x)], 1u);
        const unsigned gen = old / nloc;
        XBS(2);
        if (old + 1u == (gen + 1u) * nloc) {
            __builtin_amdgcn_fence(__ATOMIC_RELEASE, "agent");
            asm volatile("s_waitcnt vmcnt(0)" ::: "memory");
            XBS(3);
            const unsigned og = xb_add(&bar[XB_TOP], 1u);
            const unsigned tg = og / nx;
            if (og + 1u == (tg + 1u) * nx) xb_add(&bar[XB_TOPGEN], 1u);
            else XB_SPIN(xb_ld(&bar[XB_TOPGEN]) == tg, bar);
            XBS(4);
            __builtin_amdgcn_fence(__ATOMIC_ACQUIRE, "agent");
            xb_add(&bar[XB_XGEN(b.x)], 1u);
            asm volatile("s_waitcnt vmcnt(0)" ::: "memory");
            XBS(5);
        } else {
            XB_SPIN(xb_ld(&bar[XB_XGEN(b.x)]) == gen, bar);
            XBS(4);
            __builtin_amdgcn_fence(__ATOMIC_ACQUIRE, "agent");
            asm volatile("s_waitcnt vmcnt(0)" ::: "memory");
            XBS(5);
        }
    }
    __syncthreads();
}
#endif
__global__ void __launch_bounds__(NWAVES * 64, 2) mk_fwd(Args args) {
    extern __shared__ __attribute__((aligned(16))) unsigned char lds_raw[];
    Ctx C;
    C.lds = (LAS unsigned char*)lds_raw;
    volatile LAS unsigned* MISC = (volatile LAS unsigned*)(C.lds + MISC_OFF);
    C.tid = threadIdx.x; C.lane = C.tid & 63; C.wave = __builtin_amdgcn_readfirstlane(C.tid >> 6); C.G = gridDim.x; C.bid = blockIdx.x;
    C.ka = (const CAS char*)__builtin_amdgcn_kernarg_segment_ptr(); gu32* ctl = (gu32*)(args.ws + WS_CTL);
    for (int u = C.tid; u < (LDS_BYTES - MISC_OFF) / 4; u += NWAVES * 64) ((LAS unsigned*)(C.lds + MISC_OFF))[u] = 0u;
    __syncthreads();
    const int lo = args.ph_lo, hi = args.ph_hi;
    const bool fused = (hi - lo) > 1;
    XcdBarrier bar; bar.bar = (unsigned*)(ctl + CW_BAR); bar.x = 0; bar.st = nullptr;
    if (fused) bar = xcd_barrier_post((unsigned*)(ctl + CW_BAR), MISC + 8);
#ifndef PH_MASK
#define PH_MASK 0x1FFF
#endif
#define IN(k) ((((PH_MASK) >> ((k) >= DEPTH * 12 ? 12 : (k) % 12)) & 1) && lo <= (k) && (k) < hi)
#define PH_FENCE() do { asm volatile("" : "+s"(C.ka), "+v"(C.tid)); C.lane = C.tid & 63; C.wave = __builtin_amdgcn_readfirstlane(C.tid >> 6); } while (0)
#ifndef PROBE_STAMP
#define PROBE_STAMP 0
#endif
#ifndef PROBE_STAMP_SEL
#define PROBE_STAMP_SEL 0xFFF
#endif
#define STAMP_AT(k) do { if (PROBE_STAMP && C.tid == 0) ((unsigned long long*)(args.ws + 262144))[C.bid * 64 + (k)] = __builtin_amdgcn_s_memrealtime(); } while (0)
#define STAMP2_AT(k) do { if (PROBE_STAMP && C.tid == 0) ((unsigned long long*)(args.ws + 262144 + 131072))[C.bid * 64 + (k)] = __builtin_amdgcn_s_memrealtime(); } while (0)
#if PROBE_STAMP >= 6 && PROBE_STAMP < 10
#define SEAM(k) do { STAMP_AT(k); if ((k) + 1 < hi) { XcdBarrier b2_ = bar; asm volatile("" : "+s"(b2_.bar)); xcd_barrier_probe(b2_, (unsigned long long*)(args.ws + 262144) + C.bid * 64 + (k)); } STAMP2_AT(k); } while (0)
#else
#define SEAM(k) do { STAMP_AT(k); if ((k) + 1 < hi) { _Pragma("unroll") for (int rb_ = 0; rb_ < REPN(15); ++rb_) { XcdBarrier b2_ = bar; asm volatile("" : "+s"(b2_.bar)); xcd_barrier(b2_); } } STAMP2_AT(k); } while (0)
#endif
#ifndef PROBE_REP_MASK
#define PROBE_REP_MASK 0
#endif
#define REPN(k) ((((PROBE_REP_MASK) >> (k)) & 1) ? 2 : 1)
#define gw (C.bid * NWAVES + C.wave)
#define NGW (C.G * NWAVES)

    for (int l = 0; l < DEPTH; ++l) {
        const int pb = l * 12;
        if (IN(pb + 0)) { PH_FENCE();
_Pragma("unroll")
            for (int rep = 0; rep < REPN(12); ++rep) convert_weights(C, l);
_Pragma("unroll")
            for (int rep = 0; rep < REPN(14); ++rep) { ssm_lp(C, l); if (l == 0) rope_tables(C); }
            if (l == 0) { row_phase<0>(C, C_in(I_X), nullptr, nullptr, nullptr, C_XB, nullptr, C_RS1); }
            else { const float* wpost = C_in(I_POSTFFN) + (l - 1) * DM;
                if (REPN(0) > 1) row_phase<1>(C, nullptr, C_XB, C_F, wpost, C_XB2, nullptr, C_RS1);
                row_phase<1>(C, nullptr, C_XB, C_F, wpost, C_XB, nullptr, C_RS1); }
            SEAM(pb + 0);
        }
        if (IN(pb + 1)) { PH_FENCE();
            EpiInProj E{C_CQ, C_CKV, C_KPE, C_U, C_GA, C_GB, C_ssqq, C_ssqkv, C_in(I_BGATE) + l * 2 * DM, C_cosT, C_sinT, C_RS1};
_Pragma("unroll")
            for (int rep = 0; rep < REPN(1); ++rep) run_gemm(C, C_XB, C_Win, NIN, DM, E);
_Pragma("unroll")
            for (int rep = 0; rep < REPN(13); ++rep) ssm_tables(C, l);
            SEAM(pb + 1);
        }
        if (IN(pb + 2)) { PH_FENCE();
_Pragma("unroll")
            for (int rep = 0; rep < REPN(2); ++rep) ssm_states(C);
            if (!fused) SEAM(pb + 2); }
        if (IN(pb + 3)) { PH_FENCE();
#ifndef NO_Q
_Pragma("unroll")
            for (int rep = 0; rep < REPN(3); ++rep) { EpiQ E{C_Q, C_ssqq, C_cosT, C_sinT}; run_gemm(C, C_CQ, C_Wuq, NH * DQK, QL, E); }
#endif
#ifndef NO_KV
_Pragma("unroll")
            for (int rep = 0; rep < REPN(3); ++rep) { EpiKV E{C_KV, C_ssqkv}; run_gemm(C, C_CKV, C_Wukv, 4096, KVL, E); }
#endif
            SEAM(pb + 3);
        }
        if (IN(pb + 4)) { PH_FENCE();
_Pragma("unroll")
            for (int rep = 0; rep < REPN(4); ++rep) ssm_outputs(C, l);
            if (!fused) SEAM(pb + 4); }
        if (IN(pb + 5)) { PH_FENCE();
_Pragma("unroll")
            for (int rep = 0; rep < REPN(5); ++rep) attn_phase(C);
            SEAM(pb + 5); }
        if (IN(pb + 6)) { PH_FENCE(); if (REPN(6) > 1) { EpiPlain E2{C_Q}; run_gemm(C, C_RA, C_Wo, DM, DM, E2); } EpiWo E{C_GA}; run_gemm(C, C_RA, C_Wo, DM, DM, E); SEAM(pb + 6); }
        if (IN(pb + 7)) { PH_FENCE(); if (REPN(7) > 1) { EpiSwiGlu E2{C_Q, C_RS2}; run_gemm(C, C_Z, C_Wglu, 4096, SW, E2); } EpiGlu E{C_GA, C_GB, C_in(I_BGLU) + l * 2 * DM}; run_gemm(C, C_Z, C_Wglu, 4096, SW, E); SEAM(pb + 7); }
        #ifdef DBG_K8
        if (IN(pb + 8)) { PH_FENCE(); EpiPlain E{C_GA}; run_gemm(C, C_RA, C_Wout, DM, DM, E); SEAM(pb + 8); }
#else
        if (IN(pb + 8)) { PH_FENCE(); EpiPlain E{C_RA};
_Pragma("unroll")
            for (int rep = 0; rep < REPN(8); ++rep) run_gemm(C, C_GA, C_Wout, DM, DM, E);
            SEAM(pb + 8); }
#endif
        if (IN(pb + 9)) { PH_FENCE();
            const float* wpost = C_in(I_POSTMIX) + l * DM;
            if (REPN(9) > 1) row_phase<1>(C, nullptr, C_XB, DBG_DELTA, wpost, C_XB2, nullptr, C_RS2);
            row_phase<1>(C, nullptr, C_XB, DBG_DELTA, wpost, l == DEPTH - 1 ? C_XB2 : C_XB, nullptr, C_RS2);
            SEAM(pb + 9);
        }
        if (IN(pb + 10)) { PH_FENCE(); EpiSwiGlu E{C_HID, C_RS2};
_Pragma("unroll")
            for (int rep = 0; rep < REPN(10); ++rep) run_gemm(C, l == DEPTH - 1 ? C_XB2 : C_XB, C_Wgu, 2 * FF, DM, E);
            SEAM(pb + 10); }
        if (IN(pb + 11)) { PH_FENCE(); EpiPlain E{C_F};
_Pragma("unroll")
            for (int rep = 0; rep < REPN(11); ++rep) run_gemm(C, C_HID, C_Wdn, DM, FF, E);
            SEAM(pb + 11); }
    }
    if (IN(DEPTH * 12)) { PH_FENCE();
        const float* wpost = C_in(I_POSTFFN) + (DEPTH - 1) * DM;
        row_phase<2>(C, nullptr, C_XB2, C_F, wpost, nullptr, C_out, nullptr);
    }
    if (PROBE_STAMP && fused) {
        STAMP_AT(48); { XcdBarrier b2_ = bar; xcd_barrier(b2_); }
        if (C.bid == 0 && C.tid == 0) { const unsigned long long* st = (const unsigned long long*)(args.ws + 262144); unsigned long long q1 = 0, q2 = 0, q3 = 0;
            for (int k = 0; k < 49; ++k) { if (!(((PROBE_STAMP_SEL) >> (k % 12)) & 1)) continue; unsigned long long mx = 0, mn = ~0ull, sm = 0; for (int b = 0; b < C.G; ++b) { const unsigned long long v = __hip_atomic_load(st + b * 64 + k, __ATOMIC_RELAXED, __HIP_MEMORY_SCOPE_AGENT); mx = v > mx ? v : mx; mn = v < mn ? v : mn; sm += v; }
                q1 += mx - mn; q2 += mx - sm / C.G;
                if (PROBE_STAMP == 3) { unsigned long long se = 0; const unsigned long long* st2 = st + 16384; for (int b = 0; b < C.G; ++b) se += __hip_atomic_load(st2 + b * 64 + k, __ATOMIC_RELAXED, __HIP_MEMORY_SCOPE_AGENT); if (se / C.G > mx && mx > 0) q3 += se / C.G - mx; } }
            if (PROBE_STAMP >= 6) { q3 = 0;
                for (int k = 0; k < 48; ++k) { if (!(((PROBE_STAMP_SEL) >> (k % 12)) & 1)) continue;
                    unsigned long long mxa = 0, sc = 0, se = 0, sd = 0, swb = 0, nl = 0, mxw = 0, scl = 0;
                    for (int b = 0; b < C.G; ++b) { const unsigned long long* q = st + b * 64 + k;
                        const unsigned long long a = __hip_atomic_load(q, __ATOMIC_RELAXED, __HIP_MEMORY_SCOPE_AGENT), e = __hip_atomic_load(q + 16384, __ATOMIC_RELAXED, __HIP_MEMORY_SCOPE_AGENT), b2 = __hip_atomic_load(q + 2 * 16384, __ATOMIC_RELAXED, __HIP_MEMORY_SCOPE_AGENT),
                            w = __hip_atomic_load(q + 3 * 16384, __ATOMIC_RELAXED, __HIP_MEMORY_SCOPE_AGENT), c = __hip_atomic_load(q + 4 * 16384, __ATOMIC_RELAXED, __HIP_MEMORY_SCOPE_AGENT), d = __hip_atomic_load(q + 5 * 16384, __ATOMIC_RELAXED, __HIP_MEMORY_SCOPE_AGENT);
                        mxa = a > mxa ? a : mxa; sc += c; se += e; sd += d; if (w) { ++nl; swb += w - b2; mxw = w > mxw ? w : mxw; scl += c; } }
                    const unsigned long long G_ = C.G;
                    if (PROBE_STAMP == 6) { if (sc / G_ > mxa) q3 += sc / G_ - mxa; }
                    if (PROBE_STAMP == 7) { if (se > sc) q3 += (se - sc) / G_; }
                    if (PROBE_STAMP == 8) { if (nl) q3 += swb / nl; }
                    if (PROBE_STAMP >= 10) { unsigned long long sdiff = 0, mnd = ~0ull, mxd = 0; for (int b = 0; b < C.G; ++b) { const unsigned long long* q = st + b * 64 + k; const unsigned long long a = __hip_atomic_load(q, __ATOMIC_RELAXED, __HIP_MEMORY_SCOPE_AGENT), e = __hip_atomic_load(q + 16384, __ATOMIC_RELAXED, __HIP_MEMORY_SCOPE_AGENT), df = e > a ? e - a : 0; sdiff += df; mnd = df < mnd ? df : mnd; mxd = df > mxd ? df : mxd; }
                        q3 += PROBE_STAMP == 10 ? sdiff / G_ : PROBE_STAMP == 11 ? mnd : mxd; }
                    if (PROBE_STAMP == 9) { if (nl && scl / nl > mxw) q3 += scl / nl - mxw; } }
            }
            unsigned long long spin = (PROBE_STAMP == 1 ? q1 : PROBE_STAMP >= 3 ? q3 * 4 : q2 * 2); if (spin > 2000000ull) spin = 2000000ull;     const unsigned long long t0 = __builtin_amdgcn_s_memrealtime();
            while (__builtin_amdgcn_s_memrealtime() - t0 < spin) __builtin_amdgcn_s_sleep(8); }
    }
#undef IN
#undef SEAM
#undef gw
#undef NGW
}

#ifndef MK_SINGLE
#define MK_SINGLE 0
#endif
#ifndef MK_PH_END
#define MK_PH_END NPH
#endif
extern "C" void kernel_launch(void* const* d_in, const int* in_sizes, int n_in, void* d_out, int out_size, void* d_ws, size_t ws_size, hipStream_t stream) {
    static int grid = 0;
    if (grid == 0) {
        if (n_in != 27 || in_sizes[0] != T * DM || out_size != T * DM || ws_size < WS_END) { fprintf(stderr, "kernel_launch: unexpected shapes: n_in %d in0 %d out %d ws %zu (need %zu)\n", n_in, n_in > 0 ? in_sizes[0] : -1, out_size, ws_size, (size_t)WS_END); grid = -1; return; }
        int dev = 0, cus = 0, per_cu = 0;
        if (hipGetDevice(&dev) != hipSuccess || hipDeviceGetAttribute(&cus, hipDeviceAttributeMultiprocessorCount, dev) != hipSuccess) { grid = -1; return; }
        if (hipFuncSetAttribute((const void*)mk_fwd, hipFuncAttributeMaxDynamicSharedMemorySize, LDS_BYTES) != hipSuccess) { fprintf(stderr, "kernel_launch: hipFuncSetAttribute failed\n"); grid = -1; return; }
        if (hipOccupancyMaxActiveBlocksPerMultiprocessor(&per_cu, (const void*)mk_fwd, NWAVES * 64, LDS_BYTES) != hipSuccess || per_cu < 1) fprintf(stderr, "kernel_launch: occupancy query says %d\n", per_cu);
        (void)hipGetLastError();
        grid = cus;
    }
    if (grid < 0) return;
    if (hipMemsetAsync((char*)d_ws + WS_CTL, 0, CTL_ZERO_BYTES, stream) != hipSuccess) return;
    Args a{};
    for (int i = 0; i < 27; ++i) a.in[i] = (const float*)d_in[i];
    a.out = (float*)d_out; a.ws = (unsigned char*)d_ws;
#if MK_SINGLE
    a.ph_lo = 0; a.ph_hi = MK_PH_END;
    hipLaunchKernelGGL(mk_fwd, dim3(grid), dim3(NWAVES * 64), LDS_BYTES, stream, a);
#else
    for (int p = 0; p < MK_PH_END; ++p) { a.ph_lo = p; a.ph_hi = p + 1; hipLaunchKernelGGL(mk_fwd, dim3(grid), dim3(NWAVES * 64), LDS_BYTES, stream, a); }
#endif
    const hipError_t le = hipPeekAtLastError();
    if (le != hipSuccess) fprintf(stderr, "kernel_launch: launch failed: %s\n", hipGetErrorName(le));
}
```

```cpp
#include <hip/hip_runtime.h>
#include <cstdio>
#include <cstdint>
#define REPS3 1
#define PROBE_STAMP 0
#define PROBE_STAMP_SEL 0xFFF
#define PROBE_REP_MASK 0
#define MK_ALIGN true
#define MK_SP2 true
#ifndef MK_SINGLE
#define MK_SINGLE 1
#endif
#ifndef MK_PH_END
#define MK_PH_END NPH
#endif
#ifndef PH_MASK
#define PH_MASK 0x1FFF
#endif
#ifndef DBG_DELTA
#define DBG_DELTA C_RA
#endif
namespace pg8 {
#define PG8_LAS __attribute__((address_space(3)))
typedef unsigned short bf16_t;
typedef short bf16x8 __attribute__((ext_vector_type(8)));
typedef float f32x4 __attribute__((ext_vector_type(4)));
typedef unsigned u32x4 __attribute__((ext_vector_type(4)));
constexpr int BM = 256, BK = 64, HALF = 128, HTB = HALF * BK * 2  , STAGE_BYTES = 8 * HTB, NXCD = 8, WGM = 8;

__host__ __device__ __forceinline__ int lds_byte(int r, int c) { const int st = (r >> 4) * 2 + (c >> 5), rr = r & 15, cc = c & 31, ob = rr * 64 + cc * 2; return st * 1024 + (ob ^ (((ob >> 9) & 1) << 5)); }
__host__ __device__ __forceinline__ void stage_rc(int b, int& R, int& C) { const int st = b / 1024, sb = b % 1024, swz = sb ^ (((sb >> 9) & 1) << 5); R = (st >> 1) * 16 + swz / 64; C = (st & 1) * 32 + (swz % 64) / 2; }
__host__ __device__ __forceinline__ int perm32(int rho) { const int n = rho >> 4, i = rho & 15; return 8 * (i >> 2) + 4 * n + (i & 3); }

__device__ __forceinline__ int opaque_tid() { int t = threadIdx.x; asm volatile("" : "+v"(t)); return t; }
struct Unit { int pm, pn; };
struct Gemm { const bf16_t* A; const bf16_t* Bt; int M, N, K; };

struct StaticOrder {
    int nM, nN, nwg, G, c;
    __host__ __device__ void init(int M, int N, int G_, int c_) { nM = M / BM; nN = N / BM; nwg = nM * nN; G = G_; c = c_; }
    __host__ __device__ bool next(int i, Unit& u) const {
        const long L = (long)i * G + c; if (L >= nwg) return false;
        int wgid = (int)L; { const int q = nwg / NXCD, r = nwg % NXCD, xcd = wgid % NXCD, off = wgid / NXCD; wgid = (xcd < r ? xcd * (q + 1) : r * (q + 1) + (xcd - r) * q) + off; }
        const int nig = WGM * nN, gid = wgid / nig, fm = gid * WGM, gsz = (nM - fm) < WGM ? (nM - fm) : WGM;
        u.pm = fm + ((wgid % nig) % gsz); u.pn = (wgid % nig) / gsz; return true;
    }
    __device__ __forceinline__ void a_ready(const Unit&) const {}
    __device__ __forceinline__ void done(const Unit&) const {}
};

typedef __bf16 bf16x2_t __attribute__((ext_vector_type(2))); typedef float f32x2_t __attribute__((ext_vector_type(2)));
__device__ __forceinline__ unsigned cvt_pk_bf16(float lo, float hi) { const f32x2_t v = {lo, hi}; const bf16x2_t b = __builtin_convertvector(v, bf16x2_t); return __builtin_bit_cast(unsigned, b); }
template <class Epi, class Sched, bool ALIGN_EPI = false, bool SP2 = false>
__device__ __forceinline__ void gemm_phase(PG8_LAS unsigned char* lds, const Gemm g, const Sched& S, const Epi& E) {
    const int tid = opaque_tid(), wid = __builtin_amdgcn_readfirstlane(tid >> 6), lane = tid & 63, wr = wid >> 2, wc = wid & 3, fr = lane & 15, fq = lane >> 4;
    const int K = g.K, nt = K / BK;
    unsigned voffA[2], voffB[2];
#pragma unroll
    for (int i = 0; i < 2; ++i) { int R, C; stage_rc(tid * 16 + i * 8192, R, C); const int Rb = Epi::PERM ? ((R & ~31) + perm32(R & 31)) : R;
        voffA[i] = (unsigned)(R * K + C) * 2u; voffB[i] = (unsigned)(Rb * K + C) * 2u; }
    const size_t kstep = (size_t)(BK * 2);
    const size_t hstep = (size_t)HALF * K * 2;
    const size_t tstep = 2 * hstep;
    const unsigned ldsw = (unsigned)wid * 1024u;
    const int aoff = lds_byte(wr * 64 + fr, fq * 8), boff = lds_byte(wc * 32 + fr, fq * 8);
#define PG8_SA(b, h) (((b) * 2 + (h)) * HTB)
#define PG8_SB(b, h) ((4 + (b) * 2 + (h)) * HTB)
#define PG8_STAGE(bufoff, gbase, voff) do { _Pragma("unroll") for (int _i = 0; _i < 2; ++_i) \
        __builtin_amdgcn_global_load_lds((const unsigned*)((const char*)(gbase) + (voff)[_i]), (PG8_LAS unsigned*)(lds + (bufoff) + ldsw + _i * 8192), 16, 0, 0); } while (0)
#define PG8_LDA(dst, b, h) do { _Pragma("unroll") for (int m = 0; m < 4; ++m) _Pragma("unroll") for (int k = 0; k < 2; ++k) dst[m][k] = *(const PG8_LAS bf16x8*)(lds + PG8_SA(b, h) + aoff + m * 2048 + k * 1024); } while (0)
#define PG8_LDB(dst, b, h) do { _Pragma("unroll") for (int n = 0; n < 2; ++n) _Pragma("unroll") for (int k = 0; k < 2; ++k) dst[n][k] = *(const PG8_LAS bf16x8*)(lds + PG8_SB(b, h) + boff + n * 2048 + k * 1024); } while (0)
#define PG8_MMA(ai, bj, At, Bt) do { __builtin_amdgcn_s_setprio(1); _Pragma("unroll") for (int m = 0; m < 4; ++m) _Pragma("unroll") for (int n = 0; n < 2; ++n) _Pragma("unroll") for (int k = 0; k < 2; ++k) \
        acc[ai][bj][m][n] = __builtin_amdgcn_mfma_f32_16x16x32_bf16(Bt[n][k], At[m][k], acc[ai][bj][m][n], 0, 0, 0); __builtin_amdgcn_s_setprio(0); } while (0)
#define PG8_WAIT_V(n) asm volatile("s_waitcnt vmcnt(" #n ")" ::: "memory")
#define PG8_WAIT_L(n) asm volatile("s_waitcnt lgkmcnt(" #n ")" ::: "memory")
#define PG8_BAR __builtin_amdgcn_s_barrier()
#define PG8_SCHED __builtin_amdgcn_sched_barrier(0)
    Unit cur, nxt; int ui = 0;
    if (!S.next(0, cur)) return;
    f32x4 acc[2][2][4][2];
#pragma unroll
    for (int a = 0; a < 2; ++a)
#pragma unroll
        for (int b = 0; b < 2; ++b)
#pragma unroll
            for (int m = 0; m < 4; ++m)
#pragma unroll
                for (int n = 0; n < 2; ++n) acc[a][b][m][n] = (f32x4){0.f, 0.f, 0.f, 0.f};
    bf16x8 At[4][2], B0[2][2], B1[2][2];
    const char* cA = (const char*)g.A + (size_t)cur.pm * tstep; const char* cB = (const char*)g.Bt + (size_t)cur.pn * tstep;
    S.a_ready(cur);
    if constexpr (SP2) {
        PG8_STAGE(PG8_SB(0, 0), cB, voffB); PG8_STAGE(PG8_SB(0, 1), cB + hstep, voffB); PG8_STAGE(PG8_SA(0, 0), cA, voffA); PG8_STAGE(PG8_SA(0, 1), cA + hstep, voffA);
        if (wr == 1) PG8_BAR;
        PG8_WAIT_V(2); PG8_BAR;
        PG8_STAGE(PG8_SB(1, 0), cB + kstep, voffB); PG8_STAGE(PG8_SA(1, 0), cA + kstep, voffA); PG8_STAGE(PG8_SB(1, 1), cB + hstep + kstep, voffB);
        PG8_WAIT_V(6); PG8_BAR;
    } else {
        PG8_STAGE(PG8_SB(0, 0), cB, voffB); PG8_STAGE(PG8_SA(0, 0), cA, voffA); PG8_STAGE(PG8_SB(0, 1), cB + hstep, voffB); PG8_STAGE(PG8_SA(0, 1), cA + hstep, voffA);
        if (wr == 1) PG8_BAR;
        PG8_WAIT_V(4); PG8_BAR;
        PG8_STAGE(PG8_SB(1, 0), cB + kstep, voffB); PG8_STAGE(PG8_SA(1, 0), cA + kstep, voffA); PG8_STAGE(PG8_SB(1, 1), cB + hstep + kstep, voffB);
        PG8_WAIT_V(6); PG8_BAR;
    }
    for (;;) {
        const bool has_next = S.next(ui + 1, nxt);
        const char* nA = has_next ? (const char*)g.A + (size_t)nxt.pm * tstep : cA; const char* nB = has_next ? (const char*)g.Bt + (size_t)nxt.pn * tstep : cB;
        for (int t = 0; t < nt; t += 2) {
            const bool last = (t == nt - 2);
            const char* a1 = cA + (size_t)(t + 1) * kstep;
            const char* a2 = last ? nA : cA + (size_t)(t + 2) * kstep; const char* b2 = last ? nB : cB + (size_t)(t + 2) * kstep;
            const char* a3 = a2 + kstep; const char* b3 = b2 + kstep;
            if (last && has_next) S.a_ready(nxt);
            if constexpr (SP2) {
            PG8_LDB(B0, 0, 0); PG8_LDB(B1, 0, 1); PG8_SCHED; PG8_LDA(At, 0, 0); PG8_STAGE(PG8_SA(1, 1), a1 + hstep, voffA);
            PG8_WAIT_V(8); PG8_WAIT_L(0); PG8_BAR; PG8_MMA(0, 0, At, B0); PG8_MMA(0, 1, At, B1); PG8_BAR; PG8_SCHED;
            PG8_LDA(At, 0, 1); PG8_STAGE(PG8_SB(0, 0), b2, voffB); PG8_STAGE(PG8_SB(0, 1), b2 + hstep, voffB); PG8_STAGE(PG8_SA(0, 0), a2, voffA);
            PG8_WAIT_V(8); PG8_WAIT_L(0); PG8_BAR; PG8_MMA(1, 0, At, B0); PG8_MMA(1, 1, At, B1); PG8_BAR; PG8_SCHED;
            PG8_LDB(B0, 1, 0); PG8_LDB(B1, 1, 1); PG8_SCHED; PG8_LDA(At, 1, 0); PG8_STAGE(PG8_SA(0, 1), a2 + hstep, voffA);
            PG8_WAIT_V(8); PG8_WAIT_L(0); PG8_BAR; PG8_MMA(0, 0, At, B0); PG8_MMA(0, 1, At, B1); PG8_BAR; PG8_SCHED;
            PG8_LDA(At, 1, 1); PG8_STAGE(PG8_SB(1, 0), b3, voffB); PG8_STAGE(PG8_SB(1, 1), b3 + hstep, voffB); PG8_STAGE(PG8_SA(1, 0), a3, voffA);
            PG8_WAIT_V(8); PG8_WAIT_L(0); PG8_BAR; PG8_MMA(1, 0, At, B0); PG8_MMA(1, 1, At, B1); PG8_BAR; PG8_SCHED;
            } else {
            PG8_LDB(B0, 0, 0); PG8_SCHED; PG8_LDA(At, 0, 0); PG8_STAGE(PG8_SA(1, 1), a1 + hstep, voffA);
            PG8_WAIT_L(8); PG8_BAR; PG8_WAIT_L(0); PG8_MMA(0, 0, At, B0); PG8_BAR; PG8_SCHED;
            PG8_LDB(B1, 0, 1); PG8_STAGE(PG8_SB(0, 0), b2, voffB);
            PG8_BAR; PG8_WAIT_L(0); PG8_MMA(0, 1, At, B1); PG8_BAR;
            PG8_LDA(At, 0, 1); PG8_STAGE(PG8_SA(0, 0), a2, voffA);
            PG8_BAR; PG8_WAIT_L(0); PG8_MMA(1, 0, At, B0); PG8_BAR; PG8_SCHED;
            PG8_STAGE(PG8_SB(0, 1), b2 + hstep, voffB);
            PG8_WAIT_V(6); PG8_BAR; PG8_MMA(1, 1, At, B1); PG8_BAR;
            PG8_LDB(B0, 1, 0); PG8_SCHED; PG8_LDA(At, 1, 0); PG8_STAGE(PG8_SA(0, 1), a2 + hstep, voffA);
            PG8_WAIT_L(8); PG8_BAR; PG8_WAIT_L(0); PG8_MMA(0, 0, At, B0); PG8_BAR; PG8_SCHED;
            PG8_LDB(B1, 1, 1); PG8_STAGE(PG8_SB(1, 0), b3, voffB);
            PG8_BAR; PG8_WAIT_L(0); PG8_MMA(0, 1, At, B1); PG8_BAR;
            PG8_LDA(At, 1, 1); PG8_STAGE(PG8_SA(1, 0), a3, voffA);
            PG8_BAR; PG8_WAIT_L(0); PG8_MMA(1, 0, At, B0); PG8_BAR; PG8_SCHED;
            PG8_STAGE(PG8_SB(1, 1), b3 + hstep, voffB);
            PG8_WAIT_V(6); PG8_BAR; PG8_MMA(1, 1, At, B1); PG8_BAR;
            }
        }
        if constexpr (ALIGN_EPI) { if (wr == 0) PG8_BAR; }
        if constexpr (!Epi::AFTER_DRAIN) { E(acc, cur, wr, wc, fr, fq); S.done(cur); }
        if (!has_next) break;
#pragma unroll
        for (int a = 0; a < 2; ++a)
#pragma unroll
            for (int b = 0; b < 2; ++b)
#pragma unroll
                for (int m = 0; m < 4; ++m)
#pragma unroll
                    for (int n = 0; n < 2; ++n) acc[a][b][m][n] = (f32x4){0.f, 0.f, 0.f, 0.f};
        cur = nxt; cA = nA; cB = nB; ++ui;
        if constexpr (ALIGN_EPI) { if (wr == 1) PG8_BAR; }
    }
    PG8_WAIT_V(0);
    if constexpr (!ALIGN_EPI) { if (wr == 0) PG8_BAR; }
    PG8_BAR;
    if constexpr (Epi::AFTER_DRAIN) { E.fused(acc, cur, wr, wc, fr, fq, lds, wid, lane); S.done(cur); }
#undef PG8_SA
#undef PG8_SB
#undef PG8_STAGE
#undef PG8_LDA
#undef PG8_LDB
#undef PG8_MMA
#undef PG8_WAIT_V
#undef PG8_WAIT_L
#undef PG8_BAR
#undef PG8_SCHED
}
}

constexpr int BATCH = 8, SEQ = 4096, DM = 2048, DEPTH = 4, T = BATCH * SEQ;
constexpr int NH = 16, DQK = 192, QL = 512, KVL = 256;
constexpr int SW = 1024, SG = 64, SN = 64, SP = 16, FF = 5632;
constexpr int INW = 5952, OFF_SSM = 832, OFF_GATE = 1856;
constexpr int NIN = 6144;
constexpr float EPS = 1e-6f;
constexpr float QSCALE = 0.07216878364870322f * 1.4426950408889634f;
constexpr int NWAVES = 8;
constexpr int NPH = DEPTH * 12 + 1;

constexpr size_t MiB = 1u << 20;
constexpr size_t WS_CTL = 0, CTL_ZERO_BYTES = 1 * MiB;
constexpr size_t WS_COS = 1 * MiB, WS_SIN = 5 * MiB;
constexpr size_t WS_SSQQ = 9 * MiB, WS_SSQKV = 10 * MiB;
constexpr size_t WS_RS1 = 10 * MiB + 512 * 1024, WS_RS2 = 10 * MiB + 768 * 1024;
constexpr size_t WS_LP = 11 * MiB;
constexpr size_t WS_FB = WS_LP + 5 * MiB / 2;
constexpr size_t WS_KD = 14 * MiB;
constexpr size_t WS_MAT = 17 * MiB;
constexpr size_t WS_CCT = 33 * MiB;
constexpr size_t WS_XST = 49 * MiB;
constexpr size_t WS_W = 57 * MiB;
constexpr size_t WO_WIN = 0, WO_WUQ = 24 * MiB, WO_WUKV = 27 * MiB, WO_WO = 29 * MiB, WO_WGLU = 37 * MiB, WO_WOUT = 45 * MiB, WO_WGU = 53 * MiB, WO_WDN = 97 * MiB;
constexpr size_t WS_RA = 176 * MiB;
constexpr size_t WS_CQ = 304 * MiB, WS_CKV = 336 * MiB, WS_KPE = 352 * MiB, WS_U = 356 * MiB, WS_GA = 420 * MiB, WS_GB = 548 * MiB;
constexpr size_t WS_HID = 304 * MiB;
constexpr size_t WS_Q = 676 * MiB;
constexpr size_t WS_KV = 868 * MiB;
constexpr size_t WS_Z = 1124 * MiB;
constexpr size_t WS_END = 1188 * MiB;
static_assert(WS_HID + (size_t)T * FF * 2 <= WS_Q, "HID overlay");

constexpr int CW_TMO = 0, CW_CODE = 1, CW_BAR = 4096;

constexpr int RING_BYTES = 131072, KD_LDS_BYTES = 4 * 65 * 256 * 2, LDS_BYTES = 163840, MISC_OFF = LDS_BYTES - 512;

#define GAS __attribute__((address_space(1)))
#define LAS __attribute__((address_space(3)))
#define CAS __attribute__((address_space(4)))
typedef unsigned short bf16;
using pg8::bf16x8; using pg8::f32x4; using pg8::u32x4; using pg8::cvt_pk_bf16;
typedef float f32x2 __attribute__((ext_vector_type(2)));
typedef float f32x16 __attribute__((ext_vector_type(16)));
typedef unsigned u32x2 __attribute__((ext_vector_type(2)));
typedef short s16x4 __attribute__((ext_vector_type(4)));
typedef GAS unsigned gu32;
#define RLX_AGENT __ATOMIC_RELAXED, __HIP_MEMORY_SCOPE_AGENT
#define LDS_WAIT() asm volatile("s_waitcnt lgkmcnt(0)" ::: "memory")
#define VM_WAIT() asm volatile("s_waitcnt vmcnt(0)" ::: "memory")
__device__ __forceinline__ unsigned f2bf(float f) { unsigned u = __builtin_bit_cast(unsigned, f); return (u + 0x7fffu + ((u >> 16) & 1u)) >> 16; }
__device__ __forceinline__ unsigned pk2(float lo, float hi) { return f2bf(lo) | (f2bf(hi) << 16); }
__device__ __forceinline__ float bflo(unsigned w) { return __uint_as_float(w << 16); }
__device__ __forceinline__ float bfhi(unsigned w) { return __uint_as_float(w & 0xffff0000u); }
__device__ __forceinline__ float sigm(float x) { return __builtin_amdgcn_rcpf(1.0f + __builtin_amdgcn_exp2f(-1.4426950408889634f * x)); }
__device__ __forceinline__ void st8(bf16* p, f32x4 v0, f32x4 v1) { u32x4 w; w.x = cvt_pk_bf16(v0[0], v0[1]); w.y = cvt_pk_bf16(v0[2], v0[3]); w.z = cvt_pk_bf16(v1[0], v1[1]); w.w = cvt_pk_bf16(v1[2], v1[3]); *(u32x4*)p = w; }
__device__ __forceinline__ void ld8(const bf16* p, f32x4& v0, f32x4& v1) { const u32x4 w = *(const u32x4*)p; v0[0] = bflo(w.x); v0[1] = bfhi(w.x); v0[2] = bflo(w.y); v0[3] = bfhi(w.y); v1[0] = bflo(w.z); v1[1] = bfhi(w.z); v1[2] = bflo(w.w); v1[3] = bfhi(w.w); }
__device__ __forceinline__ float wave_sum(float v) {
#pragma unroll
    for (int o = 1; o < 64; o <<= 1) v += __shfl_xor(v, o);
    return v;
}

#define XB_TMO      128
#define XB_XCNT(j)  (256  + 64 * (j))
#define XB_XSUB(j)  (1280 + 64 * (j))
#define XB_XGEN(j)  (2304 + 64 * (j))
#define XB_TOP      3328
#define XB_TOPGEN   3392
#define XCD_BAR_WORDS 3456
#define XB_SPIN_CAP (1u << 18)

__device__ __forceinline__ unsigned xb_ld(unsigned* p)              { return __hip_atomic_load(p, __ATOMIC_RELAXED, __HIP_MEMORY_SCOPE_AGENT); }
__device__ __forceinline__ unsigned xb_add(unsigned* p, unsigned v) { return __hip_atomic_fetch_add(p, v, __ATOMIC_RELAXED, __HIP_MEMORY_SCOPE_AGENT); }
__device__ __forceinline__ unsigned xb_xcc_id() { return (unsigned)__builtin_amdgcn_s_getreg((3 << 11) | 20) & 0xFu; }
#define XB_SPIN(cond, bar) do { unsigned _sp = 0; while (cond) { __builtin_amdgcn_s_sleep(1); \
    if ((++_sp & 255u) == 0u) { if (xb_ld(&(bar)[XB_TMO])) break; if (_sp > XB_SPIN_CAP) { atomicAdd(&(bar)[XB_TMO], 1u); break; } } } } while (0)

struct XcdBarrier {
    unsigned* bar; unsigned x;
    volatile LAS unsigned* st;
};

__device__ __forceinline__ XcdBarrier xcd_barrier_post(unsigned* bar, volatile LAS unsigned* st) {
    XcdBarrier b; b.bar = bar; b.x = xb_xcc_id(); b.st = st;
    if (threadIdx.x == 0) (void)xb_add(&bar[XB_XCNT(b.x)], 1u);
    return b;
}
__device__ __forceinline__ void xcd_barrier_complete(unsigned* bar, unsigned x, unsigned& nloc, unsigned& nx) {
    const unsigned G = gridDim.x * gridDim.y * gridDim.z;
    unsigned sum, cnt, mine, sp = 0u;
    for (;;) {
        sum = 0u; cnt = 0u; mine = 0u;
#pragma unroll
        for (unsigned j = 0; j < 16; ++j) { const unsigned c = xb_ld(&bar[XB_XCNT(j)]); sum += c; cnt += (c > 0u) ? 1u : 0u; mine = (j == x) ? c : mine; }
        if (sum == G) break;
        __builtin_amdgcn_s_sleep(1);
        if ((++sp & 255u) == 0u) { if (xb_ld(&bar[XB_TMO])) break; if (sp > XB_SPIN_CAP) { atomicAdd(&bar[XB_TMO], 1u); break; } }
    }
    nloc = mine > 0u ? mine : 1u; nx = cnt > 0u ? cnt : 1u;
}

__device__ __forceinline__ void xcd_barrier(const XcdBarrier& b) {
    asm volatile("s_waitcnt vmcnt(0)" ::: "memory");
    __syncthreads();
    if (threadIdx.x == 0) {
        unsigned* bar = b.bar;
        __builtin_amdgcn_s_waitcnt(0);
        unsigned nloc = b.st[0], nx = b.st[1];
        if (nloc == 0u) { xcd_barrier_complete(bar, b.x, nloc, nx); b.st[0] = nloc; b.st[1] = nx; }
        const unsigned old = xb_add(&bar[XB_XSUB(b.x)], 1u);
        const unsigned gen = old / nloc;
        if (old + 1u == (gen + 1u) * nloc) {
            __builtin_amdgcn_fence(__ATOMIC_RELEASE, "agent");
            asm volatile("s_waitcnt vmcnt(0)" ::: "memory");
            const unsigned og = xb_add(&bar[XB_TOP], 1u);
            const unsigned tg = og / nx;
            if (og + 1u == (tg + 1u) * nx) xb_add(&bar[XB_TOPGEN], 1u);
            else XB_SPIN(xb_ld(&bar[XB_TOPGEN]) == tg, bar);
            __builtin_amdgcn_fence(__ATOMIC_ACQUIRE, "agent");
            xb_add(&bar[XB_XGEN(b.x)], 1u);
            asm volatile("s_waitcnt vmcnt(0)" ::: "memory");
        } else {
            XB_SPIN(xb_ld(&bar[XB_XGEN(b.x)]) == gen, bar);
            __builtin_amdgcn_fence(__ATOMIC_ACQUIRE, "agent");
            asm volatile("s_waitcnt vmcnt(0)" ::: "memory");
        }
    }
    __syncthreads();
}

struct Args { const float* in[27]; float* out; unsigned char* ws; int ph_lo, ph_hi; };
struct Ctx {
    LAS unsigned char* lds;
    int tid, lane, wave, G, bid;
    const CAS char* ka;
};
static_assert(sizeof(Args) == 240, "Args layout");
#define C_in(i) (*(const float* const CAS*)(C.ka + 8 * (i)))
#define C_out (*(float* const CAS*)(C.ka + 216))
#define C_ws (*(unsigned char* const CAS*)(C.ka + 224))
#define WSP(TY, off) ((TY*)(C_ws + (off)))
#define C_cosT WSP(float, WS_COS)
#define C_sinT WSP(float, WS_SIN)
#define C_ssqq WSP(float, WS_SSQQ)
#define C_ssqkv WSP(float, WS_SSQKV)
#define C_LP WSP(f32x2, WS_LP)
#define C_FB WSP(f32x2, WS_FB)
#define C_KD WSP(bf16, WS_KD)
#define C_MAT WSP(bf16, WS_MAT)
#define C_CCT WSP(bf16, WS_CCT)
#define C_XST WSP(bf16, WS_XST)
#define C_Win WSP(bf16, WS_W + WO_WIN)
#define C_Wuq WSP(bf16, WS_W + WO_WUQ)
#define C_Wukv WSP(bf16, WS_W + WO_WUKV)
#define C_Wo WSP(bf16, WS_W + WO_WO)
#define C_Wglu WSP(bf16, WS_W + WO_WGLU)
#define C_Wout WSP(bf16, WS_W + WO_WOUT)
#define C_Wgu WSP(bf16, WS_W + WO_WGU)
#define C_Wdn WSP(bf16, WS_W + WO_WDN)
#define C_RA WSP(bf16, WS_RA)
#define C_CQ WSP(bf16, WS_CQ)
#define C_CKV WSP(bf16, WS_CKV)
#define C_KPE WSP(bf16, WS_KPE)
#define C_U WSP(bf16, WS_U)
#define C_GA WSP(bf16, WS_GA)
#define C_GB WSP(bf16, WS_GB)
#define C_HID WSP(bf16, WS_HID)
#define C_Q WSP(bf16, WS_Q)
#define C_KV WSP(bf16, WS_KV)
#define C_Z WSP(bf16, WS_Z)
#define C_XB2 WSP(bf16, WS_Q)
#define C_XB ((bf16*)C_out)
#define C_RS1 WSP(float, WS_RS1)
#define C_RS2 WSP(float, WS_RS2)
#define C_F WSP(bf16, WS_KV)
enum { I_X = 0, I_POS, I_PREMIX, I_WIN, I_BGATE, I_QNORM, I_KVNORM, I_WUQ, I_WUKV, I_WO, I_ARE, I_AIM, I_LOGDT, I_BRE, I_BIM, I_CRE, I_CIM, I_SSMD, I_WGLU, I_BGLU, I_WOUT, I_POSTMIX, I_PREFFN, I_WFG, I_WFU, I_WFD, I_POSTFFN };

using pg8::Unit;
#define EPI_HDR static constexpr bool PERM = true, AFTER_DRAIN = false;
#define EPI_ARGS const f32x4 (&acc)[2][2][4][2], const Unit& u, int wr, int wc, int fr, int fq
#define FOR_AI_M _Pragma("unroll") for (int ai = 0; ai < 2; ++ai) _Pragma("unroll") for (int m = 0; m < 4; ++m)

#ifndef MK_ST_AUX
#define MK_ST_AUX 16
#endif
typedef __amdgpu_buffer_rsrc_t rsrc_t;
__device__ __forceinline__ rsrc_t mk_rsrc(const void* p, unsigned bytes) { return __builtin_amdgcn_make_buffer_rsrc((void*)p, (short)0, (int)bytes, 0x00020000); }
__device__ __forceinline__ void bst8(rsrc_t r, unsigned voff, unsigned soff, f32x4 v0, f32x4 v1) { u32x4 w; w.x = cvt_pk_bf16(v0[0], v0[1]); w.y = cvt_pk_bf16(v0[2], v0[3]); w.z = cvt_pk_bf16(v1[0], v1[1]); w.w = cvt_pk_bf16(v1[2], v1[3]); __builtin_amdgcn_raw_buffer_store_b128(w, r, voff + soff, 0, MK_ST_AUX); }
__device__ __forceinline__ void bld8(rsrc_t r, unsigned voff, unsigned soff, f32x4& v0, f32x4& v1) { const u32x4 w = __builtin_amdgcn_raw_buffer_load_b128(r, voff, soff, 0); v0[0] = bflo(w.x); v0[1] = bfhi(w.x); v0[2] = bflo(w.y); v0[3] = bfhi(w.y); v1[0] = bflo(w.z); v1[1] = bfhi(w.z); v1[2] = bflo(w.w); v1[3] = bfhi(w.w); }
__device__ __forceinline__ f32x4 bldf4(rsrc_t r, unsigned voff, unsigned soff) { return __builtin_bit_cast(f32x4, __builtin_amdgcn_raw_buffer_load_b128(r, voff, soff, 0)); }
#define ROWG (ai * 128 + m * 16)
#define TILE_BYTES(PB) (255u * (PB) + (PB))
#define RS_LOAD(P) float rsv[2][4]; { const rsrc_t rr_ = mk_rsrc((P) + r0, 1024); FOR_AI_M rsv[ai][m] = __uint_as_float(__builtin_amdgcn_raw_buffer_load_b32(rr_, (unsigned)lr * 4u, ROWG * 4, 0)); }

struct EpiInProj { EPI_HDR
    bf16 *CQ, *CKV, *KPE, *U, *GA, *GB; float *ssqq, *ssqkv; const float *bgate, *cosT, *sinT, *rsr;
    __device__ __forceinline__ void operator()(EPI_ARGS) const {
        const int pn = u.pn, lr = wr * 64 + fr, cl = wc * 32 + 8 * fq; const size_t r0 = (size_t)u.pm * 256;
        RS_LOAD(rsr);
        if (pn < 2) {
            const rsrc_t rb = mk_rsrc(CQ + r0 * QL + pn * 256, TILE_BYTES(QL * 2)), rq = mk_rsrc(ssqq + r0 * 8, 256 * 32);
            const unsigned vo = (unsigned)(lr * QL + cl) * 2u, vs = (unsigned)(lr * 8 + pn * 4 + wc) * 4u;
            FOR_AI_M { float s = 0.f;
#pragma unroll
                for (int bj = 0; bj < 2; ++bj) { const f32x4 v0 = acc[ai][bj][m][0] * rsv[ai][m], v1 = acc[ai][bj][m][1] * rsv[ai][m];
                    s += (v0[0] * v0[0] + v0[1] * v0[1]) + (v0[2] * v0[2] + v0[3] * v0[3]) + (v1[0] * v1[0] + v1[1] * v1[1]) + (v1[2] * v1[2] + v1[3] * v1[3]);
                    bst8(rb, vo, ROWG * QL * 2 + bj * 256, v0, v1); }
                s += __shfl_xor(s, 16); s += __shfl_xor(s, 32);
                if (fq == 0) __builtin_amdgcn_raw_buffer_store_b32(__float_as_uint(s), rq, vs + ROWG * 32, 0, 0); }
        } else if (pn == 2) {
            const rsrc_t rb = mk_rsrc(CKV + r0 * KVL, TILE_BYTES(KVL * 2)), rq = mk_rsrc(ssqkv + r0 * 4, 256 * 16);
            const unsigned vo = (unsigned)(lr * KVL + cl) * 2u, vs = (unsigned)(lr * 4 + wc) * 4u;
            FOR_AI_M { float s = 0.f;
#pragma unroll
                for (int bj = 0; bj < 2; ++bj) { const f32x4 v0 = acc[ai][bj][m][0] * rsv[ai][m], v1 = acc[ai][bj][m][1] * rsv[ai][m];
                    s += (v0[0] * v0[0] + v0[1] * v0[1]) + (v0[2] * v0[2] + v0[3] * v0[3]) + (v1[0] * v1[0] + v1[1] * v1[1]) + (v1[2] * v1[2] + v1[3] * v1[3]);
                    bst8(rb, vo, ROWG * KVL * 2 + bj * 256, v0, v1); }
                s += __shfl_xor(s, 16); s += __shfl_xor(s, 32);
                if (fq == 0) __builtin_amdgcn_raw_buffer_store_b32(__float_as_uint(s), rq, vs + ROWG * 16, 0, 0); }
        } else if (pn < 7) {
            const rsrc_t rb = mk_rsrc(U + r0 * SW + (pn - 3) * 256, TILE_BYTES(SW * 2)); const unsigned vo = (unsigned)(lr * SW + cl) * 2u;
            FOR_AI_M {
#pragma unroll
                for (int bj = 0; bj < 2; ++bj) bst8(rb, vo, ROWG * SW * 2 + bj * 256, acc[ai][bj][m][0] * rsv[ai][m], acc[ai][bj][m][1] * rsv[ai][m]); }
        } else if (pn < 23) {
            const int colt = (pn - (pn < 15 ? 7 : 15)) * 256;
            const rsrc_t rb = mk_rsrc((pn < 15 ? GA : GB) + r0 * DM + colt, TILE_BYTES(DM * 2)); const unsigned vo = (unsigned)(lr * DM + cl) * 2u;
            const float* bb = bgate + (pn < 15 ? 0 : DM) + colt + cl;
            f32x4 bv[2][2];
#pragma unroll
            for (int bj = 0; bj < 2; ++bj) { bv[bj][0] = *(const f32x4*)(bb + bj * 128); bv[bj][1] = *(const f32x4*)(bb + bj * 128 + 4); }
            FOR_AI_M {
#pragma unroll
                for (int bj = 0; bj < 2; ++bj) { f32x4 v0 = acc[ai][bj][m][0] * rsv[ai][m] + bv[bj][0], v1 = acc[ai][bj][m][1] * rsv[ai][m] + bv[bj][1];
#pragma unroll
                    for (int e = 0; e < 4; ++e) { v0[e] = sigm(v0[e]); v1[e] = sigm(v1[e]); }
#ifdef DBG_PLAINGATE
                    v0 = acc[ai][bj][m][0]; v1 = acc[ai][bj][m][1];
#endif
#ifdef DBG_BIASONLY
#pragma unroll
                    for (int e = 0; e < 4; ++e) { float t0 = acc[ai][bj][m][0][e] + bv[bj][0][e], t1 = acc[ai][bj][m][1][e] + bv[bj][1][e]; asm volatile("" : "+v"(t0), "+v"(t1)); v0[e] = t0; v1[e] = t1; }
#endif
                    bst8(rb, vo, ROWG * DM * 2 + bj * 256, v0, v1); } }
        } else if (wc == 0) {
            const rsrc_t rb = mk_rsrc(KPE + r0 * 64, 256 * 128), rc = mk_rsrc(cosT + r0 * 32, 256 * 128), rs_ = mk_rsrc(sinT + r0 * 32, 256 * 128);
            const unsigned vo = (unsigned)(lr * 64 + 8 * fq) * 2u, vt = (unsigned)(lr * 32 + 8 * fq) * 4u;
#pragma unroll
            for (int h4 = 0; h4 < 4; ++h4) { const int ai = h4 >> 1; f32x4 c0[2], c1[2], s0[2], s1[2];
#pragma unroll
                for (int mm = 0; mm < 2; ++mm) { const int m = (h4 & 1) * 2 + mm; c0[mm] = bldf4(rc, vt, ROWG * 128); c1[mm] = bldf4(rc, vt, ROWG * 128 + 16); s0[mm] = bldf4(rs_, vt, ROWG * 128); s1[mm] = bldf4(rs_, vt, ROWG * 128 + 16); }
                asm volatile("" ::: "memory");
#pragma unroll
                for (int mm = 0; mm < 2; ++mm) { const int m = (h4 & 1) * 2 + mm;
                    const f32x4 x10 = acc[ai][0][m][0] * rsv[ai][m], x11 = acc[ai][0][m][1] * rsv[ai][m], x20 = acc[ai][1][m][0] * rsv[ai][m], x21 = acc[ai][1][m][1] * rsv[ai][m];
                    bst8(rb, vo, ROWG * 128, x10 * c0[mm] - x20 * s0[mm], x11 * c1[mm] - x21 * s1[mm]);
                    bst8(rb, vo, ROWG * 128 + 64, x10 * s0[mm] + x20 * c0[mm], x11 * s1[mm] + x21 * c1[mm]); }
                asm volatile("" ::: "memory"); }
        }
    }
};
struct EpiQ { EPI_HDR
    bf16* Q; const float *ssqq, *cosT, *sinT;
    __device__ __forceinline__ void operator()(EPI_ARGS) const {
        constexpr int PQ = NH * DQK * 2;
        const int pn = u.pn, lr = wr * 64 + fr, cl = wc * 32 + 8 * fq; const size_t r0 = (size_t)u.pm * 256;
        const rsrc_t rq = mk_rsrc(ssqq + r0 * 8, 256 * 32), rb = mk_rsrc(Q + r0 * (NH * DQK), TILE_BYTES(PQ));
        const unsigned vs = (unsigned)lr * 32u;
        float rsv[2][4];
#pragma unroll
        for (int ai = 0; ai < 2; ++ai) { f32x4 sa[4], sb[4];
#pragma unroll
          for (int m = 0; m < 4; ++m) { sa[m] = bldf4(rq, vs, ROWG * 32); sb[m] = bldf4(rq, vs, ROWG * 32 + 16); }
#pragma unroll
          for (int m = 0; m < 4; ++m) rsv[ai][m] = rsqrtf((((sa[m][0] + sa[m][1]) + (sa[m][2] + sa[m][3])) + ((sb[m][0] + sb[m][1]) + (sb[m][2] + sb[m][3]))) * (1.0f / QL) + EPS) * QSCALE; }
        asm volatile("" ::: "memory");
        if (pn < 8) {
            const unsigned vo = (unsigned)lr * PQ + (unsigned)(2 * pn * DQK + cl) * 2u;
            FOR_AI_M { const float rs = rsv[ai][m];
#pragma unroll
                for (int bj = 0; bj < 2; ++bj) bst8(rb, vo, ROWG * PQ + bj * DQK * 2, acc[ai][bj][m][0] * rs, acc[ai][bj][m][1] * rs); }
        } else {
            const rsrc_t rc = mk_rsrc(cosT + r0 * 32, 256 * 128), rs_ = mk_rsrc(sinT + r0 * 32, 256 * 128);
            const unsigned vo = (unsigned)lr * PQ + (unsigned)((4 * (pn - 8) + wc) * DQK + 128 + 8 * fq) * 2u, vt = (unsigned)(lr * 32 + 8 * fq) * 4u;
#pragma unroll
            for (int h4 = 0; h4 < 4; ++h4) { const int ai = h4 >> 1; f32x4 c0[2], c1[2], s0[2], s1[2];
#pragma unroll
                for (int mm = 0; mm < 2; ++mm) { const int m = (h4 & 1) * 2 + mm; c0[mm] = bldf4(rc, vt, ROWG * 128); c1[mm] = bldf4(rc, vt, ROWG * 128 + 16); s0[mm] = bldf4(rs_, vt, ROWG * 128); s1[mm] = bldf4(rs_, vt, ROWG * 128 + 16); }
                asm volatile("" ::: "memory");
#pragma unroll
                for (int mm = 0; mm < 2; ++mm) { const int m = (h4 & 1) * 2 + mm; const float rs = rsv[ai][m];
                    const f32x4 x10 = acc[ai][0][m][0] * rs, x11 = acc[ai][0][m][1] * rs, x20 = acc[ai][1][m][0] * rs, x21 = acc[ai][1][m][1] * rs;
                    bst8(rb, vo, ROWG * PQ, x10 * c0[mm] - x20 * s0[mm], x11 * c1[mm] - x21 * s1[mm]);
                    bst8(rb, vo, ROWG * PQ + 64, x10 * s0[mm] + x20 * c0[mm], x11 * s1[mm] + x21 * c1[mm]); }
                asm volatile("" ::: "memory"); }
        }
    }
};
struct EpiKV { EPI_HDR
    bf16* KV; const float* ssqkv;
    __device__ __forceinline__ void operator()(EPI_ARGS) const {
        const int lr = wr * 64 + fr, cl = wc * 32 + 8 * fq; const size_t r0 = (size_t)u.pm * 256;
        const rsrc_t rq = mk_rsrc(ssqkv + r0 * 4, 256 * 16), rb = mk_rsrc(KV + r0 * 4096 + u.pn * 256, TILE_BYTES(8192));
        const unsigned vs = (unsigned)lr * 16u, vo = (unsigned)(lr * 4096 + cl) * 2u;
        f32x4 sa[2][4];
        FOR_AI_M sa[ai][m] = bldf4(rq, vs, ROWG * 16);
        asm volatile("" ::: "memory");
        FOR_AI_M { const float rs = rsqrtf(((sa[ai][m][0] + sa[ai][m][1]) + (sa[ai][m][2] + sa[ai][m][3])) * (1.0f / KVL) + EPS);
#pragma unroll
            for (int bj = 0; bj < 2; ++bj) bst8(rb, vo, ROWG * 8192 + bj * 256, acc[ai][bj][m][0] * rs, acc[ai][bj][m][1] * rs); }
    }
};
struct EpiWo { EPI_HDR
    bf16* GA;
    __device__ __forceinline__ void operator()(EPI_ARGS) const {
        const int lr = wr * 64 + fr, cl = wc * 32 + 8 * fq; const size_t r0 = (size_t)u.pm * 256;
        const rsrc_t rb = mk_rsrc(GA + r0 * DM + u.pn * 256, TILE_BYTES(DM * 2)); const unsigned vo = (unsigned)(lr * DM + cl) * 2u;
        u32x4 gw[2][4][2];
        FOR_AI_M {
#pragma unroll
            for (int bj = 0; bj < 2; ++bj) gw[ai][m][bj] = __builtin_amdgcn_raw_buffer_load_b128(rb, vo, ROWG * DM * 2 + bj * 256, 0); }
        asm volatile("" ::: "memory");
        FOR_AI_M {
#pragma unroll
            for (int bj = 0; bj < 2; ++bj) { const u32x4 w = gw[ai][m][bj];
                const f32x4 g0 = {bflo(w.x), bfhi(w.x), bflo(w.y), bfhi(w.y)}, g1 = {bflo(w.z), bfhi(w.z), bflo(w.w), bfhi(w.w)};
                bst8(rb, vo, ROWG * DM * 2 + bj * 256, g0 * acc[ai][bj][m][0], g1 * acc[ai][bj][m][1]); } }
    }
};
struct EpiGlu { EPI_HDR
    bf16 *GA, *GB; const float* bglu;
    __device__ __forceinline__ void operator()(EPI_ARGS) const {
        const int lr = wr * 64 + fr, j0 = u.pn * 128 + wc * 32 + 8 * fq; const size_t r0 = (size_t)u.pm * 256;
        const rsrc_t ra = mk_rsrc(GA + r0 * DM, TILE_BYTES(DM * 2)), rb = mk_rsrc(GB + r0 * DM, TILE_BYTES(DM * 2)); const unsigned vo = (unsigned)(lr * DM + j0) * 2u;
        const f32x4 bv0 = *(const f32x4*)(bglu + j0), bv1 = *(const f32x4*)(bglu + j0 + 4), bg0 = *(const f32x4*)(bglu + DM + j0), bg1 = *(const f32x4*)(bglu + DM + j0 + 4);
        u32x4 mw[2][4], qw[2][4];
        FOR_AI_M { mw[ai][m] = __builtin_amdgcn_raw_buffer_load_b128(ra, vo, ROWG * DM * 2, 0); qw[ai][m] = __builtin_amdgcn_raw_buffer_load_b128(rb, vo, ROWG * DM * 2, 0); }
        asm volatile("" ::: "memory");
        FOR_AI_M {
            f32x4 v0 = acc[ai][0][m][0] + bv0, v1 = acc[ai][0][m][1] + bv1, g0 = acc[ai][1][m][0] + bg0, g1 = acc[ai][1][m][1] + bg1;
#pragma unroll
            for (int e = 0; e < 4; ++e) { v0[e] *= sigm(g0[e]); v1[e] *= sigm(g1[e]); }
            const u32x4 a = mw[ai][m], b = qw[ai][m];
            const f32x4 m0 = {bflo(a.x), bfhi(a.x), bflo(a.y), bfhi(a.y)}, m1 = {bflo(a.z), bfhi(a.z), bflo(a.w), bfhi(a.w)}, q0 = {bflo(b.x), bfhi(b.x), bflo(b.y), bfhi(b.y)}, q1 = {bflo(b.z), bfhi(b.z), bflo(b.w), bfhi(b.w)};
            bst8(ra, vo, ROWG * DM * 2, m0 + q0 * v0, m1 + q1 * v1); }
    }
};
struct EpiPlain { EPI_HDR
    bf16* O;
    __device__ __forceinline__ void operator()(EPI_ARGS) const {
        const int lr = wr * 64 + fr, cl = wc * 32 + 8 * fq; const size_t r0 = (size_t)u.pm * 256;
        const rsrc_t rb = mk_rsrc(O + r0 * DM + u.pn * 256, TILE_BYTES(DM * 2)); const unsigned vo = (unsigned)(lr * DM + cl) * 2u;
        FOR_AI_M {
#pragma unroll
            for (int bj = 0; bj < 2; ++bj) bst8(rb, vo, ROWG * DM * 2 + bj * 256, acc[ai][bj][m][0], acc[ai][bj][m][1]); }
    }
};
struct EpiSwiGlu { EPI_HDR
    bf16* HID; const float* rsr;
    __device__ __forceinline__ void operator()(EPI_ARGS) const {
        const int lr = wr * 64 + fr, j0 = u.pn * 128 + wc * 32 + 8 * fq; const size_t r0 = (size_t)u.pm * 256;
        const rsrc_t rb = mk_rsrc(HID + r0 * FF, TILE_BYTES(FF * 2)); const unsigned vo = (unsigned)(lr * FF + j0) * 2u;
        RS_LOAD(rsr);
        FOR_AI_M {
            f32x4 g0 = acc[ai][0][m][0] * rsv[ai][m], g1 = acc[ai][0][m][1] * rsv[ai][m];
#pragma unroll
            for (int e = 0; e < 4; ++e) { g0[e] *= sigm(g0[e]); g1[e] *= sigm(g1[e]); }
            bst8(rb, vo, ROWG * FF * 2, g0 * (acc[ai][1][m][0] * rsv[ai][m]), g1 * (acc[ai][1][m][1] * rsv[ai][m])); }
    }
};

template <class Epi> __device__ __forceinline__ void run_gemm(Ctx& C, const bf16* A, const bf16* Bt, int N, int K, const Epi& E) {
    int Kv = K, Nv = N; asm volatile("" : "+s"(Kv), "+s"(Nv));
    pg8::Gemm g{A, Bt, T, Nv, Kv}; pg8::StaticOrder S; S.init(T, Nv, C.G, C.bid);
    pg8::gemm_phase<Epi, pg8::StaticOrder, MK_ALIGN, MK_SP2>(C.lds, g, S, E);
}

__device__ __forceinline__ void row_pass(const float* xin, const bf16* delta, const float* wpost, float* xout, const float* wpre, bf16* hout, int lane) {
    f32x4 x[8];
#pragma unroll
    for (int j = 0; j < 8; ++j) x[j] = ((const f32x4*)xin)[64 * j + lane];
    if (delta) {
        f32x4 d[8]; float s = 0.f;
#pragma unroll
        for (int j = 0; j < 8; ++j) { const u32x2 w = ((const u32x2*)delta)[64 * j + lane]; d[j] = (f32x4){bflo(w.x), bfhi(w.x), bflo(w.y), bfhi(w.y)};
            s += (d[j][0] * d[j][0] + d[j][1] * d[j][1]) + (d[j][2] * d[j][2] + d[j][3] * d[j][3]); }
        const float rs = rsqrtf(wave_sum(s) * (1.0f / DM) + EPS);
#pragma unroll
        for (int j = 0; j < 8; ++j) { const f32x4 w = ((const f32x4*)wpost)[64 * j + lane]; x[j] = x[j] + d[j] * rs * w; }
        if (xout) {
#pragma unroll
            for (int j = 0; j < 8; ++j) ((f32x4*)xout)[64 * j + lane] = x[j]; }
    }
    if (hout) {
        float s = 0.f;
#pragma unroll
        for (int j = 0; j < 8; ++j) s += (x[j][0] * x[j][0] + x[j][1] * x[j][1]) + (x[j][2] * x[j][2] + x[j][3] * x[j][3]);
        const float rs = rsqrtf(wave_sum(s) * (1.0f / DM) + EPS);
#pragma unroll
        for (int j = 0; j < 8; ++j) { const f32x4 w = ((const f32x4*)wpre)[64 * j + lane]; const f32x4 h = x[j] * rs * w;
            u32x2 o; o.x = cvt_pk_bf16(h[0], h[1]); o.y = cvt_pk_bf16(h[2], h[3]); ((u32x2*)hout)[64 * j + lane] = o; }
    }
}

template <int MODE>
__device__ __forceinline__ void row_phase(Ctx& C, const float* xf, const bf16* xb, const bf16* delta, const float* wpost, bf16* xo, float* of, float* rso) {
    const int lane = C.lane, rpb = T / C.G, row0 = C.bid * rpb;
    LAS unsigned* ctr = (LAS unsigned*)(C.lds + MISC_OFF + 64);
    if (C.tid == 0) *ctr = 0u;
    LDS_WAIT(); __syncthreads();
#define ROW_GRAB(dst) do { unsigned v_ = 0; if (lane == 0) v_ = __hip_atomic_fetch_add(ctr, 1u, __ATOMIC_RELAXED, __HIP_MEMORY_SCOPE_WORKGROUP); dst = (int)__builtin_amdgcn_readfirstlane(v_); } while (0)
#define ROW_LOAD(R, mrow) do { const size_t m_ = (size_t)(mrow); _Pragma("unroll") for (int j = 0; j < 4; ++j) { \
        if (MODE == 0) { R[2 * j] = __builtin_nontemporal_load(((const u32x4*)(xf + m_ * DM)) + (64 * j + lane) * 2); R[2 * j + 1] = __builtin_nontemporal_load(((const u32x4*)(xf + m_ * DM)) + (64 * j + lane) * 2 + 1); } \
        else { R[j] = __builtin_nontemporal_load(((const u32x4*)(xb + m_ * DM)) + 64 * j + lane); R[4 + j] = __builtin_nontemporal_load(((const u32x4*)(delta + m_ * DM)) + 64 * j + lane); } } } while (0)
    f32x4 wp[8];
#pragma unroll
    for (int j = 0; j < 4; ++j) { wp[2 * j] = MODE ? ((const f32x4*)wpost)[(64 * j + lane) * 2] : (f32x4){0.f, 0.f, 0.f, 0.f}; wp[2 * j + 1] = MODE ? ((const f32x4*)wpost)[(64 * j + lane) * 2 + 1] : (f32x4){0.f, 0.f, 0.f, 0.f}; }
    u32x4 raw[8]; int cur, nxt; ROW_GRAB(cur);
    if (cur < rpb) ROW_LOAD(raw, row0 + cur);
    while (cur < rpb) {
        ROW_GRAB(nxt);
        u32x4 rn[8];
        if (nxt < rpb) ROW_LOAD(rn, row0 + nxt);
        else {
#pragma unroll
            for (int j = 0; j < 8; ++j) rn[j] = (u32x4){0u, 0u, 0u, 0u}; }
        const size_t m = (size_t)(row0 + cur);
        f32x4 x[8];
        if (MODE == 0) {
#pragma unroll
            for (int j = 0; j < 8; ++j) x[j] = __builtin_bit_cast(f32x4, raw[j]);
        } else {
            f32x4 d[8]; float s = 0.f;
#pragma unroll
            for (int j = 0; j < 4; ++j) { const u32x4 xw = raw[j], dw = raw[4 + j];
                x[2 * j] = (f32x4){bflo(xw.x), bfhi(xw.x), bflo(xw.y), bfhi(xw.y)}; x[2 * j + 1] = (f32x4){bflo(xw.z), bfhi(xw.z), bflo(xw.w), bfhi(xw.w)};
                d[2 * j] = (f32x4){bflo(dw.x), bfhi(dw.x), bflo(dw.y), bfhi(dw.y)}; d[2 * j + 1] = (f32x4){bflo(dw.z), bfhi(dw.z), bflo(dw.w), bfhi(dw.w)}; }
#pragma unroll
            for (int j = 0; j < 8; ++j) s += (d[j][0] * d[j][0] + d[j][1] * d[j][1]) + (d[j][2] * d[j][2] + d[j][3] * d[j][3]);
            const float rs = rsqrtf(wave_sum(s) * (1.0f / DM) + EPS);
#pragma unroll
            for (int j = 0; j < 8; ++j) x[j] = x[j] + d[j] * rs * wp[j];
        }
        if (MODE == 2) {
#pragma unroll
            for (int j = 0; j < 4; ++j) { __builtin_nontemporal_store(x[2 * j], ((f32x4*)(of + m * DM)) + (64 * j + lane) * 2); __builtin_nontemporal_store(x[2 * j + 1], ((f32x4*)(of + m * DM)) + (64 * j + lane) * 2 + 1); }
        } else {
            float s = 0.f;
#pragma unroll
            for (int j = 0; j < 4; ++j) { u32x4 o; o.x = cvt_pk_bf16(x[2 * j][0], x[2 * j][1]); o.y = cvt_pk_bf16(x[2 * j][2], x[2 * j][3]); o.z = cvt_pk_bf16(x[2 * j + 1][0], x[2 * j + 1][1]); o.w = cvt_pk_bf16(x[2 * j + 1][2], x[2 * j + 1][3]);
                ((u32x4*)(xo + m * DM))[64 * j + lane] = o;
                const float a0 = bflo(o.x), a1 = bfhi(o.x), a2 = bflo(o.y), a3 = bfhi(o.y), a4 = bflo(o.z), a5 = bfhi(o.z), a6 = bflo(o.w), a7 = bfhi(o.w);
                s += ((a0 * a0 + a1 * a1) + (a2 * a2 + a3 * a3)) + ((a4 * a4 + a5 * a5) + (a6 * a6 + a7 * a7)); }
            const float rs = rsqrtf(wave_sum(s) * (1.0f / DM) + EPS);
            if (lane == 0) rso[m] = rs;
        }
#pragma unroll
        for (int j = 0; j < 8; ++j) raw[j] = rn[j];
        cur = nxt;
    }
#undef ROW_LOAD
#undef ROW_GRAB
}

__device__ __forceinline__ void tr_item(const float* src, int lds_, bf16* dst, int ldd, const float* ksc, LAS float* scr, int lane) {
    float tv[32];
#pragma unroll
    for (int i = 0; i < 32; ++i) { const int kk = 2 * i + (lane >> 5); tv[i] = src ? __builtin_nontemporal_load(src + (size_t)kk * lds_ + (lane & 31)) : 0.f; }
#pragma unroll
    for (int i = 0; i < 32; ++i) { const int kk = 2 * i + (lane >> 5); float v = tv[i]; if (ksc) v *= ksc[kk]; scr[kk * 33 + (lane & 31)] = v; }
    LDS_WAIT(); asm volatile("" ::: "memory");
    const int c = lane & 7;
#pragma unroll
    for (int j = 0; j < 4; ++j) { const int n = (lane >> 3) + 8 * j; const LAS float* s = scr + (8 * c) * 33 + n;
        u32x4 o; o.x = pk2(s[0 * 33], s[1 * 33]); o.y = pk2(s[2 * 33], s[3 * 33]); o.z = pk2(s[4 * 33], s[5 * 33]); o.w = pk2(s[6 * 33], s[7 * 33]);
        *(u32x4*)(dst + (size_t)n * ldd + 8 * c) = o; }
    LDS_WAIT(); asm volatile("" ::: "memory");
}
constexpr int IT_WIN = 32 * 192, IT_WUQ = 8 * 96, IT_WUKV = 4 * 128, IT_WO = 32 * 64, IT_WGLU = 16 * 128, IT_WOUT = 32 * 64, IT_WGU = 32 * 352, IT_WDN = 88 * 64;
constexpr int IT_ALL = IT_WIN + IT_WUQ + IT_WUKV + IT_WO + IT_WGLU + IT_WOUT + IT_WGU + IT_WDN;
__device__ __forceinline__ void convert_weights(Ctx& C, int l) {
    LAS float* scr = (LAS float*)(C.lds + C.wave * 16384);
    const int gw = C.bid * NWAVES + C.wave, NGW = C.G * NWAVES, lane = C.lane;
    for (int it = gw; it < IT_ALL; it += NGW) {
        int r = it; const float* src; int lds_; bf16* dst; int ldd; const float* ksc = nullptr;
        if (r < IT_WIN) { const int kb = r / 192, nb = r % 192, n0 = nb * 32, k0 = kb * 64; int sc = -1;
            if (n0 < 768) sc = n0; else if (n0 < 5888) sc = n0 + 64; else if (n0 == 5888) sc = 768; else if (n0 == 5888 + 128) sc = 800;
            const float* W = C_in(I_WIN) + (size_t)l * DM * INW;
            src = sc >= 0 ? W + (size_t)k0 * INW + sc : nullptr; lds_ = INW; dst = C_Win + (size_t)n0 * DM + k0; ldd = DM; ksc = C_in(I_PREMIX) + l * DM + k0; }
        else if ((r -= IT_WIN) < IT_WUQ) { const int kb = r / 96, nb = r % 96, n0 = nb * 32, k0 = kb * 64; int sc;
            if (n0 < 2048) sc = (n0 >> 7) * DQK + (n0 & 127); else { const int rr = n0 - 2048, t = rr >> 8, c = rr & 255, bj = c >> 7, hh = (c & 127) >> 5; sc = (4 * t + hh) * DQK + 128 + bj * 32; }
            const float* W = C_in(I_WUQ) + (size_t)l * QL * (NH * DQK);
            src = W + (size_t)k0 * (NH * DQK) + sc; lds_ = NH * DQK; dst = C_Wuq + (size_t)n0 * QL + k0; ldd = QL; ksc = C_in(I_QNORM) + l * QL + k0; }
        else if ((r -= IT_WUQ) < IT_WUKV) { const int kb = r / 128, nb = r % 128, n0 = nb * 32, k0 = kb * 64;
            const float* W = C_in(I_WUKV) + (size_t)l * KVL * 4096;
            src = W + (size_t)k0 * 4096 + n0; lds_ = 4096; dst = C_Wukv + (size_t)n0 * KVL + k0; ldd = KVL; ksc = C_in(I_KVNORM) + l * KVL + k0; }
        else if ((r -= IT_WUKV) < IT_WO) { const int kb = r / 64, nb = r % 64, n0 = nb * 32, k0 = kb * 64;
            const float* W = C_in(I_WO) + (size_t)l * DM * DM;
            src = W + (size_t)k0 * DM + n0; lds_ = DM; dst = C_Wo + (size_t)n0 * DM + k0; ldd = DM; }
        else if ((r -= IT_WO) < IT_WGLU) { const int kb = r / 128, nb = r % 128, n0 = nb * 32, k0 = kb * 64; const int t = n0 >> 8, bj = (n0 >> 7) & 1, i0 = n0 & 127;
            const float* W = C_in(I_WGLU) + (size_t)l * SW * 4096;
            src = W + (size_t)k0 * 4096 + bj * DM + t * 128 + i0; lds_ = 4096; dst = C_Wglu + (size_t)n0 * SW + k0; ldd = SW; }
        else if ((r -= IT_WGLU) < IT_WOUT) { const int kb = r / 64, nb = r % 64, n0 = nb * 32, k0 = kb * 64;
            const float* W = C_in(I_WOUT) + (size_t)l * DM * DM;
            src = W + (size_t)k0 * DM + n0; lds_ = DM; dst = C_Wout + (size_t)n0 * DM + k0; ldd = DM; }
        else if ((r -= IT_WOUT) < IT_WGU) { const int kb = r / 352, nb = r % 352, n0 = nb * 32, k0 = kb * 64; const int t = n0 >> 8, bj = (n0 >> 7) & 1, i0 = n0 & 127;
            const float* W = (bj ? C_in(I_WFU) : C_in(I_WFG)) + (size_t)l * DM * FF;
            src = W + (size_t)k0 * FF + t * 128 + i0; lds_ = FF; dst = C_Wgu + (size_t)n0 * DM + k0; ldd = DM; ksc = C_in(I_PREFFN) + l * DM + k0; }
        else { r -= IT_WGU; const int kb = r / 64, nb = r % 64, n0 = nb * 32, k0 = kb * 64;
            const float* W = C_in(I_WFD) + (size_t)l * FF * DM;
            src = W + (size_t)k0 * DM + n0; lds_ = DM; dst = C_Wdn + (size_t)n0 * FF + k0; ldd = FF; }
        tr_item(src, lds_, dst, ldd, ksc, scr, lane);
    }
}

__device__ __forceinline__ void rope_tables(Ctx& C) {
    const int* pos = (const int*)C_in(I_POS); float* cT = C_cosT; float* sT = C_sinT;
    for (int i = C.bid * 512 + C.tid; i < T * 32; i += C.G * 512) { const int row = i >> 5, k = i & 31;
        const float inv = __builtin_amdgcn_exp2f(-(float)k * (13.287712379549449f / 32.0f));
        const float ang = (float)pos[row] * inv;
        cT[i] = cosf(ang); sT[i] = sinf(ang); }
}
__device__ __forceinline__ void ssm_lp(Ctx& C, int l) {
    const float* are = C_in(I_ARE) + l * SG * SN; const float* aim = C_in(I_AIM) + l * SG * SN; const float* ldt = C_in(I_LOGDT) + l * SG; f32x2* LPp = C_LP; f32x2* FBp = C_FB;
    for (int i = C.bid * 512 + C.tid; i < SG * 65 * SN; i += C.G * 512) { const int n = i & 63, d = (i >> 6) % 65, g = i / (65 * 64);
        const float dt = expf(ldt[g]), ar = are[g * SN + n], ai = aim[g * SN + n];
        const float e = expf((float)d * (ar * dt)), ang = (float)d * (ai * dt); const float s = sinf(ang), c = cosf(ang);
        LPp[i] = (f32x2){e * c, e * s};
        if (d == 1) { const float lr = e * c, li = e * s, nr = lr - 1.0f, den = ar * ar + ai * ai;
            FBp[g * SN + n] = (f32x2){(nr * ar + li * ai) / den, (li * ar - nr * ai) / den}; } }
}
__device__ __forceinline__ void ssm_tables(Ctx& C, int l) {
    const float* bre = C_in(I_BRE) + (size_t)l * SG * SN * SP; const float* bim = C_in(I_BIM) + (size_t)l * SG * SN * SP;
    const float* cre = C_in(I_CRE) + (size_t)l * SG * SP * SN; const float* cim = C_in(I_CIM) + (size_t)l * SG * SP * SN; const float* dsk_ = C_in(I_SSMD) + l * SW;
    const int gt = C.bid * 512 + C.tid, NT_ = C.G * 512;
    { LAS float* LC = (LAS float*)C.lds; LAS float* LB = LC + 2048; LAS float* LL = LB + 2048; bf16* KDp = C_KD; const f32x2* LPp = C_LP; const f32x2* FBp = C_FB;
      for (int unit = C.bid; unit < SG * 4; unit += C.G) { const int g = unit >> 2, d0 = (unit & 3) * 17, nd = (65 - d0) < 17 ? (65 - d0) : 17;
        for (int i = C.tid; i < 1024; i += NWAVES * 64) { const int n = i >> 4, p = i & 15; const f32x2 f = FBp[g * SN + n]; const float br = bre[(g * SN + n) * SP + p], bi = bim[(g * SN + n) * SP + p];
            LC[2 * i] = cre[(g * SP + p) * SN + n]; LC[2 * i + 1] = cim[(g * SP + p) * SN + n]; LB[2 * i] = f.x * br - f.y * bi; LB[2 * i + 1] = f.x * bi + f.y * br; }
        for (int i = C.tid; i < nd * 64; i += NWAVES * 64) { const int dd = d0 + (i >> 6), n = i & 63; f32x2 L = {0.f, 0.f}; if (dd > 0) L = LPp[(size_t)(g * 65 + dd - 1) * 64 + n]; LL[2 * i] = L.x; LL[2 * i + 1] = L.y; }
        LDS_WAIT(); __syncthreads();
        const int p = (C.tid >> 4) & 15, pp = C.tid & 15, half = C.tid >> 8; float acc[9];
#pragma unroll
        for (int k = 0; k < 9; ++k) acc[k] = 0.f;
        for (int n = 0; n < SN; ++n) { const float cr = LC[(n * 16 + p) * 2], ci = LC[(n * 16 + p) * 2 + 1], br = LB[(n * 16 + pp) * 2], bi = LB[(n * 16 + pp) * 2 + 1];
            const float wr_ = cr * br - ci * bi, wi_ = cr * bi + ci * br;
#pragma unroll
            for (int k = 0; k < 9; ++k) { const int dl = half * 9 + k, dc = dl < nd ? dl : nd - 1;
                acc[k] += wr_ * LL[(dc * 64 + n) * 2] - wi_ * LL[(dc * 64 + n) * 2 + 1]; } }
#pragma unroll
        for (int k = 0; k < 9; ++k) { const int dl = half * 9 + k; if (dl < nd) { float v = acc[k]; if (d0 + dl == 1 && p == pp) v += dsk_[g * 16 + p];
                KDp[(size_t)g * (65 * 256) + (d0 + dl) * 256 + p * 16 + pp] = (bf16)f2bf(v); } }
        LDS_WAIT(); __syncthreads(); } }
    for (int i = gt; i < SG * 16 * 128; i += NT_) { const int ncol = i & 127, jb = (i >> 7) & 15, g = i >> 11, n = ncol & 63, part = ncol >> 6;
        const f32x2 f = C_FB[g * SN + n]; float Br[16], Bi[16]; f32x2 L[4];
#pragma unroll
        for (int k = 0; k < 4; ++k) L[k] = C_LP[(size_t)(g * 65 + 63 - (jb * 4 + k)) * 64 + n];
#pragma unroll
        for (int pp = 0; pp < 16; ++pp) { const float br = bre[(g * SN + n) * SP + pp], bi = bim[(g * SN + n) * SP + pp]; Br[pp] = f.x * br - f.y * bi; Bi[pp] = f.x * bi + f.y * br; }
#pragma unroll
        for (int k = 0; k < 4; ++k) { float o[16];
#pragma unroll
            for (int pp = 0; pp < 16; ++pp) o[pp] = part ? (L[k].x * Bi[pp] + L[k].y * Br[pp]) : (L[k].x * Br[pp] - L[k].y * Bi[pp]);
            u32x4 w0, w1; w0.x = pk2(o[0], o[1]); w0.y = pk2(o[2], o[3]); w0.z = pk2(o[4], o[5]); w0.w = pk2(o[6], o[7]); w1.x = pk2(o[8], o[9]); w1.y = pk2(o[10], o[11]); w1.z = pk2(o[12], o[13]); w1.w = pk2(o[14], o[15]);
            u32x4* dst = (u32x4*)(C_MAT + ((size_t)((g * 64 + jb * 4 + k) * 128 + ncol)) * 16); dst[0] = w0; dst[1] = w1; } }
    for (int i = gt; i < SG * 8 * 16 * 16; i += NT_) { const int p = i & 15, jb = (i >> 4) & 15, kk = (i >> 8) & 7, g = i >> 11, n0 = (kk & 3) * 16, part = kk >> 2;
        float cr[16], ci[16];
#pragma unroll
        for (int k = 0; k < 16; ++k) { cr[k] = cre[(g * SP + p) * SN + n0 + k]; ci[k] = cim[(g * SP + p) * SN + n0 + k]; }
#pragma unroll 2
        for (int k2 = 0; k2 < 4; ++k2) { const int j = jb * 4 + k2; float o[16]; const f32x2* Lr = C_LP + (size_t)(g * 65 + j + 1) * 64 + n0;
#pragma unroll
            for (int k = 0; k < 16; ++k) { const f32x2 L = Lr[k]; o[k] = part ? -(cr[k] * L.y + ci[k] * L.x) : (cr[k] * L.x - ci[k] * L.y); }
            u32x4 w0, w1; w0.x = pk2(o[0], o[1]); w0.y = pk2(o[2], o[3]); w0.z = pk2(o[4], o[5]); w0.w = pk2(o[6], o[7]); w1.x = pk2(o[8], o[9]); w1.y = pk2(o[10], o[11]); w1.z = pk2(o[12], o[13]); w1.w = pk2(o[14], o[15]);
            u32x4* dst = (u32x4*)(C_CCT + ((size_t)(((g * 8 + kk) * 64 + j) * 16 + p)) * 16); dst[0] = w0; dst[1] = w1; } }
}

__device__ __forceinline__ int crow(int r, int hi) { return (r & 3) + 8 * (r >> 2) + 4 * hi; }
__device__ __forceinline__ f32x16 mfma32(bf16x8 a, bf16x8 b, f32x16 c) { return __builtin_amdgcn_mfma_f32_32x32x16_bf16(a, b, c, 0, 0, 0); }
__device__ __forceinline__ void ssm_states(Ctx& C) {
    const int lane = C.lane, r32 = lane & 31, hi = lane >> 5, mt = C.wave >> 2, nblk = C.wave & 3;
    LAS float* SL = (LAS float*)C.lds;
    for (int unit = C.bid; unit < SG * BATCH; unit += C.G) { const int g = unit >> 3, b = unit & 7;
        f32x16 acc = {};
        const bf16* ap = C_U + ((size_t)(b * SEQ + (32 * mt + r32) * 64)) * SW + g * 16 + hi * 8;
        const bf16* bp = C_MAT + ((size_t)(g * 64) * 128 + nblk * 32 + r32) * 16 + hi * 8;
#pragma unroll 8
        for (int j = 0; j < 64; ++j) { const bf16x8 a = *(const bf16x8*)(ap + (size_t)j * SW), bb = *(const bf16x8*)(bp + (size_t)j * 128 * 16); acc = mfma32(a, bb, acc); }
#pragma unroll
        for (int r = 0; r < 16; ++r) SL[(32 * mt + crow(r, hi)) * 128 + 32 * nblk + r32] = acc[r];
        LDS_WAIT(); __syncthreads();
        if (C.tid < 64) { const int n = C.tid; const f32x2 lam = C_LP[(size_t)(g * 65 + 64) * 64 + n]; float xr = 0.f, xi = 0.f;
            bf16* xp = C_XST + ((size_t)(b * 64) * 64 + g) * 128 + n;
            for (int c = 0; c < 64; ++c) { xp[(size_t)c * 64 * 128] = (bf16)f2bf(xr); xp[(size_t)c * 64 * 128 + 64] = (bf16)f2bf(xi);
                const float sr = SL[c * 128 + n], si = SL[c * 128 + 64 + n]; const float nr = lam.x * xr - lam.y * xi + sr, ni = lam.x * xi + lam.y * xr + si; xr = nr; xi = ni; } }
        LDS_WAIT(); __syncthreads();
    }
}
#ifndef REPS3
#define REPS3 1
#endif
__device__ __forceinline__ float gelu_tanh(float y) { return y * sigm(1.5957691216057308f * (y + 0.044715f * y * y * y)); }
__device__ __forceinline__ void ssm_outputs(Ctx& C, int l) {
    const int lane = C.lane, r32 = lane & 31, hi = lane >> 5, half = C.wave & 1;
    for (int unit = C.bid; unit < 16 * 16; unit += C.G) { const int gb = unit >> 4, mt = unit & 15, g = 4 * gb + (C.wave >> 1), b = mt >> 1, c0 = 32 * (mt & 1);
        const bf16* up = C_U + ((size_t)(b * SEQ + (c0 + r32) * 64)) * SW + g * 16 + hi * 8;
        const bf16* xp = C_XST + ((size_t)((b * 64 + c0 + r32) * 64 + g)) * 128 + hi * 8;
        { const u32x4* src = (const u32x4*)(C_KD + (size_t)(4 * gb) * (65 * 256)); LAS u32x4* dstl = (LAS u32x4*)C.lds;
          for (int i = C.tid; i < KD_LDS_BYTES / 16; i += NWAVES * 64) dstl[i] = src[i];
          LDS_WAIT(); __syncthreads(); }
        const LAS bf16* kd = (const LAS bf16*)C.lds + (size_t)(C.wave >> 1) * (65 * 256) + r32 * 16 + hi * 8;
        const bf16* cc = C_CCT + ((size_t)(g * 8) * 1024 + r32) * 16 + hi * 8;
        for (int s2 = 0; s2 < 2; ++s2) { const int sp = half ? (2 - s2) : (s2 ? 0 : 3);
            f32x16 acc[8];
_Pragma("unroll")
            for (int rep_ = 0; rep_ < REPS3; ++rep_) {
#pragma unroll
            for (int nb = 0; nb < 8; ++nb) acc[nb] = (f32x16){};
            {
                bf16x8 aA, aB, bA[8], bB[8];
#define S3C_LOAD(a_, b_, kk_) do { a_ = *(const bf16x8*)(xp + (kk_) * 16); _Pragma("unroll") for (int nb = 0; nb < 8; ++nb) b_[nb] = *(const bf16x8*)(cc + ((size_t)(kk_) * 1024 + (16 * sp + 2 * nb) * 16) * 16); } while (0)
#define S3C_MMA(a_, b_) do { _Pragma("unroll") for (int nb = 0; nb < 8; ++nb) acc[nb] = mfma32(a_, b_[nb], acc[nb]); } while (0)
                S3C_LOAD(aA, bA, 0);
#pragma unroll 1
                for (int kk = 0; kk < 8; kk += 2) {
                    S3C_LOAD(aB, bB, kk + 1); asm volatile("" ::: "memory");
                    S3C_MMA(aA, bA); asm volatile("" ::: "memory");
                    if (kk + 2 < 8) S3C_LOAD(aA, bA, kk + 2);
                    asm volatile("" ::: "memory");
                    S3C_MMA(aB, bB); asm volatile("" ::: "memory");
                }
#undef S3C_LOAD
#undef S3C_MMA
            }
            const int iend = 16 * sp + 15;
            int i0 = 0;
            for (; i0 + 8 <= 16 * sp; i0 += 8) {
                bf16x8 a8[8];
#pragma unroll
                for (int u = 0; u < 8; ++u) a8[u] = *(const bf16x8*)(up + (size_t)(i0 + u) * SW);
                const LAS bf16* kb = kd + (16 * sp - i0 - 6) * 256;
#pragma unroll
                for (int u = 0; u < 8; ++u) {
#pragma unroll
                    for (int nb = 0; nb < 8; ++nb) { const bf16x8 bb = *(const LAS bf16x8*)(kb + (2 * nb - u + 7) * 256); acc[nb] = mfma32(a8[u], bb, acc[nb]); }
                    __builtin_amdgcn_sched_barrier(0); } }
            for (; i0 <= iend; i0 += 8) {
                bf16x8 a8[8];
#pragma unroll
                for (int u = 0; u < 8; ++u) a8[u] = *(const bf16x8*)(up + (size_t)(i0 + u) * SW);
#pragma unroll
                for (int u = 0; u < 8; ++u) {
#pragma unroll
                    for (int nb = 0; nb < 8; ++nb) { const int d = 16 * sp + 2 * nb - (i0 + u);
                        if (d >= -1) { const bf16x8 bb = *(const LAS bf16x8*)(kd + (d + 1) * 256); acc[nb] = mfma32(a8[u], bb, acc[nb]); } } } }
            }
            {
                const int p = r32 & 15, toff = r32 >> 4;
                const rsrc_t rz = mk_rsrc(C_Z + ((size_t)(b * SEQ + c0 * 64 + 16 * sp)) * SW + g * 16, (unsigned)((31 * 64 + 16) * SW * 2));
                const unsigned vz = (unsigned)((4 * hi * 64 + toff) * SW + p) * 2u;
#pragma unroll
                for (int nb = 0; nb < 8; ++nb)
#pragma unroll
                    for (int r = 0; r < 16; ++r) __builtin_amdgcn_raw_buffer_store_b16((unsigned short)f2bf(gelu_tanh(acc[nb][r])), rz, vz, (((r & 3) + 8 * (r >> 2)) * 64 + 2 * nb) * SW * 2, 0);
            }
        }
        __syncthreads();
    }
}

namespace att {
constexpr int LDQ = NH * DQK, LDKV = 4096, LDO = DM;
constexpr int SHM_V = 16384, SHM_K = 16384, SHM_KP = 8192;
constexpr int OFF_V = 0, OFF_K = 2 * SHM_V, OFF_KP = OFF_K + 2 * SHM_K, OFF_WS = OFF_KP + 2 * SHM_KP, ATT_LDS = OFF_WS + NWAVES * 64 * 4;
constexpr float THRL = 11.5f;
#define KSWZ(row, colB) ((row) * 256 + ((colB) ^ (((row) & 7) << 4)))
#define KPSWZ(row, colB) ((row) * 128 + ((colB) ^ (((row) & 7) << 4)))
#define SBAR() __builtin_amdgcn_sched_barrier(0)
__device__ __forceinline__ void partialSM(f32x16& p0, f32x16& p1, float& m_reg, float& mn, float& alpha, bool dead) {
    if (dead) {
#pragma unroll
        for (int r = 0; r < 16; ++r) { p0[r] = -1e30f; p1[r] = -1e30f; } }
    float pmax = p0[0];
#pragma unroll
    for (int r = 1; r < 16; ++r) pmax = fmaxf(pmax, p0[r]);
#pragma unroll
    for (int r = 0; r < 16; ++r) pmax = fmaxf(pmax, p1[r]);
    { auto rr = __builtin_amdgcn_permlane32_swap(__float_as_uint(pmax), __float_as_uint(pmax), false, false); pmax = fmaxf(__uint_as_float(rr[0]), __uint_as_float(rr[1])); }
    if (__builtin_expect(__all(pmax - m_reg <= THRL), 1)) { mn = m_reg; alpha = 1.f; }
    else { mn = fmaxf(m_reg, pmax); alpha = __builtin_amdgcn_exp2f(m_reg - mn); m_reg = mn; }
#pragma unroll
    for (int r = 0; r < 16; ++r) p0[r] = p0[r] - mn;
#pragma unroll
    for (int r = 0; r < 16; ++r) p1[r] = p1[r] - mn;
#pragma unroll
    for (int r = 0; r < 16; ++r) p0[r] = __builtin_amdgcn_exp2f(p0[r]);
}
__device__ __forceinline__ void finishSM(f32x16& p0, f32x16& p1, float alpha, float& l_reg, bf16x8& pa0, bf16x8& pa1, bf16x8& pa2, bf16x8& pa3) {
#pragma unroll
    for (int r = 0; r < 16; ++r) p1[r] = __builtin_amdgcn_exp2f(p1[r]);
    float ps = 0;
#pragma unroll
    for (int r = 0; r < 16; ++r) ps += p0[r];
#pragma unroll
    for (int r = 0; r < 16; ++r) ps += p1[r];
    { auto rr = __builtin_amdgcn_permlane32_swap(__float_as_uint(ps), __float_as_uint(ps), false, false); ps = __uint_as_float(rr[0]) + __uint_as_float(rr[1]); }
    l_reg = l_reg * alpha + ps;
#define PK4(P, BASE, OUT) do { unsigned a0 = cvt_pk_bf16(P[BASE + 0], P[BASE + 1]), a1 = cvt_pk_bf16(P[BASE + 2], P[BASE + 3]);   \
    unsigned b0 = cvt_pk_bf16(P[BASE + 4], P[BASE + 5]), b1 = cvt_pk_bf16(P[BASE + 6], P[BASE + 7]);                              \
    auto r0 = __builtin_amdgcn_permlane32_swap(a0, b0, false, false); auto r1 = __builtin_amdgcn_permlane32_swap(a1, b1, false, false); \
    u32x4 w = {r0[0], r1[0], r0[1], r1[1]}; OUT = *reinterpret_cast<bf16x8*>(&w); } while (0)
    PK4(p0, 0, pa0); PK4(p0, 8, pa1); PK4(p1, 0, pa2); PK4(p1, 8, pa3);
#undef PK4
}
__device__ __forceinline__ void qkt(f32x16& p0, f32x16& p1, const LAS char* Ks, const LAS char* KPs, const bf16x8* qr, int r32, int hi) {
    p0 = f32x16{}; p1 = f32x16{};
    bf16x8 ka[4], kb[4];
#define QK_LD(F, g) do { _Pragma("unroll") for (int t = 0; t < 2; ++t) { const int d0 = 2 * (g) + t; const LAS char* B_ = d0 < 8 ? Ks : KPs; const int cb = ((d0 & 7) * 16 + hi * 8) * 2; \
        if (d0 < 8) { F[2 * t] = *(const LAS bf16x8*)(B_ + KSWZ(r32, cb)); F[2 * t + 1] = *(const LAS bf16x8*)(B_ + KSWZ(32 + r32, cb)); } \
        else { F[2 * t] = *(const LAS bf16x8*)(B_ + KPSWZ(r32, cb)); F[2 * t + 1] = *(const LAS bf16x8*)(B_ + KPSWZ(32 + r32, cb)); } } } while (0)
#define QK_MM(F, g) do { _Pragma("unroll") for (int t = 0; t < 2; ++t) { p0 = mfma32(F[2 * t], qr[2 * (g) + t], p0); p1 = mfma32(F[2 * t + 1], qr[2 * (g) + t], p1); } } while (0)
#define QK_SB() __builtin_amdgcn_sched_barrier(0)
    QK_LD(ka, 0); QK_SB();
    QK_LD(kb, 1); QK_SB(); QK_MM(ka, 0); QK_SB();
    QK_LD(ka, 2); QK_SB(); QK_MM(kb, 1); QK_SB();
    QK_LD(kb, 3); QK_SB(); QK_MM(ka, 2); QK_SB();
    QK_LD(ka, 4); QK_SB(); QK_MM(kb, 3); QK_SB();
    QK_LD(kb, 5); QK_SB(); QK_MM(ka, 4); QK_SB();
    QK_MM(kb, 5);
#undef QK_LD
#undef QK_MM
#undef QK_SB
}
__device__ __forceinline__ int v_st(int k, int c) { const int kk = (k & ~0xC) | ((k & 4) << 1) | ((k & 8) >> 1); return ((kk >> 3) * 4 + (c >> 5)) * 512 + ((kk & 7) * 32 + (c & 31)) * 2; }
__device__ __forceinline__ int v_rd_base(int lane) { return ((lane & 3) << 3) | (((lane >> 2) & 3) << 6) | (((lane >> 4) & 1) << 5) | (((lane >> 5) & 1) << 8); }
constexpr int v_rd_off(int d0, int ks, int half) { return d0 * 512 + ks * 4096 + half * 2048; }
template <int OFF> __device__ __forceinline__ s16x4 tr_read(int vb) { s16x4 r; asm volatile("ds_read_b64_tr_b16 %0, %1 offset:%2" : "=&v"(r) : "v"(vb), "i"(OFF) : "memory"); return r; }
template <int D0> __device__ __forceinline__ void pv_one(f32x16& od, int vb, bf16x8 pa0, bf16x8 pa1, bf16x8 pa2, bf16x8 pa3) {
    const s16x4 l0 = tr_read<v_rd_off(D0, 0, 0)>(vb), h0 = tr_read<v_rd_off(D0, 0, 1)>(vb), l1 = tr_read<v_rd_off(D0, 1, 0)>(vb), h1 = tr_read<v_rd_off(D0, 1, 1)>(vb);
    const s16x4 l2 = tr_read<v_rd_off(D0, 2, 0)>(vb), h2 = tr_read<v_rd_off(D0, 2, 1)>(vb), l3 = tr_read<v_rd_off(D0, 3, 0)>(vb), h3 = tr_read<v_rd_off(D0, 3, 1)>(vb);
    asm volatile("s_waitcnt lgkmcnt(0)" ::: "memory"); SBAR();
#define PK(L, H) (bf16x8){L[0], L[1], L[2], L[3], H[0], H[1], H[2], H[3]}
    od = mfma32(pa0, PK(l0, h0), od); od = mfma32(pa1, PK(l1, h1), od); od = mfma32(pa2, PK(l2, h2), od); od = mfma32(pa3, PK(l3, h3), od);
#undef PK
}
struct VFrag { s16x4 l0, h0, l1, h1, l2, h2, l3, h3; };
template <int D0> __device__ __forceinline__ void v_issue(VFrag& f, int vb) {
    f.l0 = tr_read<v_rd_off(D0, 0, 0)>(vb); f.h0 = tr_read<v_rd_off(D0, 0, 1)>(vb); f.l1 = tr_read<v_rd_off(D0, 1, 0)>(vb); f.h1 = tr_read<v_rd_off(D0, 1, 1)>(vb);
    f.l2 = tr_read<v_rd_off(D0, 2, 0)>(vb); f.h2 = tr_read<v_rd_off(D0, 2, 1)>(vb); f.l3 = tr_read<v_rd_off(D0, 3, 0)>(vb); f.h3 = tr_read<v_rd_off(D0, 3, 1)>(vb);
}
__device__ __forceinline__ void v_mma(f32x16& od, const VFrag& f, bf16x8 pa0, bf16x8 pa1, bf16x8 pa2, bf16x8 pa3) {
#define PK(L, H) (bf16x8){L[0], L[1], L[2], L[3], H[0], H[1], H[2], H[3]}
    od = mfma32(pa0, PK(f.l0, f.h0), od); od = mfma32(pa1, PK(f.l1, f.h1), od); od = mfma32(pa2, PK(f.l2, f.h2), od); od = mfma32(pa3, PK(f.l3, f.h3), od);
#undef PK
}
#define VF_WAIT(n, f) asm volatile("s_waitcnt lgkmcnt(" #n ")" : "+v"(f.l0), "+v"(f.h0), "+v"(f.l1), "+v"(f.h1), "+v"(f.l2), "+v"(f.h2), "+v"(f.l3), "+v"(f.h3) :: "memory")
__device__ __forceinline__ void pv_d0(f32x16* o, int vb, bf16x8 pa0, bf16x8 pa1, bf16x8 pa2, bf16x8 pa3) {
    VFrag fa, fb;
    v_issue<0>(fa, vb);
    v_issue<1>(fb, vb); VF_WAIT(8, fa); SBAR(); v_mma(o[0], fa, pa0, pa1, pa2, pa3); SBAR();
    v_issue<2>(fa, vb); VF_WAIT(8, fb); SBAR(); v_mma(o[1], fb, pa0, pa1, pa2, pa3); SBAR();
    v_issue<3>(fb, vb); VF_WAIT(8, fa); SBAR(); v_mma(o[2], fa, pa0, pa1, pa2, pa3); SBAR();
    VF_WAIT(0, fb); SBAR(); v_mma(o[3], fb, pa0, pa1, pa2, pa3);
}
__device__ __forceinline__ void attn_unit(const bf16* __restrict__ Q, const bf16* __restrict__ KV, const bf16* __restrict__ KPE, bf16* __restrict__ O, int b, int h, int qb, LAS char* lds) {
    const int tid = pg8::opaque_tid(), wid = __builtin_amdgcn_readfirstlane(tid >> 6), lane = tid & 63, r32 = lane & 31, hi = lane >> 5;
    LAS char* V_lds = lds + OFF_V; LAS char* K_lds = lds + OFF_K; LAS char* KP_lds = lds + OFF_KP;
    LAS float* ws = (LAS float*)(lds + OFF_WS) + wid * 64; LAS float* li_l = ws; LAS float* al_l = ws + 32;
    const bf16* Kh = KV + (size_t)(b * SEQ) * LDKV + h * 256; const bf16* Vh = Kh + 128; const bf16* Pb = KPE + (size_t)(b * SEQ) * 64;
    const int NT = 4 * qb + 4, NTw = 4 * qb + (wid >> 1) + 1;
    float m_reg = -1e30f, l_reg = 0; f32x16 o[4] = {}; bf16x8 qr[12];
    const bf16* Qw = Q + (size_t)(b * SEQ + qb * 256 + wid * 32 + r32) * LDQ + h * DQK + hi * 8;
#pragma unroll
    for (int d0 = 0; d0 < 12; ++d0) qr[d0] = *(const bf16x8*)(Qw + d0 * 16);
    const int sr = tid >> 4, sc = (tid & 15) * 8, vst0 = v_st(sr, sc), vst1 = v_st(32 + sr, sc), pr = tid >> 3, pc = (tid & 7) * 8;
    const int vb0 = (int)(unsigned)(uintptr_t)V_lds + v_rd_base(lane);
    bf16x8 vs0, vs1, ks0, ks1, kp0;
#define SLOAD(k0) do { vs0 = *(const bf16x8*)(Vh + (size_t)((k0) + sr) * LDKV + sc); vs1 = *(const bf16x8*)(Vh + (size_t)((k0) + 32 + sr) * LDKV + sc); \
    ks0 = *(const bf16x8*)(Kh + (size_t)((k0) + sr) * LDKV + sc); ks1 = *(const bf16x8*)(Kh + (size_t)((k0) + 32 + sr) * LDKV + sc); kp0 = *(const bf16x8*)(Pb + (size_t)((k0) + pr) * 64 + pc); } while (0)
#define SWRITE(bb) do { *(LAS bf16x8*)(V_lds + (bb) * SHM_V + vst0) = vs0; *(LAS bf16x8*)(V_lds + (bb) * SHM_V + vst1) = vs1; \
    *(LAS bf16x8*)(K_lds + (bb) * SHM_K + KSWZ(sr, sc * 2)) = ks0; *(LAS bf16x8*)(K_lds + (bb) * SHM_K + KSWZ(32 + sr, sc * 2)) = ks1; \
    *(LAS bf16x8*)(KP_lds + (bb) * SHM_KP + KPSWZ(pr, pc * 2)) = kp0; } while (0)
#define RESC(a) do { if (__any((a) < 1.f)) { if (hi == 0) al_l[r32] = (a); asm volatile("s_waitcnt lgkmcnt(0)" ::: "memory"); \
    _Pragma("unroll") for (int d = 0; d < 4; ++d) _Pragma("unroll") for (int r = 0; r < 16; ++r) o[d][r] *= al_l[crow(r, hi)]; } } while (0)
    f32x16 p0, p1; float mn, al; bf16x8 pa0, pa1, pa2, pa3;
    SLOAD(0); asm volatile("s_waitcnt vmcnt(0)" ::: "memory"); SWRITE(0); __syncthreads();
    for (int j = 0; j < NT; ++j) {
        const int bsel = j & 1;
        if (j + 1 < NT) SLOAD((j + 1) * 64);
        SBAR();
        if (j < NTw) {
            qkt(p0, p1, K_lds + bsel * SHM_K, KP_lds + bsel * SHM_KP, qr, r32, hi);
            partialSM(p0, p1, m_reg, mn, al, false);
            RESC(al);
            finishSM(p0, p1, al, l_reg, pa0, pa1, pa2, pa3); SBAR();
            pv_d0(o, vb0 + bsel * SHM_V, pa0, pa1, pa2, pa3);
        }
        SBAR();
        if (j + 1 < NT) { asm volatile("s_waitcnt vmcnt(0)" ::: "memory"); SWRITE(bsel ^ 1); }
        __syncthreads();
    }
    if (hi == 0) li_l[r32] = l_reg; asm volatile("s_waitcnt lgkmcnt(0)" ::: "memory");
    float rli[16];
#pragma unroll
    for (int r = 0; r < 16; ++r) rli[r] = __builtin_amdgcn_rcpf(li_l[crow(r, hi)]);
    bf16* Ow = O + (size_t)(b * SEQ + qb * 256 + wid * 32) * LDO + h * 128;
#pragma unroll
    for (int r = 0; r < 16; ++r) { const int orow = crow(r, hi);
#pragma unroll
        for (int d0 = 0; d0 < 4; ++d0) Ow[(size_t)orow * LDO + d0 * 32 + r32] = (bf16)f2bf(o[d0][r] * rli[r]); }
    __syncthreads();
#undef SLOAD
#undef SWRITE
#undef RESC
}
}
__device__ __forceinline__ void attn_phase(Ctx& C) {
    const int x = C.bid & 7, idx = C.bid >> 3, per = C.G >> 3;
    for (int p = idx; p < 128; p += per) { const int bh = 16 * x + (p >> 3), pr = p & 7, b = bh >> 4, h = bh & 15;
        att::attn_unit(C_Q, C_KV, C_KPE, C_RA, b, h, 15 - pr, (LAS char*)C.lds);
        att::attn_unit(C_Q, C_KV, C_KPE, C_RA, b, h, pr, (LAS char*)C.lds); }
}

#ifndef DBG_DELTA
#define DBG_DELTA C_RA
#endif
__global__ void __launch_bounds__(NWAVES * 64, 2) mk_fwd(Args args) {
    extern __shared__ __attribute__((aligned(16))) unsigned char lds_raw[];
    Ctx C;
    C.lds = (LAS unsigned char*)lds_raw;
    volatile LAS unsigned* MISC = (volatile LAS unsigned*)(C.lds + MISC_OFF);
    C.tid = threadIdx.x; C.lane = C.tid & 63; C.wave = __builtin_amdgcn_readfirstlane(C.tid >> 6); C.G = gridDim.x; C.bid = blockIdx.x;
    C.ka = (const CAS char*)__builtin_amdgcn_kernarg_segment_ptr(); gu32* ctl = (gu32*)(args.ws + WS_CTL);
    for (int u = C.tid; u < (LDS_BYTES - MISC_OFF) / 4; u += NWAVES * 64) ((LAS unsigned*)(C.lds + MISC_OFF))[u] = 0u;
    __syncthreads();
    const int lo = args.ph_lo, hi = args.ph_hi;
    const bool fused = (hi - lo) > 1;
    XcdBarrier bar; bar.bar = (unsigned*)(ctl + CW_BAR); bar.x = 0; bar.st = nullptr;
    if (fused) bar = xcd_barrier_post((unsigned*)(ctl + CW_BAR), MISC + 8);
#ifndef PH_MASK
#define PH_MASK 0x1FFF
#endif
#define IN(k) ((((PH_MASK) >> ((k) >= DEPTH * 12 ? 12 : (k) % 12)) & 1) && lo <= (k) && (k) < hi)
#define PH_FENCE() do { asm volatile("" : "+s"(C.ka), "+v"(C.tid)); C.lane = C.tid & 63; C.wave = __builtin_amdgcn_readfirstlane(C.tid >> 6); } while (0)
#ifndef PROBE_STAMP
#define PROBE_STAMP 0
#endif
#ifndef PROBE_STAMP_SEL
#define PROBE_STAMP_SEL 0xFFF
#endif
#define STAMP_AT(k) do { if (PROBE_STAMP && C.tid == 0) ((unsigned long long*)(args.ws + 262144))[C.bid * 64 + (k)] = __builtin_amdgcn_s_memrealtime(); } while (0)
#define STAMP2_AT(k) do { if (PROBE_STAMP && C.tid == 0) ((unsigned long long*)(args.ws + 262144 + 131072))[C.bid * 64 + (k)] = __builtin_amdgcn_s_memrealtime(); } while (0)
#define SEAM(k) do { STAMP_AT(k); if ((k) + 1 < hi) { _Pragma("unroll") for (int rb_ = 0; rb_ < REPN(15); ++rb_) { XcdBarrier b2_ = bar; asm volatile("" : "+s"(b2_.bar)); xcd_barrier(b2_); } } STAMP2_AT(k); } while (0)
#ifndef PROBE_REP_MASK
#define PROBE_REP_MASK 0
#endif
#define REPN(k) ((((PROBE_REP_MASK) >> (k)) & 1) ? 2 : 1)
#define gw (C.bid * NWAVES + C.wave)
#define NGW (C.G * NWAVES)

    for (int l = 0; l < DEPTH; ++l) {
        const int pb = l * 12;
        if (IN(pb + 0)) { PH_FENCE();
_Pragma("unroll")
            for (int rep = 0; rep < REPN(12); ++rep) convert_weights(C, l);
_Pragma("unroll")
            for (int rep = 0; rep < REPN(14); ++rep) { ssm_lp(C, l); if (l == 0) rope_tables(C); }
            if (l == 0) { row_phase<0>(C, C_in(I_X), nullptr, nullptr, nullptr, C_XB, nullptr, C_RS1); }
            else { const float* wpost = C_in(I_POSTFFN) + (l - 1) * DM;
                if (REPN(0) > 1) row_phase<1>(C, nullptr, C_XB, C_F, wpost, C_XB2, nullptr, C_RS1);
                row_phase<1>(C, nullptr, C_XB, C_F, wpost, C_XB, nullptr, C_RS1); }
            SEAM(pb + 0);
        }
        if (IN(pb + 1)) { PH_FENCE();
            EpiInProj E{C_CQ, C_CKV, C_KPE, C_U, C_GA, C_GB, C_ssqq, C_ssqkv, C_in(I_BGATE) + l * 2 * DM, C_cosT, C_sinT, C_RS1};
_Pragma("unroll")
            for (int rep = 0; rep < REPN(1); ++rep) run_gemm(C, C_XB, C_Win, NIN, DM, E);
_Pragma("unroll")
            for (int rep = 0; rep < REPN(13); ++rep) ssm_tables(C, l);
            SEAM(pb + 1);
        }
        if (IN(pb + 2)) { PH_FENCE();
_Pragma("unroll")
            for (int rep = 0; rep < REPN(2); ++rep) ssm_states(C);
            if (!fused) SEAM(pb + 2); }
        if (IN(pb + 3)) { PH_FENCE();
#ifndef NO_Q
_Pragma("unroll")
            for (int rep = 0; rep < REPN(3); ++rep) { EpiQ E{C_Q, C_ssqq, C_cosT, C_sinT}; run_gemm(C, C_CQ, C_Wuq, NH * DQK, QL, E); }
#endif
#ifndef NO_KV
_Pragma("unroll")
            for (int rep = 0; rep < REPN(3); ++rep) { EpiKV E{C_KV, C_ssqkv}; run_gemm(C, C_CKV, C_Wukv, 4096, KVL, E); }
#endif
            SEAM(pb + 3);
        }
        if (IN(pb + 4)) { PH_FENCE();
_Pragma("unroll")
            for (int rep = 0; rep < REPN(4); ++rep) ssm_outputs(C, l);
            if (!fused) SEAM(pb + 4); }
        if (IN(pb + 5)) { PH_FENCE();
_Pragma("unroll")
            for (int rep = 0; rep < REPN(5); ++rep) attn_phase(C);
            SEAM(pb + 5); }
        if (IN(pb + 6)) { PH_FENCE(); if (REPN(6) > 1) { EpiPlain E2{C_Q}; run_gemm(C, C_RA, C_Wo, DM, DM, E2); } EpiWo E{C_GA}; run_gemm(C, C_RA, C_Wo, DM, DM, E); SEAM(pb + 6); }
        if (IN(pb + 7)) { PH_FENCE(); if (REPN(7) > 1) { EpiSwiGlu E2{C_Q, C_RS2}; run_gemm(C, C_Z, C_Wglu, 4096, SW, E2); } EpiGlu E{C_GA, C_GB, C_in(I_BGLU) + l * 2 * DM}; run_gemm(C, C_Z, C_Wglu, 4096, SW, E); SEAM(pb + 7); }
        #ifdef DBG_K8
        if (IN(pb + 8)) { PH_FENCE(); EpiPlain E{C_GA}; run_gemm(C, C_RA, C_Wout, DM, DM, E); SEAM(pb + 8); }
#else
        if (IN(pb + 8)) { PH_FENCE(); EpiPlain E{C_RA};
_Pragma("unroll")
            for (int rep = 0; rep < REPN(8); ++rep) run_gemm(C, C_GA, C_Wout, DM, DM, E);
            SEAM(pb + 8); }
#endif
        if (IN(pb + 9)) { PH_FENCE();
            const float* wpost = C_in(I_POSTMIX) + l * DM;
            if (REPN(9) > 1) row_phase<1>(C, nullptr, C_XB, DBG_DELTA, wpost, C_XB2, nullptr, C_RS2);
            row_phase<1>(C, nullptr, C_XB, DBG_DELTA, wpost, l == DEPTH - 1 ? C_XB2 : C_XB, nullptr, C_RS2);
            SEAM(pb + 9);
        }
        if (IN(pb + 10)) { PH_FENCE(); EpiSwiGlu E{C_HID, C_RS2};
_Pragma("unroll")
            for (int rep = 0; rep < REPN(10); ++rep) run_gemm(C, l == DEPTH - 1 ? C_XB2 : C_XB, C_Wgu, 2 * FF, DM, E);
            SEAM(pb + 10); }
        if (IN(pb + 11)) { PH_FENCE(); EpiPlain E{C_F};
_Pragma("unroll")
            for (int rep = 0; rep < REPN(11); ++rep) run_gemm(C, C_HID, C_Wdn, DM, FF, E);
            SEAM(pb + 11); }
    }
    if (IN(DEPTH * 12)) { PH_FENCE();
        const float* wpost = C_in(I_POSTFFN) + (DEPTH - 1) * DM;
        row_phase<2>(C, nullptr, C_XB2, C_F, wpost, nullptr, C_out, nullptr);
    }
    if (PROBE_STAMP && fused) {
        STAMP_AT(48); { XcdBarrier b2_ = bar; xcd_barrier(b2_); }
        if (C.bid == 0 && C.tid == 0) { const unsigned long long* st = (const unsigned long long*)(args.ws + 262144); unsigned long long q1 = 0, q2 = 0, q3 = 0;
            for (int k = 0; k < 49; ++k) { if (!(((PROBE_STAMP_SEL) >> (k % 12)) & 1)) continue; unsigned long long mx = 0, mn = ~0ull, sm = 0; for (int b = 0; b < C.G; ++b) { const unsigned long long v = __hip_atomic_load(st + b * 64 + k, __ATOMIC_RELAXED, __HIP_MEMORY_SCOPE_AGENT); mx = v > mx ? v : mx; mn = v < mn ? v : mn; sm += v; }
                q1 += mx - mn; q2 += mx - sm / C.G;
                if (PROBE_STAMP == 3) { unsigned long long se = 0; const unsigned long long* st2 = st + 16384; for (int b = 0; b < C.G; ++b) se += __hip_atomic_load(st2 + b * 64 + k, __ATOMIC_RELAXED, __HIP_MEMORY_SCOPE_AGENT); if (se / C.G > mx && mx > 0) q3 += se / C.G - mx; } }
            unsigned long long spin = (PROBE_STAMP == 1 ? q1 : PROBE_STAMP == 3 ? q3 * 4 : q2 * 2); if (spin > 2000000ull) spin = 2000000ull;     const unsigned long long t0 = __builtin_amdgcn_s_memrealtime();
            while (__builtin_amdgcn_s_memrealtime() - t0 < spin) __builtin_amdgcn_s_sleep(8); }
    }
#undef IN
#undef SEAM
#undef gw
#undef NGW
}

#ifndef MK_SINGLE
#define MK_SINGLE 0
#endif
#ifndef MK_PH_END
#define MK_PH_END NPH
#endif
extern "C" void kernel_launch(void* const* d_in, const int* in_sizes, int n_in, void* d_out, int out_size, void* d_ws, size_t ws_size, hipStream_t stream) {
    static int grid = 0;
    if (grid == 0) {
        if (n_in != 27 || in_sizes[0] != T * DM || out_size != T * DM || ws_size < WS_END) { fprintf(stderr, "kernel_launch: unexpected shapes: n_in %d in0 %d out %d ws %zu (need %zu)\n", n_in, n_in > 0 ? in_sizes[0] : -1, out_size, ws_size, (size_t)WS_END); grid = -1; return; }
        int dev = 0, cus = 0, per_cu = 0;
        if (hipGetDevice(&dev) != hipSuccess || hipDeviceGetAttribute(&cus, hipDeviceAttributeMultiprocessorCount, dev) != hipSuccess) { grid = -1; return; }
        if (hipFuncSetAttribute((const void*)mk_fwd, hipFuncAttributeMaxDynamicSharedMemorySize, LDS_BYTES) != hipSuccess) { fprintf(stderr, "kernel_launch: hipFuncSetAttribute failed\n"); grid = -1; return; }
        if (hipOccupancyMaxActiveBlocksPerMultiprocessor(&per_cu, (const void*)mk_fwd, NWAVES * 64, LDS_BYTES) != hipSuccess || per_cu < 1) fprintf(stderr, "kernel_launch: occupancy query says %d\n", per_cu);
        (void)hipGetLastError();
        grid = cus;
    }
    if (grid < 0) return;
    if (hipMemsetAsync((char*)d_ws + WS_CTL, 0, CTL_ZERO_BYTES, stream) != hipSuccess) return;
    Args a{};
    for (int i = 0; i < 27; ++i) a.in[i] = (const float*)d_in[i];
    a.out = (float*)d_out; a.ws = (unsigned char*)d_ws;
#if MK_SINGLE
    a.ph_lo = 0; a.ph_hi = MK_PH_END;
    hipLaunchKernelGGL(mk_fwd, dim3(grid), dim3(NWAVES * 64), LDS_BYTES, stream, a);
#else
    for (int p = 0; p < MK_PH_END; ++p) { a.ph_lo = p; a.ph_hi = p + 1; hipLaunchKernelGGL(mk_fwd, dim3(grid), dim3(NWAVES * 64), LDS_BYTES, stream, a); }
#endif
    const hipError_t le = hipPeekAtLastError();
    if (le != hipSuccess) fprintf(stderr, "kernel_launch: launch failed: %s\n", hipGetErrorName(le));
}
```
